# Optimizing an MI355X kernel written in HIP

```python
import jax, jax.numpy as jnp
from jax import lax
import numpy as np

D_MODEL = 1024
BATCH = 16
SEQ = 2048
DEPTH = 4

GRID_W = 64
CTX_LEN = 256
N_MIXERS = 2
N_FNET_LAYERS = (DEPTH + 1) // 2
N_RWKV_LAYERS = DEPTH // 2
N_VRES_LAYERS = N_RWKV_LAYERS - 1
FNET_GROUPS = 4
FNET_GROUP_DIM = D_MODEL // FNET_GROUPS
HEAD_SIZE = 64
N_HEADS = D_MODEL // HEAD_SIZE
D_DECAY_LORA = 64
D_AAA_LORA = 64
D_MV_LORA = 32
D_GATE_LORA = 128
N_DIRS = 2
N_EXPERTS = 16
D_EXPERT = 1024
CAPACITY_FACTOR = 2
NORM_EPS = 1e-6
LNX_EPS = 64e-5

kernel_name = 'hybrid_fnet_rwkv7_ecmoe_dit'


def rmsnorm(h, g):
    hf = h.astype(jnp.float32)
    hf = hf * lax.rsqrt(jnp.mean(hf * hf, axis=-1, keepdims=True) + NORM_EPS)
    return (hf * g.astype(jnp.float32)).astype(h.dtype)


def adaln_params(cvec, w, b):
    return jnp.split(jax.nn.silu(cvec) @ w + b, 6, axis=-1)


def fourier_mix(h, w_o, b_o):
    bsz, t, _ = h.shape
    hg = h.astype(jnp.float32).reshape(bsz, t, FNET_GROUPS, FNET_GROUP_DIM)
    f = jnp.fft.fft2(hg, axes=(1, 3), norm='ortho').real
    return f.reshape(bsz, t, D_MODEL).astype(h.dtype) @ w_o + b_o


def qshift_grid(h):
    bsz, t, d = h.shape
    rows = t // GRID_W
    g = h.reshape(bsz, rows, GRID_W, d)
    q = d // 4
    left = jnp.pad(g[:, :, :-1, :q], ((0, 0), (0, 0), (1, 0), (0, 0)))
    right = jnp.pad(g[:, :, 1:, q:2 * q], ((0, 0), (0, 0), (0, 1), (0, 0)))
    up = jnp.pad(g[:, :-1, :, 2 * q:3 * q], ((0, 0), (1, 0), (0, 0), (0, 0)))
    down = jnp.pad(g[:, 1:, :, 3 * q:], ((0, 0), (0, 1), (0, 0), (0, 0)))
    return jnp.concatenate([left, right, up, down], axis=-1).reshape(bsz, t, d)


def shift_seq(h):
    half = h.shape[-1] // 2
    prev = jnp.pad(h[:, :-1, :half], ((0, 0), (1, 0), (0, 0)))
    nxt = jnp.pad(h[:, 1:, half:], ((0, 0), (0, 1), (0, 0)))
    return jnp.concatenate([prev, nxt], axis=-1)


def to_heads(t):
    return t.reshape(t.shape[0], t.shape[1], N_HEADS, HEAD_SIZE)


def rwkv_project(h, h_shift, mix, wr, wk, wv, w0, w1, w2, a0, a1, a2, g1, g2, k_k, k_a, v_first, vres):
    xx = h_shift - h
    xr, xw, xk, xv, xa, xg = [h + xx * mix[j] for j in range(6)]
    r = xr @ wr
    k = xk @ wk
    v = xv @ wv
    if vres is not None:
        v0, v1, v2 = vres
        v = v + (v_first - v) * jax.nn.sigmoid(v0 + (xv @ v1) @ v2)
    g = jax.nn.sigmoid(xg @ g1) @ g2
    kk = to_heads((k * k_k).astype(jnp.float32))
    kk = kk * lax.rsqrt(jnp.sum(kk * kk, axis=-1, keepdims=True) + 1e-12)
    kf = k.astype(jnp.float32)
    dirs = []
    for d in range(N_DIRS):
        wlog = (w0[d] + jnp.tanh(xw @ w1[d]) @ w2[d]).astype(jnp.float32)
        wlog = -jax.nn.softplus(-wlog) - 0.5
        decay = jnp.exp(-jnp.exp(wlog))
        a = jax.nn.sigmoid((a0[d] + (xa @ a1[d]) @ a2[d]).astype(jnp.float32))
        k_d = kf * (1.0 + (a - 1.0) * k_a.astype(jnp.float32))
        dirs.append((to_heads(decay), to_heads(k_d), to_heads(a)))
    return to_heads(r.astype(jnp.float32)), v, g, kk, dirs


def wkv_scan(r, decay, k, v, a_vec, b_vec, s0, reverse):
    def step(s, inp):
        r_t, w_t, k_t, v_t, a_t, b_t = inp
        sa = jnp.einsum('bhvk,bhk->bhv', s, a_t)
        s = s * w_t[:, :, None, :] + sa[..., None] * b_t[:, :, None, :] + v_t[..., None] * k_t[:, :, None, :]
        return s, jnp.einsum('bhvk,bhk->bhv', s, r_t)
    xs = tuple(jnp.swapaxes(t, 0, 1) for t in (r, decay, k, v, a_vec, b_vec))
    s_final, ys = lax.scan(step, s0, xs, reverse=reverse)
    return jnp.swapaxes(ys, 0, 1), s_final


def rwkv_output(y, r, v, g, k_dirs, r_k, lnx_w, lnx_b, wo, dtype):
    mu = jnp.mean(y, axis=-1, keepdims=True)
    var = jnp.mean(jnp.square(y - mu), axis=-1, keepdims=True)
    yn = (y - mu) * lax.rsqrt(var + LNX_EPS)
    bsz, t = y.shape[:2]
    yn = yn.reshape(bsz, t, D_MODEL) * lnx_w.astype(jnp.float32) + lnx_b.astype(jnp.float32)
    rk = r_k.astype(jnp.float32)
    bonus = sum(jnp.sum(r * k_d * rk, axis=-1, keepdims=True) for k_d in k_dirs) * v
    out = (yn + bonus.reshape(bsz, t, D_MODEL)).astype(dtype) * g
    return out @ wo


def ec_moe(h, router, wg, wu, wd):
    bsz, t, d = h.shape
    cap = CAPACITY_FACTOR * t // N_EXPERTS
    aff = jax.nn.softmax((h @ router).astype(jnp.float32), axis=-1)
    gates, idx = lax.top_k(jnp.swapaxes(aff, 1, 2), cap)
    xs = jax.vmap(lambda hb, ib: hb[ib])(h, idx)
    hid = jax.nn.silu(jnp.einsum('becd,edf->becf', xs, wg)) * jnp.einsum('becd,edf->becf', xs, wu)
    ys = jnp.einsum('becf,efd->becd', hid, wd) * gates[..., None].astype(h.dtype)
    return jax.vmap(lambda ib, yb: jnp.zeros((t, d), h.dtype).at[ib.reshape(-1)].add(yb.reshape(-1, d)))(idx, ys)


def setup_inputs(seed: int = 0) -> dict:
    key = jax.random.key(seed)
    ks = iter(jax.random.split(key, 40))

    def nrm(shape, scale):
        return jax.random.normal(next(ks), shape, jnp.float32) * scale

    D = D_MODEL
    inv = D ** -0.5
    NR = N_RWKV_LAYERS
    NV = N_VRES_LAYERS
    return {
        'x': nrm((BATCH, SEQ, D), 1.0),
        'c': nrm((BATCH, D), 1.0),
        'ctx': nrm((BATCH, CTX_LEN, D), 1.0),
        'c_ctx': nrm((D,), 1.0),
        'ada_w': nrm((DEPTH, D, 6 * D), 0.5 * inv),
        'ada_b': nrm((DEPTH, 6 * D), 0.01),
        'norm_g': 1.0 + nrm((DEPTH, 2, D), 0.1),
        'fnet_wo': nrm((N_FNET_LAYERS, D, D), inv),
        'fnet_bo': nrm((N_FNET_LAYERS, D), 0.01),
        'rw_mix': jax.random.uniform(next(ks), (NR, 6, D), jnp.float32),
        'rw_wr': nrm((NR, D, D), inv),
        'rw_wk': nrm((NR, D, D), inv),
        'rw_wv': nrm((NR, D, D), inv),
        'rw_wo': nrm((NR, D, D), inv),
        'rw_w0': jax.random.uniform(next(ks), (NR, N_DIRS, D), jnp.float32, -6.0, 1.0),
        'rw_w1': nrm((NR, N_DIRS, D, D_DECAY_LORA), inv),
        'rw_w2': nrm((NR, N_DIRS, D_DECAY_LORA, D), 0.1),
        'rw_a0': nrm((NR, N_DIRS, D), 0.5),
        'rw_a1': nrm((NR, N_DIRS, D, D_AAA_LORA), inv),
        'rw_a2': nrm((NR, N_DIRS, D_AAA_LORA, D), 0.1),
        'rw_v0': nrm((NV, D), 0.5),
        'rw_v1': nrm((NV, D, D_MV_LORA), inv),
        'rw_v2': nrm((NV, D_MV_LORA, D), 0.1),
        'rw_g1': nrm((NR, D, D_GATE_LORA), inv),
        'rw_g2': nrm((NR, D_GATE_LORA, D), D_GATE_LORA ** -0.5),
        'rw_kk': 0.85 + nrm((NR, D), 0.1),
        'rw_ka': 1.0 + nrm((NR, D), 0.1),
        'rw_rk': nrm((NR, N_HEADS, HEAD_SIZE), 0.1),
        'rw_lnx_w': 1.0 + nrm((NR, D), 0.1),
        'rw_lnx_b': nrm((NR, D), 0.01),
        'moe_router': nrm((DEPTH, D, N_EXPERTS), inv),
        'moe_wg': nrm((DEPTH, N_EXPERTS, D, D_EXPERT), inv),
        'moe_wu': nrm((DEPTH, N_EXPERTS, D, D_EXPERT), inv),
        'moe_wd': nrm((DEPTH, N_EXPERTS, D_EXPERT, D), D_EXPERT ** -0.5),
        'final_g': 1.0 + nrm((D,), 0.1),
    }


def reference(x, c, ctx, c_ctx, ada_w, ada_b, norm_g, fnet_wo, fnet_bo, rw_mix, rw_wr, rw_wk, rw_wv, rw_wo,
              rw_w0, rw_w1, rw_w2, rw_a0, rw_a1, rw_a2, rw_v0, rw_v1, rw_v2, rw_g1, rw_g2, rw_kk, rw_ka, rw_rk,
              rw_lnx_w, rw_lnx_b, moe_router, moe_wg, moe_wu, moe_wd, final_g):
    dtype = x.dtype
    v_first_x = None
    v_first_c = None
    for i in range(DEPTH):
        need_ctx = i < DEPTH - 1
        sh1x, sc1x, g1x, sh2x, sc2x, g2x = [m[:, None, :] for m in adaln_params(c, ada_w[i], ada_b[i])]
        sh1c, sc1c, g1c, sh2c, sc2c, g2c = adaln_params(c_ctx, ada_w[i], ada_b[i])
        hx = rmsnorm(x, norm_g[i, 0]) * (1.0 + sc1x) + sh1x
        if i % N_MIXERS == 0:
            fi = i // N_MIXERS
            x = x + g1x * fourier_mix(hx, fnet_wo[fi], fnet_bo[fi])
            if need_ctx:
                hc = rmsnorm(ctx, norm_g[i, 0]) * (1.0 + sc1c) + sh1c
                ctx = ctx + g1c * fourier_mix(hc, fnet_wo[fi], fnet_bo[fi])
        else:
            ri = i // N_MIXERS
            hc = rmsnorm(ctx, norm_g[i, 0]) * (1.0 + sc1c) + sh1c
            vres = None if ri == 0 else (rw_v0[ri - 1], rw_v1[ri - 1], rw_v2[ri - 1])
            prm = (rw_mix[ri], rw_wr[ri], rw_wk[ri], rw_wv[ri], rw_w0[ri], rw_w1[ri], rw_w2[ri],
                   rw_a0[ri], rw_a1[ri], rw_a2[ri], rw_g1[ri], rw_g2[ri], rw_kk[ri], rw_ka[ri])
            r_x, v_x, gt_x, kk_x, dirs_x = rwkv_project(hx, qshift_grid(hx), *prm, v_first_x, vres)
            r_c, v_c, gt_c, kk_c, dirs_c = rwkv_project(hc, shift_seq(hc), *prm, v_first_c, vres)
            if ri == 0:
                v_first_x, v_first_c = v_x, v_c
            vh_x = to_heads(v_x.astype(jnp.float32))
            vh_c = to_heads(v_c.astype(jnp.float32))
            s0 = jnp.zeros((x.shape[0], N_HEADS, HEAD_SIZE, HEAD_SIZE), jnp.float32)
            ys_x = []
            ys_c = []
            for d in range(N_DIRS):
                reverse = d == 1
                dec_c, k_c, a_c = dirs_c[d]
                yc_d, s_ctx = wkv_scan(r_c, dec_c, k_c, vh_c, -kk_c, kk_c * a_c, s0, reverse)
                dec_x, k_x, a_x = dirs_x[d]
                yx_d, _ = wkv_scan(r_x, dec_x, k_x, vh_x, -kk_x, kk_x * a_x, s_ctx, reverse)
                ys_x.append(yx_d)
                ys_c.append(yc_d)
            x = x + g1x * rwkv_output(ys_x[0] + ys_x[1], r_x, vh_x, gt_x, [dd[1] for dd in dirs_x],
                                      rw_rk[ri], rw_lnx_w[ri], rw_lnx_b[ri], rw_wo[ri], dtype)
            if need_ctx:
                ctx = ctx + g1c * rwkv_output(ys_c[0] + ys_c[1], r_c, vh_c, gt_c, [dd[1] for dd in dirs_c],
                                              rw_rk[ri], rw_lnx_w[ri], rw_lnx_b[ri], rw_wo[ri], dtype)
        hx = rmsnorm(x, norm_g[i, 1]) * (1.0 + sc2x) + sh2x
        x = x + g2x * ec_moe(hx, moe_router[i], moe_wg[i], moe_wu[i], moe_wd[i])
        if need_ctx:
            hc = rmsnorm(ctx, norm_g[i, 1]) * (1.0 + sc2c) + sh2c
            ctx = ctx + g2c * ec_moe(hc, moe_router[i], moe_wg[i], moe_wu[i], moe_wd[i])
    return rmsnorm(x, final_g)
```

```cpp
#include <hip/hip_runtime.h>
#include <cstdio>
#include <cstdint>
#include <type_traits>

#ifndef MK_SINGLE
#define MK_SINGLE 1
#endif

#define LAS __attribute__((address_space(3)))
typedef unsigned short bf16_t;
typedef short bf16x8 __attribute__((ext_vector_type(8)));
typedef float f32x4 __attribute__((ext_vector_type(4)));
typedef float f32x2 __attribute__((ext_vector_type(2)));
typedef unsigned u32x4 __attribute__((ext_vector_type(4)));
typedef unsigned u32x2 __attribute__((ext_vector_type(2)));

constexpr int D = 1024, NB = 16, TX = 2048, TCX = 256, NXR = NB * TX, NCR = NB * TCX, NR = NXR + NCR;
constexpr int NE = 16, CAPX = 256, CAPC = 32, NSX = NB * NE * CAPX, NSC = NB * NE * CAPC, NS = NSX + NSC;
constexpr int NWAVES = 8, NTHR = 512;
constexpr int LDS_BYTES = 147456, MISC_OFF = LDS_BYTES - 256;

constexpr size_t MiB = 1u << 20;
constexpr size_t WS_CTL = 0, WS_W2CAT = 1 * MiB, WS_WCAT = 7 * MiB, WS_ZERO_BYTES = 35 * MiB;
constexpr size_t WS_MOD = 35 * MiB, WS_CTXR = 37 * MiB, WS_WOT = 53 * MiB, WS_CH = 61 * MiB, WS_SEQC = 61 * MiB + 512 * 1024, WS_SEQX = 62 * MiB;
constexpr size_t WS_AFF = 78 * MiB, WS_GATE = 81 * MiB, WS_IDX = 81 * MiB + 512 * 1024, WS_INV = 82 * MiB, WS_BONUS = 84 * MiB, WS_WOB = 89 * MiB;
constexpr size_t WS_HXS = 41 * MiB, WS_WL8 = 42 * MiB, WS_WL8S = 44 * MiB;
constexpr size_t WS_WO8 = 37 * MiB, WS_WO8S = 39 * MiB, WS_OUTSC = 40 * MiB;
constexpr size_t WS_RKVWS = 89 * MiB + 64 * 1024;
constexpr size_t WS_RKVXS = 78 * MiB;
constexpr size_t WS_HBSCALE = 83 * MiB + 256 * 1024;
constexpr size_t WS_XSCALE = 89 * MiB + 256 * 1024, WS_WSCALE = 89 * MiB + 640 * 1024;
constexpr size_t WS_MOEW = 90 * MiB, WS_MOEW_GU = WS_MOEW, WS_MOEW_DN = WS_MOEW + 64 * MiB, WS_G = WS_MOEW;
constexpr size_t WS_VFIRST = 186 * MiB, WS_ARENA = 258 * MiB;
constexpr size_t WS_HB2 = WS_ARENA, WS_HB = WS_ARENA, WS_OUTB = WS_ARENA, WS_W0 = WS_ARENA, WS_W1 = WS_ARENA + 72 * MiB;
constexpr size_t WS_YS = WS_ARENA + 144 * MiB, WS_A0 = WS_ARENA + 144 * MiB, WS_A1 = WS_ARENA + 216 * MiB;
constexpr size_t WS_XS = WS_ARENA + 288 * MiB, WS_YT = WS_ARENA + 288 * MiB, WS_YTC = WS_ARENA + 416 * MiB, WS_R = WS_ARENA + 288 * MiB, WS_K = WS_ARENA + 360 * MiB;
constexpr size_t WS_HID = WS_ARENA + 432 * MiB, WS_VB = WS_ARENA + 432 * MiB, WS_A23 = WS_ARENA + 504 * MiB, WS_Y0 = WS_ARENA + 504 * MiB;
constexpr size_t WS_XR = WS_ARENA + 144 * MiB, WS_XK = WS_ARENA + 216 * MiB, WS_XV = WS_ARENA + 576 * MiB;
constexpr size_t WS_DELTA = WS_XV;
constexpr size_t WS_END = WS_ARENA + 648 * MiB;
constexpr size_t WS_XB = WS_END + 64 * MiB, WS_TOTAL = WS_XB + (size_t)NR * D * 2;

__device__ __forceinline__ float bf2f(unsigned b) { return __uint_as_float(b << 16); }
typedef __bf16 bf16x2_t __attribute__((ext_vector_type(2)));
__device__ __forceinline__ unsigned pk2(float lo, float hi) { const f32x2 v = {lo, hi}; const bf16x2_t b = __builtin_convertvector(v, bf16x2_t); return __builtin_bit_cast(unsigned, b); }
__device__ __forceinline__ unsigned f2bf(float f) { return pk2(f, 0.f) & 0xffffu; }
#define DPP_F(v, ctrl) __int_as_float(__builtin_amdgcn_update_dpp(0, __float_as_int(v), (ctrl), 0xF, 0xF, true))
__device__ __forceinline__ float row16_sum(float v) {
    v += DPP_F(v, 0xB1); v += DPP_F(v, 0x4E); v += DPP_F(v, 0x141); v += DPP_F(v, 0x140); return v; }
__device__ __forceinline__ float wave_sum(float v) {
    v = row16_sum(v);
    return (__int_as_float(__builtin_amdgcn_readlane(__float_as_int(v), 0)) + __int_as_float(__builtin_amdgcn_readlane(__float_as_int(v), 16))) + (__int_as_float(__builtin_amdgcn_readlane(__float_as_int(v), 32)) + __int_as_float(__builtin_amdgcn_readlane(__float_as_int(v), 48))); }
__device__ __forceinline__ float wave_max(float v) {
    v = fmaxf(v, DPP_F(v, 0xB1)); v = fmaxf(v, DPP_F(v, 0x4E)); v = fmaxf(v, DPP_F(v, 0x141)); v = fmaxf(v, DPP_F(v, 0x140));
    return fmaxf(fmaxf(__int_as_float(__builtin_amdgcn_readlane(__float_as_int(v), 0)), __int_as_float(__builtin_amdgcn_readlane(__float_as_int(v), 16))), fmaxf(__int_as_float(__builtin_amdgcn_readlane(__float_as_int(v), 32)), __int_as_float(__builtin_amdgcn_readlane(__float_as_int(v), 48)))); }
__device__ __forceinline__ float lane_xor(float v, int mask, int lane) { return __int_as_float(__builtin_amdgcn_ds_bpermute((lane ^ mask) << 2, __float_as_int(v))); }
__device__ __forceinline__ float sigmoidf_(float x) { return __builtin_amdgcn_rcpf(1.0f + __expf(-x)); }
__device__ __forceinline__ float tanhf_(float x) { const float e = __expf(-2.0f * fabsf(x)); const float t = (1.0f - e) * __builtin_amdgcn_rcpf(1.0f + e); return x < 0.f ? -t : t; }

#define XB_TMO      128
#define XB_XCNT(j)  (256  + 64 * (j))
#define XB_XSUB(j)  (1280 + 64 * (j))
#define XB_XGEN(j)  (2304 + 64 * (j))
#define XB_TOP      3328
#define XB_TOPGEN   3392
#define XCD_BAR_WORDS 3456
#define XB_SPIN_CAP (1u << 22)
__device__ __forceinline__ unsigned xb_ld(unsigned* p)              { return __hip_atomic_load(p, __ATOMIC_RELAXED, __HIP_MEMORY_SCOPE_AGENT); }
__device__ __forceinline__ unsigned xb_add(unsigned* p, unsigned v) { return __hip_atomic_fetch_add(p, v, __ATOMIC_RELAXED, __HIP_MEMORY_SCOPE_AGENT); }
__device__ __forceinline__ unsigned xb_xcc_id() { return (unsigned)__builtin_amdgcn_s_getreg((3 << 11) | 20) & 0xFu; }
#define XB_SPIN(cond, bar) do { unsigned _sp = 0; while (cond) { __builtin_amdgcn_s_sleep(1); \
    if ((++_sp & 255u) == 0u) { if (xb_ld(&(bar)[XB_TMO])) break; if (_sp > XB_SPIN_CAP) { atomicAdd(&(bar)[XB_TMO], 1u); break; } } } } while (0)
struct XcdBarrier { unsigned* bar; unsigned x; volatile LAS unsigned* st; };
__device__ __forceinline__ XcdBarrier xcd_barrier_post(unsigned* bar, volatile LAS unsigned* st) {
    XcdBarrier b; b.bar = bar; b.x = xb_xcc_id(); b.st = st;
    if (threadIdx.x == 0) (void)xb_add(&bar[XB_XCNT(b.x)], 1u);
    return b;
}
__device__ __forceinline__ void xcd_barrier_complete(unsigned* bar, unsigned x, unsigned& nloc, unsigned& nx) {
    const unsigned G = gridDim.x * gridDim.y * gridDim.z;
    unsigned sum, cnt, mine, sp = 0u;
    for (;;) {
        sum = 0u; cnt = 0u; mine = 0u;
#pragma unroll
        for (unsigned j = 0; j < 16; ++j) { const unsigned c = xb_ld(&bar[XB_XCNT(j)]); sum += c; cnt += (c > 0u) ? 1u : 0u; mine = (j == x) ? c : mine; }
        if (sum == G) break;
        __builtin_amdgcn_s_sleep(1);
        if ((++sp & 255u) == 0u) { if (xb_ld(&bar[XB_TMO])) break; if (sp > XB_SPIN_CAP) { atomicAdd(&bar[XB_TMO], 1u); break; } }
    }
    nloc = mine > 0u ? mine : 1u; nx = cnt > 0u ? cnt : 1u;
}
__device__ __forceinline__ void xcd_barrier(const XcdBarrier& b) {
    asm volatile("s_waitcnt vmcnt(0)" ::: "memory");
    __syncthreads();
    if (threadIdx.x == 0) {
        unsigned* bar = b.bar;
        __builtin_amdgcn_s_waitcnt(0);
        unsigned nloc = b.st[0], nx = b.st[1];
        if (nloc == 0u) { xcd_barrier_complete(bar, b.x, nloc, nx); b.st[0] = nloc; b.st[1] = nx; }
        const unsigned old = xb_add(&bar[XB_XSUB(b.x)], 1u);
        const unsigned gen = old / nloc;
        if (old + 1u == (gen + 1u) * nloc) {
            __builtin_amdgcn_fence(__ATOMIC_RELEASE, "agent");
            asm volatile("s_waitcnt vmcnt(0)" ::: "memory");
            const unsigned og = xb_add(&bar[XB_TOP], 1u);
            const unsigned tg = og / nx;
            if (og + 1u == (tg + 1u) * nx) xb_add(&bar[XB_TOPGEN], 1u);
            else XB_SPIN(xb_ld(&bar[XB_TOPGEN]) == tg, bar);
            __builtin_amdgcn_fence(__ATOMIC_ACQUIRE, "agent");
            xb_add(&bar[XB_XGEN(b.x)], 1u);
            asm volatile("s_waitcnt vmcnt(0)" ::: "memory");
        } else {
            XB_SPIN(xb_ld(&bar[XB_XGEN(b.x)]) == gen, bar);
            __builtin_amdgcn_fence(__ATOMIC_ACQUIRE, "agent");
            asm volatile("s_waitcnt vmcnt(0)" ::: "memory");
        }
    }
    __syncthreads();
}

namespace pg8 {
constexpr int BM = 256, BK = 64, HALF = 128, HTB = HALF * BK * 2, STAGE_BYTES = 8 * HTB, NXCD = 8, WGM = 8;
__device__ __forceinline__ int lds_byte(int r, int c) { const int st = (r >> 4) * 2 + (c >> 5), rr = r & 15, cc = c & 31, ob = rr * 64 + cc * 2; return st * 1024 + (ob ^ (((ob >> 9) & 1) << 5)); }
__device__ __forceinline__ void stage_rc(int b, int& R, int& C) { const int st = b / 1024, sb = b % 1024, swz = sb ^ (((sb >> 9) & 1) << 5); R = (st >> 1) * 16 + swz / 64; C = (st & 1) * 32 + (swz % 64) / 2; }
__device__ __forceinline__ int perm32(int rho) { const int n = rho >> 4, i = rho & 15; return 8 * (i >> 2) + 4 * n + (i & 3); }
struct Unit { int pm, pn; };
__device__ __forceinline__ bool tile_order(int i, int G, int c, int nM, int nN, Unit& u) {
    const int nwg = nM * nN; const long L = (long)i * G + c; if (L >= nwg) return false;
    int wgid = (int)L; { const int q = nwg / NXCD, r = nwg % NXCD, xcd = wgid % NXCD, off = wgid / NXCD; wgid = (xcd < r ? xcd * (q + 1) : r * (q + 1) + (xcd - r) * q) + off; }
    const int nig = WGM * nN, gid = wgid / nig, fm = gid * WGM, gsz = (nM - fm) < WGM ? (nM - fm) : WGM;
    u.pm = fm + ((wgid % nig) % gsz); u.pn = (wgid % nig) / gsz; return true;
}
__device__ __forceinline__ unsigned cvt_pk_bf16(float lo, float hi) { const f32x2 v = {lo, hi}; const bf16x2_t b = __builtin_convertvector(v, bf16x2_t); return __builtin_bit_cast(unsigned, b); }

__device__ __forceinline__ const char* uni_ptr(const char* p) { const unsigned long long v = (unsigned long long)p;
    const unsigned lo = __builtin_amdgcn_readfirstlane((unsigned)v), hi = __builtin_amdgcn_readfirstlane((unsigned)(v >> 32)); return (const char*)(((unsigned long long)hi << 32) | lo); }
typedef int i32x4 __attribute__((ext_vector_type(4)));
template <bool I8> __device__ __forceinline__ f32x4 mma_step(const bf16x8 b, const bf16x8 a, const f32x4 c) { return __builtin_amdgcn_mfma_f32_16x16x32_bf16(b, a, c, 0, 0, 0); }
template <bool I8> __device__ __forceinline__ i32x4 mma_step(const bf16x8 b, const bf16x8 a, const i32x4 c) { return __builtin_amdgcn_mfma_i32_16x16x64_i8(__builtin_bit_cast(i32x4, b), __builtin_bit_cast(i32x4, a), c, 0, 0, 0); }
template <class Prob, class Epi, bool I8 = false>
__device__ __forceinline__ void gemm_phase(LAS unsigned char* lds, int tid, const Prob& P, const Epi& E) {
    typedef typename std::conditional<I8, i32x4, f32x4>::type acc_t;
    asm volatile("" : "+v"(tid));
    const int wid = __builtin_amdgcn_readfirstlane(tid >> 6), lane = tid & 63, wr = wid >> 2, wc = wid & 3, fr = lane & 15, fq = lane >> 4;
    constexpr int lda = Prob::LDA, ldb = Prob::LDB;
    unsigned voffA[2], voffB[2];
#pragma unroll
    for (int i = 0; i < 2; ++i) { int R, C; stage_rc(tid * 16 + i * 8192, R, C); const int Rb = Epi::PERM ? ((R & ~31) + perm32(R & 31)) : R;
        voffA[i] = (unsigned)(R * lda + C) * 2u; voffB[i] = (unsigned)(Rb * ldb + C) * 2u; }
    constexpr unsigned kstep = (unsigned)(BK * 2);
    constexpr unsigned hstepA = (unsigned)HALF * lda * 2, hstepB = (unsigned)HALF * ldb * 2;
    const unsigned ldsw = (unsigned)wid * 1024u;
    const int aoff = lds_byte(wr * 64 + fr, fq * 8), boff = lds_byte(wc * 32 + fr, fq * 8);
    typedef const __attribute__((address_space(1))) char* gptr_t;
    const gptr_t gA = (gptr_t)uni_ptr(P.gA), gB = (gptr_t)uni_ptr(P.gB);
#define PG8_SA(b, h) (((b) * 2 + (h)) * HTB)
#define PG8_SB(b, h) ((4 + (b) * 2 + (h)) * HTB)
#define PG8_STAGE(bufoff, gbase, uoff, voff) do { _Pragma("unroll") for (int _i = 0; _i < 2; ++_i) \
        __builtin_amdgcn_global_load_lds((const __attribute__((address_space(1))) unsigned*)((gbase) + (unsigned)((uoff) + (voff)[_i])), (LAS unsigned*)(lds + (bufoff) + ldsw + _i * 8192), 16, 0, 0); } while (0)
#define PG8_STA(bufoff, uoff) PG8_STAGE(bufoff, gA, uoff, voffA)
#define PG8_STB(bufoff, uoff) PG8_STAGE(bufoff, gB, uoff, voffB)
#define PG8_LDA(dst, b, h) do { _Pragma("unroll") for (int m = 0; m < 4; ++m) _Pragma("unroll") for (int k = 0; k < 2; ++k) dst[m][k] = *(const LAS bf16x8*)(lds + PG8_SA(b, h) + aoff + m * 2048 + k * 1024); } while (0)
#define PG8_LDB(dst, b, h) do { _Pragma("unroll") for (int n = 0; n < 2; ++n) _Pragma("unroll") for (int k = 0; k < 2; ++k) dst[n][k] = *(const LAS bf16x8*)(lds + PG8_SB(b, h) + boff + n * 2048 + k * 1024); } while (0)
#define PG8_MMA(ai, bj, At, Bt) do { __builtin_amdgcn_s_setprio(1); _Pragma("unroll") for (int m = 0; m < 4; ++m) _Pragma("unroll") for (int n = 0; n < 2; ++n) _Pragma("unroll") for (int k = 0; k < 2; ++k) \
        acc[ai][bj][m][n] = mma_step<I8>(Bt[n][k], At[m][k], acc[ai][bj][m][n]); __builtin_amdgcn_s_setprio(0); } while (0)
#define PG8_WAIT_V(n) asm volatile("s_waitcnt vmcnt(" #n ")" ::: "memory")
#define PG8_WAIT_L(n) asm volatile("s_waitcnt lgkmcnt(" #n ")" ::: "memory")
#define PG8_BAR __builtin_amdgcn_s_barrier()
#define PG8_SCHED __builtin_amdgcn_sched_barrier(0)
    Unit cur, nxt; int ui = 0;
    if (!P.next(0, cur)) return;
    acc_t acc[2][2][4][2];
#pragma unroll
    for (int a = 0; a < 2; ++a)
#pragma unroll
        for (int b = 0; b < 2; ++b)
#pragma unroll
            for (int m = 0; m < 4; ++m)
#pragma unroll
                for (int n = 0; n < 2; ++n) acc[a][b][m][n] = (acc_t){0, 0, 0, 0};
    bf16x8 At[4][2], B0[2][2], B1[2][2];
    unsigned cA = __builtin_amdgcn_readfirstlane(P.a_off(cur)), cB = __builtin_amdgcn_readfirstlane(P.b_off(cur)); int nt = P.nt(cur);
    PG8_STB(PG8_SB(0, 0), cB); PG8_STB(PG8_SB(0, 1), cB + hstepB); PG8_STA(PG8_SA(0, 0), cA); PG8_STA(PG8_SA(0, 1), cA + hstepA);
    if (wr == 1) PG8_BAR;
    PG8_WAIT_V(2); PG8_BAR;
    PG8_STB(PG8_SB(1, 0), cB + kstep); PG8_STA(PG8_SA(1, 0), cA + kstep); PG8_STB(PG8_SB(1, 1), cB + hstepB + kstep);
    PG8_WAIT_V(6); PG8_BAR;
    for (;;) {
        const bool has_next = P.next(ui + 1, nxt);
        const unsigned nA = has_next ? __builtin_amdgcn_readfirstlane(P.a_off(nxt)) : cA, nB = has_next ? __builtin_amdgcn_readfirstlane(P.b_off(nxt)) : cB;
#pragma unroll 1
        for (int t = 0; t < nt; t += 2) {
            const bool last = (t == nt - 2);
            const unsigned a1 = cA + (unsigned)(t + 1) * kstep;
            const unsigned a2 = last ? nA : cA + (unsigned)(t + 2) * kstep, b2 = last ? nB : cB + (unsigned)(t + 2) * kstep;
            const unsigned a3 = a2 + kstep, b3 = b2 + kstep;
            PG8_LDB(B0, 0, 0); PG8_LDB(B1, 0, 1); PG8_SCHED; PG8_LDA(At, 0, 0); PG8_STA(PG8_SA(1, 1), a1 + hstepA);
            PG8_WAIT_V(8); PG8_WAIT_L(0); PG8_BAR; PG8_MMA(0, 0, At, B0); PG8_MMA(0, 1, At, B1); PG8_BAR; PG8_SCHED;
            PG8_LDA(At, 0, 1); PG8_STB(PG8_SB(0, 0), b2); PG8_STB(PG8_SB(0, 1), b2 + hstepB); PG8_STA(PG8_SA(0, 0), a2);
            PG8_WAIT_V(8); PG8_WAIT_L(0); PG8_BAR; PG8_MMA(1, 0, At, B0); PG8_MMA(1, 1, At, B1); PG8_BAR; PG8_SCHED;
            PG8_LDB(B0, 1, 0); PG8_LDB(B1, 1, 1); PG8_SCHED; PG8_LDA(At, 1, 0); PG8_STA(PG8_SA(0, 1), a2 + hstepA);
            PG8_WAIT_V(8); PG8_WAIT_L(0); PG8_BAR; PG8_MMA(0, 0, At, B0); PG8_MMA(0, 1, At, B1); PG8_BAR; PG8_SCHED;
            PG8_LDA(At, 1, 1); PG8_STB(PG8_SB(1, 0), b3); PG8_STB(PG8_SB(1, 1), b3 + hstepB); PG8_STA(PG8_SA(1, 0), a3);
            PG8_WAIT_V(8); PG8_WAIT_L(0); PG8_BAR; PG8_MMA(1, 0, At, B0); PG8_MMA(1, 1, At, B1); PG8_BAR; PG8_SCHED;
        }
        if (wr == 0) PG8_BAR;
        E(acc, cur, wr, wc, fr, fq);
        if (!has_next) break;
#pragma unroll
        for (int a = 0; a < 2; ++a)
#pragma unroll
            for (int b = 0; b < 2; ++b)
#pragma unroll
                for (int m = 0; m < 4; ++m)
#pragma unroll
                    for (int n = 0; n < 2; ++n) acc[a][b][m][n] = (acc_t){0, 0, 0, 0};
        cur = nxt; cA = nA; cB = nB; nt = P.nt(cur); ++ui;
        if (wr == 1) PG8_BAR;
    }
    PG8_WAIT_V(0);
    PG8_BAR;
#undef PG8_SA
#undef PG8_SB
#undef PG8_STAGE
#undef PG8_STA
#undef PG8_STB
#undef PG8_LDA
#undef PG8_LDB
#undef PG8_MMA
#undef PG8_WAIT_V
#undef PG8_WAIT_L
#undef PG8_BAR
#undef PG8_SCHED
}

__device__ __forceinline__ void st8(bf16_t* p, const f32x4 v0, const f32x4 v1) {
    u32x4 w; w.x = cvt_pk_bf16(v0[0], v0[1]); w.y = cvt_pk_bf16(v0[2], v0[3]); w.z = cvt_pk_bf16(v1[0], v1[1]); w.w = cvt_pk_bf16(v1[2], v1[3]);
    *(u32x4*)p = w;
}
}

struct Args { const float* in[35]; float* out; unsigned char* ws; int ph_lo, ph_hi; };
typedef const __attribute__((address_space(4))) Args CArgs;
__device__ __forceinline__ CArgs* launder_args(CArgs* p) { unsigned long long v = (unsigned long long)p; asm volatile("" : "+s"(v)); return (CArgs*)v; }
enum { I_X = 0, I_C, I_CTX, I_CCTX, I_ADAW, I_ADAB, I_NORMG, I_FWO, I_FBO, I_MIX, I_WR, I_WK, I_WV, I_WO, I_W0, I_W1, I_W2, I_A0, I_A1, I_A2, I_V0, I_V1, I_V2, I_G1, I_G2,
       I_KK, I_KA, I_RK, I_LNW, I_LNB, I_ROUTER, I_WG, I_WU, I_WD, I_FG };

struct JobDesc { int src, soff, scl, sclo, dbuf, doff, K, N, ldt; };
#define MJ(src, soff, scl, sclo, dbuf, doff, K, N, ldt) { src, soff, scl, sclo, dbuf, doff, K, N, ldt }
#define WCB(ri) ((ri) * 3584 * 2048)
#define W2B(ri) ((ri) * 6144 * 256)
#define JOBS_RI(ri) \
    MJ(I_W1, ((ri) * 2 + 0) * 65536, -1, 0, 1, WCB(ri) + 3072 * 2048, 1024, 64, 2048), MJ(I_W1, ((ri) * 2 + 0) * 65536, I_MIX, ((ri) * 6 + 1) * 1024, 1, WCB(ri) + 3072 * 2048 + 1024, 1024, 64, 2048), \
    MJ(I_W1, ((ri) * 2 + 1) * 65536, -1, 0, 1, WCB(ri) + 3136 * 2048, 1024, 64, 2048), MJ(I_W1, ((ri) * 2 + 1) * 65536, I_MIX, ((ri) * 6 + 1) * 1024, 1, WCB(ri) + 3136 * 2048 + 1024, 1024, 64, 2048), \
    MJ(I_A1, ((ri) * 2 + 0) * 65536, -1, 0, 1, WCB(ri) + 3200 * 2048, 1024, 64, 2048), MJ(I_A1, ((ri) * 2 + 0) * 65536, I_MIX, ((ri) * 6 + 4) * 1024, 1, WCB(ri) + 3200 * 2048 + 1024, 1024, 64, 2048), \
    MJ(I_A1, ((ri) * 2 + 1) * 65536, -1, 0, 1, WCB(ri) + 3264 * 2048, 1024, 64, 2048), MJ(I_A1, ((ri) * 2 + 1) * 65536, I_MIX, ((ri) * 6 + 4) * 1024, 1, WCB(ri) + 3264 * 2048 + 1024, 1024, 64, 2048), \
    MJ(I_G1, (ri) * 131072, -1, 0, 1, WCB(ri) + 3328 * 2048, 1024, 128, 2048),   MJ(I_G1, (ri) * 131072, I_MIX, ((ri) * 6 + 5) * 1024, 1, WCB(ri) + 3328 * 2048 + 1024, 1024, 128, 2048), \
    MJ(I_W2, ((ri) * 2 + 0) * 65536, -1, 0, 2, W2B(ri) + 0 * 256 + 0, 64, 1024, 256),      MJ(I_W2, ((ri) * 2 + 1) * 65536, -1, 0, 2, W2B(ri) + 1024 * 256 + 64, 64, 1024, 256), \
    MJ(I_A2, ((ri) * 2 + 0) * 65536, -1, 0, 2, W2B(ri) + 2048 * 256 + 128, 64, 1024, 256), MJ(I_A2, ((ri) * 2 + 1) * 65536, -1, 0, 2, W2B(ri) + 3072 * 256 + 192, 64, 1024, 256), \
    MJ(I_G2, (ri) * 131072, -1, 0, 2, W2B(ri) + 4096 * 256 + 0, 128, 1024, 256)
__device__ const JobDesc JOBS[] = {
    MJ(I_FWO, 0 * 1048576, -1, 0, 0, 0 * 1048576, 1024, 1024, 1024),
    MJ(I_FWO, 1 * 1048576, -1, 0, 0, 2 * 1048576, 1024, 1024, 1024),
    JOBS_RI(0), JOBS_RI(1),
    MJ(I_V1, 0, -1, 0, 1, WCB(1) + 3456 * 2048, 1024, 32, 2048), MJ(I_V1, 0, I_MIX, (1 * 6 + 3) * 1024, 1, WCB(1) + 3456 * 2048 + 1024, 1024, 32, 2048),
    MJ(I_V2, 0, -1, 0, 2, W2B(1) + 5120 * 256 + 128, 32, 1024, 256),
};
constexpr int NJOBS = 2 + 2 * 15 + 3;
static_assert(sizeof(JOBS) / sizeof(JobDesc) == NJOBS, "job count");

__host__ __device__ constexpr int job_items(int K, int N) { return ((K + 63) / 64) * ((N + 63) / 64); }
__device__ __forceinline__ void conv_item(const float* W, int ldw, int kvalid, int nvalid, const float* scale, bf16_t* dst, int ldt, LAS float* scr, int lane) {
    const int kr = lane >> 4, nc = 4 * (lane & 15);
    f32x4 v[16];
#pragma unroll
    for (int it = 0; it < 16; ++it) { const int k = 4 * it + kr; v[it] = (f32x4){0.f, 0.f, 0.f, 0.f};
        if (k < kvalid && nc < nvalid) { v[it] = *(const f32x4*)(W + (size_t)k * ldw + nc); if (scale) v[it] = v[it] * scale[k]; } }
#pragma unroll
    for (int it = 0; it < 16; ++it) *(LAS f32x4*)(scr + (4 * it + kr) * 68 + nc) = v[it];
    asm volatile("s_waitcnt lgkmcnt(0)" ::: "memory");
    if (lane < nvalid) {
#pragma unroll
        for (int c2 = 0; c2 < 8; c2 += 4) {
            float t[4][8];
#pragma unroll
            for (int c = 0; c < 4; ++c)
#pragma unroll
                for (int k = 0; k < 8; ++k) t[c][k] = scr[(8 * (c2 + c) + k) * 68 + lane];
            asm volatile("s_waitcnt lgkmcnt(0)" ::: "memory");
#pragma unroll
            for (int c = 0; c < 4; ++c) { u32x4 o; o.x = pg8::cvt_pk_bf16(t[c][0], t[c][1]); o.y = pg8::cvt_pk_bf16(t[c][2], t[c][3]); o.z = pg8::cvt_pk_bf16(t[c][4], t[c][5]); o.w = pg8::cvt_pk_bf16(t[c][6], t[c][7]);
                *(u32x4*)(dst + (size_t)lane * ldt + 8 * (c2 + c)) = o; } }
    }
    asm volatile("s_waitcnt lgkmcnt(0)" ::: "memory");
}

struct Frame {
    LAS unsigned char* lds;
    int tid, lane, wave, G, bid;
    unsigned char* ws;
};
#define WSP(T, off) ((T*)(F.ws + (off)))

__device__ __forceinline__ void quant_strip(Frame& F, const float* W, signed char* dst, int dst_pitch, float* scl, int drow0) {
    LAS float* T = (LAS float*)F.lds;
    { const int j4 = 4 * (F.tid & 7), kk = F.tid >> 3;
      f32x4 t[16];
#pragma unroll
      for (int p = 0; p < 16; ++p) t[p] = *(const f32x4*)(W + (size_t)(64 * p + kk) * 1024 + j4);
#pragma unroll
      for (int p = 0; p < 16; ++p) { LAS float* tp = T + (64 * p + kk) * 33 + j4; tp[0] = t[p][0]; tp[1] = t[p][1]; tp[2] = t[p][2]; tp[3] = t[p][3]; } }
    __syncthreads();
#pragma unroll 1
    for (int cq = 0; cq < 4; ++cq) {
        const int c = 4 * F.wave + cq;
        float am = 0.f;
        float tv[16];
#pragma unroll
        for (int i = 0; i < 16; ++i) tv[i] = T[(F.lane + 64 * i) * 33 + c];
        asm volatile("s_waitcnt lgkmcnt(0)" ::: "memory");
#pragma unroll
        for (int i = 0; i < 16; ++i) am = fmaxf(am, fabsf(tv[i]));
#pragma unroll
        for (int i = 0; i < 16; ++i) tv[i] = T[(16 * F.lane + i) * 33 + c];
        am = wave_max(am);
        const float inv = am > 0.f ? 127.0f / am : 0.f;
        asm volatile("s_waitcnt lgkmcnt(0)" ::: "memory");
        unsigned q[4];
#pragma unroll
        for (int i = 0; i < 4; ++i) { unsigned o = 0u;
#pragma unroll
            for (int jj = 0; jj < 4; ++jj) { const int qi = (int)__builtin_rintf(tv[4 * i + jj] * inv); o |= ((unsigned)qi & 255u) << (8 * jj); }
            q[i] = o; }
        *(u32x4*)(dst + (size_t)(drow0 + c) * dst_pitch + 16 * F.lane) = (u32x4){q[0], q[1], q[2], q[3]};
        if (F.lane == 0) scl[drow0 + c] = am * (1.0f / 127.0f);
    }
    __syncthreads();
}
__device__ __forceinline__ void p0_prologue(Frame& F, CArgs& a) {
    const int gw = F.bid * NWAVES + F.wave, NGW = F.G * NWAVES;
    const size_t gt = (size_t)F.bid * NTHR + F.tid, GT = (size_t)F.G * NTHR;
    {
        LAS float* SIL = (LAS float*)F.lds;
        LAS float* RED = (LAS float*)(F.lds + 69632);
        float* MOD = WSP(float, WS_MOD);
        if (F.bid < 192) {
            for (int idx = F.tid; idx < 17 * 1024; idx += NTHR) { const int r = idx >> 10, k = idx & 1023; const float cv = (r < 16) ? a.in[I_C][r * 1024 + k] : a.in[I_CCTX][k]; SIL[idx] = cv / (1.0f + __expf(-cv)); }
            __syncthreads();
        }
        for (int u = F.bid; u < 192; u += F.G) {
            const int l = u / 48, col0 = (u % 48) * 128;
            const float* W = a.in[I_ADAW] + (size_t)l * 1024 * 6144 + col0 + 2 * F.lane;
            float acc[17][2];
#pragma unroll
            for (int r = 0; r < 17; ++r) { acc[r][0] = 0.f; acc[r][1] = 0.f; }
            const int kbase = F.wave * 128;
            f32x2 wn[8];
#pragma unroll
            for (int q = 0; q < 8; ++q) wn[q] = *(const f32x2*)(W + (size_t)(kbase + q) * 6144);
#pragma unroll 1
            for (int k8 = 0; k8 < 16; ++k8) {
                const int k = kbase + 8 * k8;
                f32x2 w[8];
#pragma unroll
                for (int q = 0; q < 8; ++q) w[q] = wn[q];
                if (k8 + 1 < 16) {
#pragma unroll
                    for (int q = 0; q < 8; ++q) wn[q] = *(const f32x2*)(W + (size_t)(k + 8 + q) * 6144); }
#pragma unroll
                for (int r = 0; r < 17; ++r) { const f32x4 s0 = *(const LAS f32x4*)(SIL + r * 1024 + k), s1 = *(const LAS f32x4*)(SIL + r * 1024 + k + 4);
#pragma unroll
                    for (int q = 0; q < 4; ++q) { acc[r][0] += s0[q] * w[q].x; acc[r][1] += s0[q] * w[q].y; }
#pragma unroll
                    for (int q = 0; q < 4; ++q) { acc[r][0] += s1[q] * w[4 + q].x; acc[r][1] += s1[q] * w[4 + q].y; } }
            }
#pragma unroll
            for (int r = 0; r < 17; ++r) { RED[(F.wave * 17 + r) * 128 + 2 * F.lane] = acc[r][0]; RED[(F.wave * 17 + r) * 128 + 2 * F.lane + 1] = acc[r][1]; }
            __syncthreads();
            for (int o = F.tid; o < 17 * 128; o += NTHR) { const int r = o >> 7, cc = o & 127; float s = a.in[I_ADAB][l * 6144 + col0 + cc];
#pragma unroll
                for (int w = 0; w < 8; ++w) s += RED[(w * 17 + r) * 128 + cc];
                MOD[(size_t)(l * 17 + r) * 6144 + col0 + cc] = s; }
            __syncthreads();
        }
        __syncthreads();
    }
    for (int sidx = F.bid; sidx < 2 * 3 * 32; sidx += F.G) {
        const int ri = sidx / 96, rem = sidx % 96, which = rem >> 5, n0 = 32 * (rem & 31);
        const float* W = (which == 0 ? a.in[I_WR] : (which == 1 ? a.in[I_WK] : a.in[I_WV])) + (size_t)ri * 1048576 + n0;
        quant_strip(F, W, WSP(signed char, WS_WCAT) + (size_t)ri * 3584 * 4096, 4096, WSP(float, WS_RKVWS) + ri * 3072, which * 1024 + n0);
    }
    for (int sidx = (F.bid + 64) % F.G; sidx < 2 * 32; sidx += F.G) { const int ri = sidx >> 5, n0 = 32 * (sidx & 31);
        quant_strip(F, a.in[I_WO] + (size_t)ri * 1048576 + n0, WSP(signed char, WS_WO8) + (size_t)ri * 1048576, 1024, WSP(float, WS_WO8S) + ri * 1024, n0); }
    {
        LAS float* scr = (LAS float*)(F.lds + F.wave * 17408);
        int total = 0;
#pragma unroll 1
        for (int j = 0; j < NJOBS; ++j) total += job_items(JOBS[j].K, JOBS[j].N);
        for (int it = gw; it < total; it += NGW) {
            int j = 0, r = it;
#pragma unroll 1
            for (; j < NJOBS; ++j) { const int n = job_items(JOBS[j].K, JOBS[j].N); if (r < n) break; r -= n; }
            const JobDesc jd = JOBS[j];
            const int nblk = (jd.N + 63) / 64, kb = r / nblk, nb = r % nblk, k0 = 64 * kb, n0 = 64 * nb;
            const float* src = nullptr; const float* scl = nullptr;
#define SEL_IN(idx, out) do { switch (idx) { case I_FWO: out = a.in[I_FWO]; break; case I_WO: out = a.in[I_WO]; break; case I_WR: out = a.in[I_WR]; break; case I_WK: out = a.in[I_WK]; break; \
                case I_WV: out = a.in[I_WV]; break; case I_W1: out = a.in[I_W1]; break; case I_W2: out = a.in[I_W2]; break; case I_A1: out = a.in[I_A1]; break; case I_A2: out = a.in[I_A2]; break; \
                case I_G1: out = a.in[I_G1]; break; case I_G2: out = a.in[I_G2]; break; case I_V1: out = a.in[I_V1]; break; case I_V2: out = a.in[I_V2]; break; case I_MIX: out = a.in[I_MIX]; break; default: out = nullptr; } } while (0)
            SEL_IN(jd.src, src); if (jd.scl >= 0) SEL_IN(jd.scl, scl);
            bf16_t* dbase = jd.dbuf == 0 ? WSP(bf16_t, WS_WOT) : (jd.dbuf == 1 ? WSP(bf16_t, WS_WCAT) : WSP(bf16_t, WS_W2CAT));
            const int kvalid = (jd.K - k0) < 64 ? (jd.K - k0) : 64, nvalid = (jd.N - n0) < 64 ? (jd.N - n0) : 64;
            conv_item(src + jd.soff + (size_t)k0 * jd.N + n0, jd.N, kvalid, nvalid, scl ? scl + jd.sclo + k0 : nullptr, dbase + jd.doff + (size_t)n0 * jd.ldt + k0, jd.ldt, scr, F.lane);
        }
    }
    {
        float* wob = WSP(float, WS_WOB);
        for (size_t i = gt; i < 4 * 1024; i += GT) { const int l = (int)(i >> 10); wob[i] = (l & 1) ? 0.f : a.in[I_FBO][(l >> 1) * 1024 + (i & 1023)]; }
    }
    {
        bf16_t* CH = WSP(bf16_t, WS_CH);
        for (size_t i = gt; i < 512 * 256; i += GT) { const int m = (int)(i >> 8), c = (int)(i & 255), l = m & 255; const float ang = (float)((l * c) & 255) * (2.0f / 256.0f);
            CH[i] = (bf16_t)f2bf((m < 256 ? cospif(ang) : sinpif(ang)) * 0.0625f); }
        bf16_t* SX = WSP(bf16_t, WS_SEQX);
        for (size_t i = gt; i < (size_t)2048 * 4096; i += GT) { const int k = (int)(i >> 12), j = (int)(i & 4095), t = j & 2047; const float ang = (float)((k * t) & 2047) * (2.0f / 2048.0f);
            SX[i] = (bf16_t)f2bf((j < 2048 ? cospif(ang) : -sinpif(ang)) * 0.022097087f); }
        bf16_t* SC = WSP(bf16_t, WS_SEQC);
        for (size_t i = gt; i < 256 * 512; i += GT) { const int k = (int)(i >> 9), j = (int)(i & 511), t = j & 255; const float ang = (float)((k * t) & 255) * (2.0f / 256.0f);
            SC[i] = (bf16_t)f2bf((j < 256 ? cospif(ang) : -sinpif(ang)) * 0.0625f); }
    }
}

template <int MODE>
__device__ __forceinline__ void row_pass(Frame& F, CArgs& a, int l, bool combine, int nrows) {
    const int gw = F.bid * NWAVES + F.wave, NGW = F.G * NWAVES, lane = F.lane;
    const float* MOD = WSP(float, WS_MOD);
    const short* INV = WSP(short, WS_INV);
    const bf16_t* YS = WSP(bf16_t, WS_YS);
    LAS float* RT = (LAS float*)F.lds;
    if (MODE == 2) {
        const float* rt = a.in[I_ROUTER] + (size_t)l * 1024 * 16;
        for (int i = F.tid; i < 16384; i += NTHR) { const int k = i >> 4, e = i & 15; RT[e * 1024 + k] = rt[i]; }
        __syncthreads();
    }
    const float* ng = (MODE == 3) ? a.in[I_FG] : a.in[I_NORMG] + (size_t)(l * 2 + (MODE == 2 ? 1 : 0)) * 1024;
    f32x4 gv[4];
#pragma unroll
    for (int j = 0; j < 4; ++j) gv[j] = *(const f32x4*)(ng + 4 * lane + 256 * j);
    const int RPW = (nrows + NGW - 1) / NGW, r0 = gw * RPW, r1 = (r0 + RPW < nrows) ? r0 + RPW : nrows;
    int bcur = -1; f32x4 shv[4], scv[4], g2v[4];
    u32x2 nv[4], nd[4];
    if (MODE == 2 && r0 < r1) { const bf16_t* xs0 = WSP(bf16_t, WS_XB) + (size_t)r0 * D + 4 * lane; const bf16_t* dp0 = WSP(bf16_t, WS_DELTA) + (size_t)r0 * D + 4 * lane;
#pragma unroll
        for (int j = 0; j < 4; ++j) { nv[j] = *(const u32x2*)(xs0 + 256 * j); nd[j] = *(const u32x2*)(dp0 + 256 * j); } }
    for (int row = r0; row < r1; ++row) {
        const bool isx = row < NXR;
        const int b = isx ? (row >> 11) : 16;
        if (b != bcur) { bcur = b;
            if (MODE != 3) { const float* mrow = MOD + (size_t)(l * 17 + b) * 6144 + 4 * lane; const int shi = (MODE == 2) ? 3 : 0, sci = (MODE == 2) ? 4 : 1;
#pragma unroll
                for (int j = 0; j < 4; ++j) { shv[j] = *(const f32x4*)(mrow + shi * 1024 + 256 * j); scv[j] = *(const f32x4*)(mrow + sci * 1024 + 256 * j) + 1.0f; } }
            if (combine) { const int lp = (MODE == 3) ? 3 : l - 1; const float* g2 = MOD + (size_t)(lp * 17 + b) * 6144 + 5 * 1024 + 4 * lane;
#pragma unroll
                for (int j = 0; j < 4; ++j) g2v[j] = *(const f32x4*)(g2 + 256 * j); } }
        bf16_t* xb = WSP(bf16_t, WS_XB) + (size_t)row * D + 4 * lane;
        float* xr = a.out + (size_t)row * D;
        f32x4 v[4];
        const bool first = (MODE == 0) && (l == 0);
        if (MODE == 2) {
#pragma unroll
            for (int j = 0; j < 4; ++j) { const u32x2 w = nd[j], xw = nv[j]; v[j] = (f32x4){bf2f(xw.x & 0xffffu), bf2f(xw.x >> 16), bf2f(xw.y & 0xffffu), bf2f(xw.y >> 16)};
                v[j][0] += bf2f(w.x & 0xffffu); v[j][1] += bf2f(w.x >> 16); v[j][2] += bf2f(w.y & 0xffffu); v[j][3] += bf2f(w.y >> 16); }
            if (row + 1 < r1) { const int rn = row + 1; const bf16_t* xsn = WSP(bf16_t, WS_XB) + (size_t)rn * D + 4 * lane; const bf16_t* dpn = WSP(bf16_t, WS_DELTA) + (size_t)rn * D + 4 * lane;
#pragma unroll
                for (int j = 0; j < 4; ++j) { nv[j] = *(const u32x2*)(xsn + 256 * j); nd[j] = *(const u32x2*)(dpn + 256 * j); } }
        } else {
        if (first) { const float* xs = isx ? a.in[I_X] + (size_t)row * D : a.in[I_CTX] + (size_t)(row - NXR) * D;
#pragma unroll
            for (int j = 0; j < 4; ++j) v[j] = *(const f32x4*)(xs + 4 * lane + 256 * j); }
        else {
#pragma unroll
            for (int j = 0; j < 4; ++j) { const u32x2 xw = *(const u32x2*)(xb + 256 * j); v[j] = (f32x4){bf2f(xw.x & 0xffffu), bf2f(xw.x >> 16), bf2f(xw.y & 0xffffu), bf2f(xw.y >> 16)}; } }
        if (combine) {
            const bf16_t* dp = WSP(bf16_t, WS_DELTA) + (size_t)row * D + 4 * lane;
#pragma unroll
            for (int j = 0; j < 4; ++j) { const u32x2 w = *(const u32x2*)(dp + 256 * j); v[j][0] += bf2f(w.x & 0xffffu); v[j][1] += bf2f(w.x >> 16); v[j][2] += bf2f(w.y & 0xffffu); v[j][3] += bf2f(w.y >> 16); }
        }
        }
        if (first) {
#pragma unroll
            for (int j = 0; j < 4; ++j) { u32x2 w; w.x = pk2(v[j][0], v[j][1]); w.y = pk2(v[j][2], v[j][3]); *(u32x2*)(xb + 256 * j) = w; }
        }
        if (combine) {
            int myinv = -1; if (lane < 16) myinv = INV[(size_t)row * 16 + lane];
            f32x4 s[4];
#pragma unroll
            for (int j = 0; j < 4; ++j) s[j] = (f32x4){0.f, 0.f, 0.f, 0.f};
            unsigned em = (unsigned)__builtin_amdgcn_ballot_w64(myinv >= 0);
#pragma unroll 1
            while (em) {
                const int e0 = __builtin_ctz(em); em &= em - 1u;
                const bool two = em != 0u; const int e1 = two ? __builtin_ctz(em) : e0; em &= em - 1u;
                const int slot0 = __builtin_amdgcn_readlane(myinv, e0), slot1 = __builtin_amdgcn_readlane(myinv, e1);
                const size_t sr0 = isx ? ((size_t)((row >> 11) * 16 + e0) * CAPX + slot0) : ((size_t)NSX + (size_t)(e0 * 16 + ((row - NXR) >> 8)) * CAPC + slot0);
                const size_t sr1 = isx ? ((size_t)((row >> 11) * 16 + e1) * CAPX + slot1) : ((size_t)NSX + (size_t)(e1 * 16 + ((row - NXR) >> 8)) * CAPC + slot1);
                const bf16_t* yp0 = YS + sr0 * D + 4 * lane; const bf16_t* yp1 = YS + sr1 * D + 4 * lane;
                const float gt0 = WSP(float, WS_GATE)[sr0]; const float gt1 = two ? WSP(float, WS_GATE)[sr1] : 0.f;
                u32x2 w0[4], w1[4];
#pragma unroll
                for (int j = 0; j < 4; ++j) { w0[j] = *(const u32x2*)(yp0 + 256 * j); w1[j] = *(const u32x2*)(yp1 + 256 * j); }
#pragma unroll
                for (int j = 0; j < 4; ++j) {
                    s[j][0] += gt0 * bf2f(w0[j].x & 0xffffu); s[j][1] += gt0 * bf2f(w0[j].x >> 16); s[j][2] += gt0 * bf2f(w0[j].y & 0xffffu); s[j][3] += gt0 * bf2f(w0[j].y >> 16);
                    s[j][0] += gt1 * bf2f(w1[j].x & 0xffffu); s[j][1] += gt1 * bf2f(w1[j].x >> 16); s[j][2] += gt1 * bf2f(w1[j].y & 0xffffu); s[j][3] += gt1 * bf2f(w1[j].y >> 16); }
            }
#pragma unroll
            for (int j = 0; j < 4; ++j) v[j] = v[j] + g2v[j] * s[j];
            if (MODE != 3) {
#pragma unroll
                for (int j = 0; j < 4; ++j) { u32x2 w; w.x = pk2(v[j][0], v[j][1]); w.y = pk2(v[j][2], v[j][3]); *(u32x2*)(xb + 256 * j) = w; }
            }
        }
        float ss = 0.f;
#pragma unroll
        for (int j = 0; j < 4; ++j) ss += (v[j][0] * v[j][0] + v[j][1] * v[j][1]) + (v[j][2] * v[j][2] + v[j][3] * v[j][3]);
        ss = wave_sum(ss);
        const float rs = 1.0f / sqrtf(ss * (1.0f / 1024.0f) + 1e-6f);
        if (MODE == 3) {
#pragma unroll
            for (int j = 0; j < 4; ++j) *(f32x4*)(xr + 4 * lane + 256 * j) = v[j] * rs * gv[j];
            continue;
        }
        f32x4 h[4];
#pragma unroll
        for (int j = 0; j < 4; ++j) h[j] = v[j] * rs * gv[j] * scv[j] + shv[j];
        if (MODE == 2) {
            float am = 0.f;
#pragma unroll
            for (int j = 0; j < 4; ++j) am = fmaxf(am, fmaxf(fmaxf(fabsf(h[j][0]), fabsf(h[j][1])), fmaxf(fabsf(h[j][2]), fabsf(h[j][3]))));
            am = wave_max(am); const float inv = am > 0.f ? 127.0f / am : 0.f;
            signed char* hq = WSP(signed char, WS_HB) + (size_t)row * D;
#pragma unroll
            for (int j = 0; j < 4; ++j) { unsigned o = 0u;
#pragma unroll
                for (int i = 0; i < 4; ++i) { const int qi = (int)__builtin_rintf(h[j][i] * inv); o |= ((unsigned)qi & 255u) << (8 * i); }
                *(unsigned*)(hq + 4 * lane + 256 * j) = o; }
            if (lane == 0) WSP(float, WS_HBSCALE)[row] = am * (1.0f / 127.0f);
        } else {
        bf16_t* hb = (MODE == 1) ? WSP(bf16_t, WS_HB2) + (size_t)row * 2048 : WSP(bf16_t, WS_HB) + (size_t)row * 1024;
#pragma unroll
        for (int j = 0; j < 4; ++j) { u32x2 w; w.x = pk2(h[j][0], h[j][1]); w.y = pk2(h[j][2], h[j][3]); *(u32x2*)(hb + 4 * lane + 256 * j) = w; }
        }
        if (MODE == 2) {
            float lg[16];
            int rto = 4 * lane; asm volatile("" : "+v"(rto));
#pragma unroll
            for (int e4 = 0; e4 < 16; e4 += 4) {
                f32x4 r4[4][4];
#pragma unroll
                for (int q = 0; q < 4; ++q)
#pragma unroll
                    for (int j = 0; j < 4; ++j) r4[q][j] = *(const LAS f32x4*)(RT + (e4 + q) * 1024 + rto + 256 * j);
                asm volatile("s_waitcnt lgkmcnt(0)" ::: "memory");
#pragma unroll
                for (int q = 0; q < 4; ++q) { f32x2 p2 = (f32x2){0.f, 0.f};
#pragma unroll
                    for (int j = 0; j < 4; ++j) { const f32x4 rr = r4[q][j], hh = h[j];
                        p2 = __builtin_shufflevector(hh, hh, 0, 1) * __builtin_shufflevector(rr, rr, 0, 1) + p2;
                        p2 = __builtin_shufflevector(hh, hh, 2, 3) * __builtin_shufflevector(rr, rr, 2, 3) + p2; }
                    lg[e4 + q] = p2[0] + p2[1]; } }
            float lgx;
            { const bool b0 = (lane & 1) != 0, b1 = (lane & 2) != 0, b2 = (lane & 4) != 0, b3 = (lane & 8) != 0;
              float q8[8], q4[4], q2[2];
#pragma unroll
              for (int i = 0; i < 8; ++i) { const float keep = b0 ? lg[2 * i + 1] : lg[2 * i], send = b0 ? lg[2 * i] : lg[2 * i + 1]; q8[i] = keep + DPP_F(send, 0xB1); }
#pragma unroll
              for (int i = 0; i < 4; ++i) { const float keep = b1 ? q8[2 * i + 1] : q8[2 * i], send = b1 ? q8[2 * i] : q8[2 * i + 1]; q4[i] = keep + DPP_F(send, 0x4E); }
#pragma unroll
              for (int i = 0; i < 2; ++i) { const float keep = b2 ? q4[2 * i + 1] : q4[2 * i], send = b2 ? q4[2 * i] : q4[2 * i + 1]; q2[i] = keep + DPP_F(send, 0x124); }
              { const float keep = b3 ? q2[1] : q2[0], send = b3 ? q2[0] : q2[1]; lgx = keep + DPP_F(send, 0x128); }
              lgx += lane_xor(lgx, 16, lane); lgx += lane_xor(lgx, 32, lane); }
            float mx = lgx; mx = fmaxf(mx, DPP_F(mx, 0xB1)); mx = fmaxf(mx, DPP_F(mx, 0x4E)); mx = fmaxf(mx, DPP_F(mx, 0x141)); mx = fmaxf(mx, DPP_F(mx, 0x140));
            const float ex = __expf(lgx - mx); const float sum = row16_sum(ex); const float inv = 1.0f / sum;
            if (lane < 16) WSP(float, WS_AFF)[(size_t)row * 16 + lane] = ex * inv;
        }
    }
    if (MODE == 2) __syncthreads();
}

__device__ __forceinline__ void moe_weight_conv(Frame& F, CArgs& a, int l, int gemm_units) {
    for (int sidx = F.bid; sidx < 16 * 2 * 32; sidx += F.G) {
        const int e = sidx >> 6, which = (sidx >> 5) & 1, n0 = 32 * (sidx & 31);
        quant_strip(F, (which ? a.in[I_WU] : a.in[I_WG]) + ((size_t)(l * 16 + e) << 20) + n0, WSP(signed char, WS_MOEW_GU), 1024, WSP(float, WS_WSCALE), e * 2048 + 256 * (n0 >> 7) + 128 * which + (n0 & 127));
    }
    constexpr int NIT = 16 * 256;
    LAS float* scr = (LAS float*)(F.lds + F.wave * 17408);
    int first, count;
    if (F.G == 256) {
        const int nbig = gemm_units % 256;
        const int lo = (nbig > 0) ? 4 : 16, hi = (nbig > 0) ? (NIT - nbig * lo + (256 - nbig) - 1) / (256 - nbig) : 16;
        if (F.bid < nbig) { first = F.bid * lo; count = lo; } else { first = nbig * lo + (F.bid - nbig) * hi; count = hi; }
        if (first > NIT) first = NIT; if (first + count > NIT) count = NIT - first;
    } else { const int per = (NIT + F.G - 1) / F.G; first = F.bid * per; count = per; if (first > NIT) first = NIT; if (first + count > NIT) count = NIT - first; }
    for (int q = F.wave; q < count; q += NWAVES) {
        const int it = first + q;
        const int e = it >> 8, blk = it & 255, kb = blk >> 4, nb = blk & 15, k0 = 64 * kb, n0 = 64 * nb;
        const float* src = a.in[I_WD] + ((size_t)(l * 16 + e) << 20) + (size_t)k0 * 1024 + n0;
        bf16_t* dst = WSP(bf16_t, WS_MOEW_DN) + ((size_t)e * 1024 + n0) * 1024 + k0;
        conv_item(src, 1024, 64, 64, nullptr, dst, 1024, scr, F.lane);
    }
}

__device__ __forceinline__ void shift_pass(Frame& F, CArgs& a, int ri) {
    const int gw = F.bid * NWAVES + F.wave, NGW = F.G * NWAVES, lane = F.lane;
    bf16_t* HB2 = WSP(bf16_t, WS_HB2);
    float* XSC = WSP(float, WS_RKVXS);
    const float* mix = a.in[I_MIX] + (size_t)ri * 6 * 1024;
    if (gw < 512) {
        const u32x4* wrow = (const u32x4*)(F.ws + WS_WCAT + ((size_t)ri * 3584 + 3072 + gw) * 4096);
        u32x4 wv[4];
#pragma unroll
        for (int q = 0; q < 4; ++q) wv[q] = wrow[lane + 64 * q];
        float wf[4][8]; float wam = 0.f;
#pragma unroll
        for (int q = 0; q < 4; ++q) { const unsigned ww[4] = {wv[q].x, wv[q].y, wv[q].z, wv[q].w};
#pragma unroll
            for (int i = 0; i < 4; ++i) { wf[q][2 * i] = bf2f(ww[i] & 0xffffu); wf[q][2 * i + 1] = bf2f(ww[i] >> 16); wam = fmaxf(wam, fmaxf(fabsf(wf[q][2 * i]), fabsf(wf[q][2 * i + 1]))); } }
        wam = wave_max(wam); const float winv = wam > 0.f ? 127.0f / wam : 0.f;
        unsigned char* wdst = F.ws + WS_WL8 + ((size_t)ri * 512 + gw) * 2048;
#pragma unroll
        for (int q = 0; q < 4; ++q) { unsigned o[2];
#pragma unroll
            for (int hh = 0; hh < 2; ++hh) { unsigned oo = 0u;
#pragma unroll
                for (int i = 0; i < 4; ++i) { const int qi = (int)__builtin_rintf(wf[q][4 * hh + i] * winv); oo |= ((unsigned)qi & 255u) << (8 * i); }
                o[hh] = oo; }
            *(u32x2*)(wdst + 8 * (lane + 64 * q)) = (u32x2){o[0], o[1]}; }
        if (lane == 0) WSP(float, WS_WL8S)[ri * 512 + gw] = wam * (1.0f / 127.0f);
    }
    f32x4 mzv[3][4];
#pragma unroll
    for (int z = 0; z < 3; ++z)
#pragma unroll
        for (int j = 0; j < 4; ++j) mzv[z][j] = *(const f32x4*)(mix + (z == 0 ? 0 : (z == 1 ? 2 : 3)) * 1024 + 4 * lane + 256 * j);
    for (int row = gw; row < NR; row += NGW) {
        bf16_t* hp = HB2 + (size_t)row * 2048;
        f32x4 xv3[3][4]; float am[3] = {0.f, 0.f, 0.f};
        f32x4 h4v[4], xxv[4]; float amh = 0.f;
        u32x2 hc[4], hn[4]; bool okj[4];
#pragma unroll
        for (int j = 0; j < 4; ++j) {
            int nrow; bool ok;
            if (row < NXR) { const int t = row & 2047, col = t & 63, rg = t >> 6;
                if (j == 0) { ok = col > 0; nrow = row - 1; } else if (j == 1) { ok = col < 63; nrow = row + 1; } else if (j == 2) { ok = rg > 0; nrow = row - 64; } else { ok = rg < 31; nrow = row + 64; } }
            else { const int t = (row - NXR) & 255; if (j < 2) { ok = t > 0; nrow = row - 1; } else { ok = t < 255; nrow = row + 1; } }
            const int c0 = 4 * lane + 256 * j;
            okj[j] = ok;
            hc[j] = *(const u32x2*)(hp + c0);
            hn[j] = *(const u32x2*)(HB2 + (size_t)(ok ? nrow : row) * 2048 + c0);
        }
#pragma unroll
        for (int j = 0; j < 4; ++j) {
            const int c0 = 4 * lane + 256 * j;
            const u32x2 hcj = hc[j]; u32x2 hnj = hn[j]; if (!okj[j]) hnj = (u32x2){0u, 0u};
            const f32x4 h4 = (f32x4){bf2f(hcj.x & 0xffffu), bf2f(hcj.x >> 16), bf2f(hcj.y & 0xffffu), bf2f(hcj.y >> 16)};
            const f32x4 xx = (f32x4){bf2f(hnj.x & 0xffffu), bf2f(hnj.x >> 16), bf2f(hnj.y & 0xffffu), bf2f(hnj.y >> 16)} - h4;
            h4v[j] = h4; xxv[j] = xx;
            amh = fmaxf(amh, fmaxf(fmaxf(fmaxf(fabsf(h4[0]), fabsf(h4[1])), fmaxf(fabsf(h4[2]), fabsf(h4[3]))), fmaxf(fmaxf(fabsf(xx[0]), fabsf(xx[1])), fmaxf(fabsf(xx[2]), fabsf(xx[3])))));
#pragma unroll
            for (int z = 0; z < 3; ++z) { const f32x4 v = h4 + xx * mzv[z][j]; xv3[z][j] = v;
                am[z] = fmaxf(am[z], fmaxf(fmaxf(fabsf(v[0]), fabsf(v[1])), fmaxf(fabsf(v[2]), fabsf(v[3])))); }
        }
        { const float amx = wave_max(amh); const float inv = amx > 0.f ? 127.0f / amx : 0.f;
          signed char* hq = (signed char*)hp + 2048;
#pragma unroll
          for (int j = 0; j < 4; ++j) { unsigned oh = 0u, ox = 0u;
#pragma unroll
              for (int i = 0; i < 4; ++i) { const int qh = (int)__builtin_rintf(h4v[j][i] * inv), qx = (int)__builtin_rintf(xxv[j][i] * inv); oh |= ((unsigned)qh & 255u) << (8 * i); ox |= ((unsigned)qx & 255u) << (8 * i); }
              *(unsigned*)(hq + 4 * lane + 256 * j) = oh; *(unsigned*)(hq + 1024 + 4 * lane + 256 * j) = ox; }
          if (lane == 0) WSP(float, WS_HXS)[row] = amx * (1.0f / 127.0f); }
#pragma unroll
        for (int z = 0; z < 3; ++z) {
            const float amz = wave_max(am[z]); const float inv = amz > 0.f ? 127.0f / amz : 0.f;
            signed char* xq = (signed char*)(F.ws + (z == 0 ? WS_XR : (z == 1 ? WS_XK : WS_XV))) + (size_t)row * D;
#pragma unroll
            for (int j = 0; j < 4; ++j) { unsigned o = 0u;
#pragma unroll
                for (int i = 0; i < 4; ++i) { const int qi = (int)__builtin_rintf(xv3[z][j][i] * inv); o |= ((unsigned)qi & 255u) << (8 * i); }
                *(unsigned*)(xq + 4 * lane + 256 * j) = o; }
            if (lane == 0) XSC[(size_t)z * NR + row] = amz * (1.0f / 127.0f);
        }
    }
}

__device__ __forceinline__ int block_excl_scan(Frame& F, int v, LAS int* wsum, int& total) {
    int x = v;
#pragma unroll
    for (int o = 1; o < 64; o <<= 1) { const int y = __builtin_amdgcn_ds_bpermute((F.lane - o) << 2, x); if (F.lane >= o) x += y; }
    if (F.lane == 63) wsum[F.wave] = x;
    __syncthreads();
    int off = 0; total = 0;
#pragma unroll
    for (int w = 0; w < 8; ++w) { const int s = wsum[w]; if (w < F.wave) off += s; total += s; }
    __syncthreads();
    return off + x - v;
}
__device__ __forceinline__ void topk_phase(Frame& F, bool with_ctx) {
    LAS unsigned* hist = (LAS unsigned*)F.lds;
    LAS int* wsum = (LAS int*)(F.lds + 1024);
    LAS int* sel = (LAS int*)(F.lds + 1536);
    LAS int* selrow = (LAS int*)(F.lds + 2048);
    const float* AFF = WSP(float, WS_AFF);
    float* GATE = WSP(float, WS_GATE); int* IDX = WSP(int, WS_IDX); short* INV = WSP(short, WS_INV);
    const bf16_t* HB = WSP(bf16_t, WS_HB); unsigned char* XS8 = WSP(unsigned char, WS_XS);
    const int ntask = with_ctx ? 512 : 256;
    for (int task = F.bid; task < ntask; task += F.G) {
        int n, C, row0, e, sr0;
        if (task < 256) { const int b = task >> 4; e = task & 15; n = TX; C = CAPX; row0 = b * TX; sr0 = (b * 16 + e) * CAPX; }
        else { const int q = task - 256, b = q >> 4; e = q & 15; n = TCX; C = CAPC; row0 = NXR + b * TCX; sr0 = NSX + (e * 16 + b) * CAPC; }
        unsigned key[4]; float val[4];
#pragma unroll
        for (int j = 0; j < 4; ++j) { const int t = F.tid * 4 + j; val[j] = AFF[(size_t)(row0 + (t < n ? t : n - 1)) * 16 + e]; }
#pragma unroll
        for (int j = 0; j < 4; ++j) { const int t = F.tid * 4 + j; if (t < n) key[j] = __float_as_uint(val[j]); else { val[j] = 0.f; key[j] = 0u; } }
        unsigned prefix = 0u, mask = 0u; int remaining = C;
#pragma unroll 1
        for (int pass = 0; pass < 4; ++pass) {
            const int shift = 24 - 8 * pass;
            if (F.tid < 256) hist[F.tid] = 0u;
            __syncthreads();
#pragma unroll
            for (int j = 0; j < 4; ++j) { const int t = F.tid * 4 + j; if (t < n && (key[j] & mask) == prefix) __hip_atomic_fetch_add(&hist[(key[j] >> shift) & 255u], 1u, __ATOMIC_RELAXED, __HIP_MEMORY_SCOPE_WORKGROUP); }
            __syncthreads();
            if (F.wave == 0) {
                const u32x4 hq = *(const LAS u32x4*)(hist + 4 * F.lane);
                const int h0 = (int)hq.x, h1 = (int)hq.y, h2 = (int)hq.z, h3 = (int)hq.w, tot = (h0 + h1) + (h2 + h3);
                int xs = tot;
#pragma unroll
                for (int o = 1; o < 64; o <<= 1) { const int y = __builtin_amdgcn_ds_bpermute((F.lane + o) << 2, xs); if (F.lane + o < 64) xs += y; }
                const int excl = xs - tot;
                const int c3 = excl + h3, c2 = c3 + h2, c1 = c2 + h1, c0 = c1 + h0;
                if (excl < remaining && c0 >= remaining) {
                    int d = 4 * F.lane, above = c1;
                    if (c3 >= remaining) { d += 3; above = excl; } else if (c2 >= remaining) { d += 2; above = c3; } else if (c1 >= remaining) { d += 1; above = c2; }
                    sel[0] = d; sel[1] = remaining - above;
                }
            }
            __syncthreads();
            const int d = sel[0]; remaining = sel[1]; prefix |= ((unsigned)d) << shift; mask |= 0xFFu << shift;
            __syncthreads();
        }
        const unsigned thr = prefix; const int need_eq = remaining;
        int ceq = 0;
#pragma unroll
        for (int j = 0; j < 4; ++j) { const int t = F.tid * 4 + j; ceq += (t < n && key[j] == thr) ? 1 : 0; }
        int tot; int req = block_excl_scan(F, ceq, wsum, tot);
        bool s[4]; int cnt = 0;
#pragma unroll
        for (int j = 0; j < 4; ++j) { const int t = F.tid * 4 + j; const bool valid = t < n; const bool gt = valid && key[j] > thr; const bool eq = valid && key[j] == thr;
            bool take = gt; if (eq) { take = req < need_eq; ++req; } s[j] = take; cnt += take ? 1 : 0; }
        int slot = block_excl_scan(F, cnt, wsum, tot);
#pragma unroll
        for (int j = 0; j < 4; ++j) { const int t = F.tid * 4 + j;
            if (t < n) { const int row = row0 + t;
                if (s[j]) { if (slot < C) { IDX[sr0 + slot] = row; GATE[sr0 + slot] = val[j]; selrow[slot] = row; } INV[(size_t)row * 16 + e] = (short)slot; ++slot; }
                else INV[(size_t)row * 16 + e] = (short)-1; } }
        __syncthreads();
        for (int sidx = F.wave; sidx < C; sidx += NWAVES) { const int row = selrow[sidx];
            const u32x4* src = (const u32x4*)(WSP(unsigned char, WS_HB) + (size_t)row * D);
            const u32x4 w = src[F.lane];
            *((u32x4*)(XS8 + (size_t)(sr0 + sidx) * D) + F.lane) = w;
            if (F.lane == 0) WSP(float, WS_XSCALE)[sr0 + sidx] = WSP(float, WS_HBSCALE)[row]; }
        __syncthreads();
    }
}

__device__ __forceinline__ float dpp_row_shr(float v, const int n) {
    int r;
    if (n == 1) r = __builtin_amdgcn_update_dpp(0, __float_as_int(v), 0x111, 0xF, 0xF, true);
    else if (n == 2) r = __builtin_amdgcn_update_dpp(0, __float_as_int(v), 0x112, 0xF, 0xF, true);
    else if (n == 4) r = __builtin_amdgcn_update_dpp(0, __float_as_int(v), 0x114, 0xF, 0xF, true);
    else r = __builtin_amdgcn_update_dpp(0, __float_as_int(v), 0x118, 0xF, 0xF, true);
    return __int_as_float(r);
}
__device__ __forceinline__ bf16x8 pack_2(const f32x4 d0, const f32x4 d1) {
    u32x4 w; w.x = pg8::cvt_pk_bf16(d0[0], d0[1]); w.y = pg8::cvt_pk_bf16(d0[2], d0[3]); w.z = pg8::cvt_pk_bf16(d1[0], d1[1]); w.w = pg8::cvt_pk_bf16(d1[2], d1[3]); return __builtin_bit_cast(bf16x8, w); }
typedef short bf16x4 __attribute__((ext_vector_type(4)));
__device__ __forceinline__ bf16x4 pack4(const f32x4 d) { u32x2 w; w.x = pg8::cvt_pk_bf16(d[0], d[1]); w.y = pg8::cvt_pk_bf16(d[2], d[3]); return __builtin_bit_cast(bf16x4, w); }
#define MFMA16(a, b, c) __builtin_amdgcn_mfma_f32_16x16x32_bf16((a), (b), (c), 0, 0, 0)
__device__ __forceinline__ bf16x8 widen4(const bf16x4 v) { const u32x2 t = __builtin_bit_cast(u32x2, v); u32x4 w; w.x = t.x; w.y = t.y; w.z = 0u; w.w = 0u; return __builtin_bit_cast(bf16x8, w); }
#define MFMA4(a, b, c) __builtin_amdgcn_mfma_f32_16x16x32_bf16(widen4(a), widen4(b), (c), 0, 0, 0)
__device__ __forceinline__ float dpp_row_last(float v) { return __int_as_float(__builtin_amdgcn_update_dpp(0, __float_as_int(v), 0x15F, 0xF, 0xF, false)); }
__device__ __forceinline__ f32x4 unpk4(const u32x2 w) { return (f32x4){__uint_as_float(w.x << 16), __uint_as_float(w.x & 0xffff0000u), __uint_as_float(w.y << 16), __uint_as_float(w.y & 0xffff0000u)}; }
__device__ __forceinline__ void scan_pipe(Frame& F, CArgs& a, int ri, const bf16_t* Vsrc, bf16_t* Y1buf) {
    const int lane = F.lane, x = lane & 15, g = lane >> 4;
    const f32x4 zero4 = (f32x4){0.f, 0.f, 0.f, 0.f};
    constexpr int NCH = (TCX + TX) / 16, NCH0 = TCX / 16;
    const int dir = F.wave >> 2, role = dir ? 3 - (F.wave & 3) : (F.wave & 3);
    if (role >= 2) __builtin_amdgcn_s_setprio(2);
    bf16_t* Yb = dir ? Y1buf : WSP(bf16_t, WS_Y0);
    float* BON = WSP(float, WS_BONUS) + (size_t)dir * NR * 16;
    LAS unsigned char* DB = F.lds + dir * 66560;
    LAS float* CST = (LAS float*)DB;
    LAS unsigned char* RINGQ = DB + 1024;
    LAS unsigned char* RINGV = DB + 17408;
    LAS unsigned char* OPS = DB + 23552;
    LAS unsigned char* C2 = DB + 40960;
    typedef const __attribute__((address_space(1))) char* gptr_t;
    size_t z0 = WS_R, z1 = WS_K; if (role == 1) { z0 = dir ? WS_A1 : WS_A0; z1 = dir ? WS_W1 : WS_W0; }
    const gptr_t gZ0 = (gptr_t)pg8::uni_ptr((const char*)(F.ws + z0)), gZ1 = (gptr_t)pg8::uni_ptr((const char*)(F.ws + z1)), gV = (gptr_t)pg8::uni_ptr((const char*)Vsrc);
    bf16x8 E0, E1;
    { u32x4 w0 = (u32x4){0u, 0u, 0u, 0u}, w1 = w0; const int d = x - 4 * g;
      const unsigned lo = (d == 0 || d == 2) ? 0x3F80u : 0u, hi = (d == 1 || d == 3) ? 0x3F800000u : 0u;
      if (d == 0 || d == 1) { w0.x = lo | hi; w1.z = lo | hi; } if (d == 2 || d == 3) { w0.y = lo | hi; w1.w = lo | hi; }
      E0 = __builtin_bit_cast(bf16x8, w0); E1 = __builtin_bit_cast(bf16x8, w1); }
    const bf16x4 E4 = __builtin_shufflevector(E0, E0, 0, 1, 2, 3);
    for (int task = F.bid; task < 256; task += F.G) {
        const int b = task >> 4, h = task & 15;
        if (role == 2) { CST[lane] = a.in[I_KK][ri * 1024 + 64 * h + lane]; CST[64 + lane] = a.in[I_KA][ri * 1024 + 64 * h + lane]; CST[128 + lane] = a.in[I_RK][ri * 1024 + 64 * h + lane]; }
        f32x4 ST[4][4];
#pragma unroll
        for (int vq = 0; vq < 4; ++vq)
#pragma unroll
            for (int q = 0; q < 4; ++q) ST[vq][q] = zero4;
#define SCAN_ROW(cc, tok) ((cc) < NCH0 ? (NXR + b * TCX + (dir ? (TCX - 1 - ((cc) * 16 + (tok))) : ((cc) * 16 + (tok)))) : (b * TX + (dir ? (TX - 1 - (((cc) - NCH0) * 16 + (tok))) : (((cc) - NCH0) * 16 + (tok)))))
#define SCAN_DMA(cc) do { LAS unsigned char* _dq = RINGQ + ((cc) & 1) * 8192 + role * 4096; LAS unsigned char* _dv = RINGV + ((cc) % 3) * 2048 + role * 1024; int _ln = lane; asm volatile("" : "+v"(_ln)); \
            const unsigned _r0 = (unsigned)(SCAN_ROW(cc, (_ln >> 3)) * D + 64 * h + 8 * (_ln & 7)) * 2u, _r1 = (unsigned)(SCAN_ROW(cc, (_ln >> 3) + 8) * D + 64 * h + 8 * (_ln & 7)) * 2u; \
            __builtin_amdgcn_global_load_lds((const __attribute__((address_space(1))) unsigned*)(gZ0 + _r0), (LAS unsigned*)(_dq), 16, 0, 0); \
            __builtin_amdgcn_global_load_lds((const __attribute__((address_space(1))) unsigned*)(gZ0 + _r1), (LAS unsigned*)(_dq + 1024), 16, 0, 0); \
            __builtin_amdgcn_global_load_lds((const __attribute__((address_space(1))) unsigned*)(gZ1 + _r0), (LAS unsigned*)(_dq + 2048), 16, 0, 0); \
            __builtin_amdgcn_global_load_lds((const __attribute__((address_space(1))) unsigned*)(gZ1 + _r1), (LAS unsigned*)(_dq + 3072), 16, 0, 0); \
            __builtin_amdgcn_global_load_lds((const __attribute__((address_space(1))) unsigned*)(gV + (role ? _r1 : _r0)), (LAS unsigned*)(_dv), 16, 0, 0); } while (0)
        if (role < 2) SCAN_DMA(0);
#pragma unroll 1
        for (int t = 0; t < NCH + 2; ++t) {
            if (role < 2) asm volatile("s_waitcnt vmcnt(0)" ::: "memory");
            asm volatile("s_waitcnt lgkmcnt(0)" ::: "memory");
            __builtin_amdgcn_s_barrier();
            asm volatile("" ::: "memory");
            if (role < 2) {
                if (t < NCH) {
                    const int cc = t;
                    if (cc + 1 < NCH) SCAN_DMA(cc + 1);
                    const LAS unsigned char* rw = RINGQ + (cc & 1) * 8192 + x * 128 + 8 * g;
                    LAS unsigned char* ob = OPS + (cc & 1) * 8704;
                    int cso = 4 * g; asm volatile("" : "+v"(cso));
                    float ssq = 0.f;
                    float bon = 0.f;
#pragma unroll
                    for (int u = 0; u < 2; ++u) {
                        const int q = 2 * role + u;
                        const f32x4 kkc = *(const LAS f32x4*)(CST + 16 * q + cso), kac = *(const LAS f32x4*)(CST + 64 + 16 * q + cso), rkc = *(const LAS f32x4*)(CST + 128 + 16 * q + cso);
                        const f32x4 rr = unpk4(*(const LAS u32x2*)(rw + 32 * q)), kv = unpk4(*(const LAS u32x2*)(rw + 2048 + 32 * q)), aa = unpk4(*(const LAS u32x2*)(rw + 4096 + 32 * q));
                        const f32x4 l2 = unpk4(*(const LAS u32x2*)(rw + 6144 + 32 * q)) * 1.44269504f;
                        const f32x4 kn = kv * kkc;
                        ssq += (kn[0] * kn[0] + kn[1] * kn[1]) + (kn[2] * kn[2] + kn[3] * kn[3]);
                        const f32x4 kd = kv * ((aa - 1.0f) * kac + 1.0f);
                        const f32x4 bq = rr * kd * rkc;
                        bon += (bq[0] + bq[1]) + (bq[2] + bq[3]);
                        f32x4 glq, at, bt, kt, rt;
#pragma unroll
                        for (int e = 0; e < 4; ++e) { float c = l2[e]; c += dpp_row_shr(c, 1); c += dpp_row_shr(c, 2); c += dpp_row_shr(c, 4); c += dpp_row_shr(c, 8);
                            const float e1 = __builtin_amdgcn_exp2f(c), e0 = __builtin_amdgcn_exp2f(c - l2[e]), e2 = __builtin_amdgcn_rcpf(e1);
                            glq[e] = dpp_row_last(e1); at[e] = -kn[e] * e0; bt[e] = kn[e] * aa[e] * e2; kt[e] = kd[e] * e2; rt[e] = rr[e] * e1; }
                        if (x == 0) *(LAS f32x4*)(ob + 8192 + (16 * g + 4 * q) * 4) = glq;
                        LAS unsigned char* op = ob + q * 512 + lane * 8;
                        *(LAS bf16x4*)(op) = pack4(at); *(LAS bf16x4*)(op + 2048) = pack4(bt); *(LAS bf16x4*)(op + 4096) = pack4(kt); *(LAS bf16x4*)(op + 6144) = pack4(rt);
                    }
                    bon += lane_xor(bon, 16, lane); bon += lane_xor(bon, 32, lane);
                    ssq += lane_xor(ssq, 16, lane); ssq += lane_xor(ssq, 32, lane);
                    if (g == 0) { *(LAS float*)(ob + 8192 + 256 + (role * 16 + x) * 4) = bon; *(LAS float*)(ob + 8192 + 384 + (role * 16 + x) * 4) = ssq; }
                }
            } else if (role == 2) {
                if (t >= 1 && t <= NCH) {
                    const int cc = t - 1;
                    const LAS unsigned char* ob = OPS + (cc & 1) * 8704;
                    LAS unsigned char* cb = C2 + (cc & 1) * 12544;
                    bf16x8 aP[2], bP[2], kP[2], rP[2];
                    { const LAS unsigned char* op = ob + lane * 8;
#pragma unroll
                      for (int s2 = 0; s2 < 2; ++s2) {
                          const u32x2 a0 = *(const LAS u32x2*)(op + (2 * s2) * 512), a1 = *(const LAS u32x2*)(op + (2 * s2 + 1) * 512);
                          const u32x2 b0 = *(const LAS u32x2*)(op + 2048 + (2 * s2) * 512), b1 = *(const LAS u32x2*)(op + 2048 + (2 * s2 + 1) * 512);
                          const u32x2 k0 = *(const LAS u32x2*)(op + 4096 + (2 * s2) * 512), k1 = *(const LAS u32x2*)(op + 4096 + (2 * s2 + 1) * 512);
                          const u32x2 r0 = *(const LAS u32x2*)(op + 6144 + (2 * s2) * 512), r1 = *(const LAS u32x2*)(op + 6144 + (2 * s2 + 1) * 512);
                          aP[s2] = __builtin_bit_cast(bf16x8, (u32x4){a0.x, a0.y, a1.x, a1.y}); bP[s2] = __builtin_bit_cast(bf16x8, (u32x4){b0.x, b0.y, b1.x, b1.y});
                          kP[s2] = __builtin_bit_cast(bf16x8, (u32x4){k0.x, k0.y, k1.x, k1.y}); rP[s2] = __builtin_bit_cast(bf16x8, (u32x4){r0.x, r0.y, r1.x, r1.y}); } }
                    *(LAS float*)(cb + 12288 + lane * 4) = *(const LAS float*)(ob + 8192 + lane * 4);
                    if (g == 0) { const LAS float* bp = (const LAS float*)(ob + 8192 + 256) + x; ((__attribute__((address_space(1))) float*)BON)[(size_t)SCAN_ROW(cc, x) * 16 + h] = bp[0] + bp[16]; }
                    LAS unsigned char* cl = cb + lane * 192;
                    *(LAS bf16x8*)(cl) = rP[0]; *(LAS bf16x8*)(cl + 16) = rP[1];
                    { const LAS unsigned char* vr = RINGV + (cc % 3) * 2048 + x * 128 + 8 * g;
#pragma unroll
                      for (int vq = 0; vq < 4; ++vq) *(LAS bf16x4*)(cl + 160 + 8 * vq) = pack4(MFMA4(__builtin_bit_cast(bf16x4, *(const LAS u32x2*)(vr + 32 * vq)), E4, zero4)); }
                    float rx; f32x4 r4;
                    { const LAS float* sq = (const LAS float*)(ob + 8192 + 384);
                      rx = __builtin_amdgcn_rsqf(sq[x] + sq[16 + x] + 1e-12f);
                      const f32x4 s0 = *(const LAS f32x4*)(sq + 4 * g), s1 = *(const LAS f32x4*)(sq + 16 + 4 * g);
#pragma unroll
                      for (int e = 0; e < 4; ++e) r4[e] = __builtin_amdgcn_rsqf(s0[e] + s1[e] + 1e-12f); }
                    f32x4 nA = MFMA16(bP[0], aP[0], zero4); nA = MFMA16(bP[1], aP[1], nA);
                    f32x4 nB = MFMA16(aP[0], bP[0], zero4); nB = MFMA16(aP[1], bP[1], nB);
                    f32x4 mak = MFMA16(kP[0], aP[0], zero4); mak = MFMA16(kP[1], aP[1], mak);
                    f32x4 mrb = MFMA16(bP[0], rP[0], zero4); mrb = MFMA16(bP[1], rP[1], mrb);
                    f32x4 mrk = MFMA16(kP[0], rP[0], zero4); mrk = MFMA16(kP[1], rP[1], mrk);
                    bf16x4 atT[4];
#pragma unroll
                    for (int q = 0; q < 4; ++q) { atT[q] = pack4(MFMA16(aP[q >> 1], (q & 1) ? E1 : E0, zero4) * r4);
                        *(LAS bf16x8*)(cl + 64 + 16 * q) = pack_2(MFMA16(bP[q >> 1], (q & 1) ? E1 : E0, zero4) * r4, MFMA16(kP[q >> 1], (q & 1) ? E1 : E0, zero4)); }
                    f32x4 eye;
#pragma unroll
                    for (int e = 0; e < 4; ++e) { const int j = 4 * g + e; const float rr2 = rx * r4[e]; nA[e] = (j < x) ? nA[e] * rr2 : 0.f; nB[e] = (j > x) ? nB[e] * rr2 : 0.f; mak[e] = (j < x) ? mak[e] * rx : 0.f; mrb[e] = (j <= x) ? mrb[e] * r4[e] : 0.f; mrk[e] = (j <= x) ? mrk[e] : 0.f; eye[e] = (j == x) ? 1.f : 0.f; }
                    const bf16x4 nAo = pack4(nA), nBo = pack4(nB);
                    *(LAS bf16x8*)(cl + 128) = pack_2(mrb, mrk);
                    *(LAS bf16x4*)(cl + 144) = pack4(mak);
                    const f32x4 m2B = MFMA4(nBo, nAo, zero4), m2A = MFMA4(nAo, nBo, zero4);
                    const bf16x4 m2Bo = pack4(m2B), m2Ao = pack4(m2A);
                    const f32x4 m4B = MFMA4(m2Ao, m2Bo, zero4), m4A = MFMA4(m2Bo, m2Ao, zero4);
                    const bf16x4 m4Bo = pack4(m4B), m4Ao = pack4(m4A);
                    const f32x4 m8A = MFMA4(m4Bo, m4Ao, zero4);
                    f32x4 X1 = eye + m2B; X1 = MFMA4(nBo, pack4(X1), X1);
                    X1 = MFMA4(m4Ao, pack4(X1), X1);
                    X1 = MFMA4(pack4(m8A), pack4(X1), X1);
                    const bf16x4 tA = pack4(X1);
                    *(LAS bf16x4*)(cl + 152) = tA;
                    { f32x4 ah[4];
#pragma unroll
                      for (int q = 0; q < 4; ++q) ah[q] = MFMA4(atT[q], tA, zero4);
                      *(LAS bf16x8*)(cl + 32) = pack_2(ah[0], ah[1]); *(LAS bf16x8*)(cl + 48) = pack_2(ah[2], ah[3]); }
                }
            } else {
                if (t >= 2) {
                    const int cc = t - 2;
                    const LAS unsigned char* cb = C2 + (cc & 1) * 12544;
                    const LAS unsigned char* cl = cb + lane * 192;
                    const bf16x8 rP0 = *(const LAS bf16x8*)(cl), rP1 = *(const LAS bf16x8*)(cl + 16), ahP0 = *(const LAS bf16x8*)(cl + 32), ahP1 = *(const LAS bf16x8*)(cl + 48);
                    bf16x8 bkT[4];
#pragma unroll
                    for (int q = 0; q < 4; ++q) bkT[q] = *(const LAS bf16x8*)(cl + 64 + 16 * q);
                    const bf16x8 mrbk = *(const LAS bf16x8*)(cl + 128);
                    const bf16x4 makA = *(const LAS bf16x4*)(cl + 144), tA = *(const LAS bf16x4*)(cl + 152);
                    f32x4 GL[4];
#pragma unroll
                    for (int q = 0; q < 4; ++q) GL[q] = *(const LAS f32x4*)(cb + 12288 + (16 * g + 4 * q) * 4);
#pragma unroll
                    for (int vq = 0; vq < 4; ++vq) {
                        const bf16x4 vT4 = *(const LAS bf16x4*)(cl + 160 + 8 * vq);
                        const f32x4 X = MFMA4(makA, vT4, zero4);
                        f32x4 U = MFMA4(tA, pack4(X), zero4);
                        const bf16x8 s0 = pack_2(ST[vq][0], ST[vq][1]), s1 = pack_2(ST[vq][2], ST[vq][3]);
                        U = MFMA16(ahP0, s0, U); U = MFMA16(ahP1, s1, U);
                        const u32x2 uu = __builtin_bit_cast(u32x2, pack4(U)), vv = __builtin_bit_cast(u32x2, vT4);
                        const bf16x8 uv = __builtin_bit_cast(bf16x8, (u32x4){uu.x, uu.y, vv.x, vv.y});
                        f32x4 Y = MFMA16(rP0, s0, zero4); Y = MFMA16(rP1, s1, Y); Y = MFMA16(mrbk, uv, Y);
#pragma unroll
                        for (int e = 0; e < 4; ++e) ((__attribute__((address_space(1))) bf16_t*)Yb)[(size_t)SCAN_ROW(cc, 4 * g + e) * D + 64 * h + 16 * vq + x] = (bf16_t)f2bf(Y[e]);
#pragma unroll
                        for (int q = 0; q < 4; ++q) ST[vq][q] = MFMA16(bkT[q], uv, ST[vq][q]) * GL[q];
                    }
                }
            }
        }
        asm volatile("s_waitcnt vmcnt(0) lgkmcnt(0)" ::: "memory");
        __builtin_amdgcn_s_barrier();
#undef SCAN_ROW
#undef SCAN_DMA
    }
    __builtin_amdgcn_s_setprio(0);
}
#undef MFMA16
#undef MFMA4

__device__ __forceinline__ void rwkv_out_pass(Frame& F, CArgs& a, int ri, const bf16_t* Vsrc, const bf16_t* Y1buf, int nrows) {
    const int gw = F.bid * NWAVES + F.wave, NGW = F.G * NWAVES, lane = F.lane;
    const bf16_t* Y0 = WSP(bf16_t, WS_Y0); const bf16_t* Gb = WSP(bf16_t, WS_G); bf16_t* OUTB = WSP(bf16_t, WS_OUTB);
    const float* BON = WSP(float, WS_BONUS);
    f32x4 lw[4], lb[4];
#pragma unroll
    for (int j = 0; j < 4; ++j) { lw[j] = *(const f32x4*)(a.in[I_LNW] + ri * 1024 + 4 * lane + 256 * j); lb[j] = *(const f32x4*)(a.in[I_LNB] + ri * 1024 + 4 * lane + 256 * j); }
    for (int row = gw; row < nrows; row += NGW) {
        const size_t base = (size_t)row * D + 4 * lane;
        u32x2 y0v[4], y1v[4], vvv[4], ggv[4]; float bonv[4]; float ov[4][4]; float am = 0.f;
#pragma unroll
        for (int j = 0; j < 4; ++j) { y0v[j] = *(const u32x2*)(Y0 + base + 256 * j); y1v[j] = *(const u32x2*)(Y1buf + base + 256 * j); vvv[j] = *(const u32x2*)(Vsrc + base + 256 * j); ggv[j] = *(const u32x2*)(Gb + base + 256 * j);
            const int head = 4 * j + (lane >> 4); bonv[j] = BON[(size_t)row * 16 + head] + BON[(size_t)NR * 16 + (size_t)row * 16 + head]; }
#pragma unroll
        for (int j = 0; j < 4; ++j) {
            const u32x2 y0 = y0v[j], y1 = y1v[j], vv = vvv[j], gg = ggv[j];
            float y[4] = { bf2f(y0.x & 0xffffu) + bf2f(y1.x & 0xffffu), bf2f(y0.x >> 16) + bf2f(y1.x >> 16), bf2f(y0.y & 0xffffu) + bf2f(y1.y & 0xffffu), bf2f(y0.y >> 16) + bf2f(y1.y >> 16) };
            float s = (y[0] + y[1]) + (y[2] + y[3]);
            s = row16_sum(s);
            const float mu = s * (1.0f / 64.0f);
            float q = 0.f;
#pragma unroll
            for (int i = 0; i < 4; ++i) { y[i] -= mu; q += y[i] * y[i]; }
            q = row16_sum(q);
            const float rstd = 1.0f / sqrtf(q * (1.0f / 64.0f) + 64e-5f);
            const float bon = bonv[j];
            const float v4[4] = { bf2f(vv.x & 0xffffu), bf2f(vv.x >> 16), bf2f(vv.y & 0xffffu), bf2f(vv.y >> 16) };
            const float g4[4] = { bf2f(gg.x & 0xffffu), bf2f(gg.x >> 16), bf2f(gg.y & 0xffffu), bf2f(gg.y >> 16) };
#pragma unroll
            for (int i = 0; i < 4; ++i) { ov[j][i] = (y[i] * rstd * lw[j][i] + lb[j][i] + bon * v4[i]) * g4[i]; am = fmaxf(am, fabsf(ov[j][i])); }
        }
        am = wave_max(am); const float inv = am > 0.f ? 127.0f / am : 0.f;
        signed char* oq = (signed char*)OUTB + (size_t)row * D;
#pragma unroll
        for (int j = 0; j < 4; ++j) { unsigned o = 0u;
#pragma unroll
            for (int i = 0; i < 4; ++i) { const int qi = (int)__builtin_rintf(ov[j][i] * inv); o |= ((unsigned)qi & 255u) << (8 * i); }
            *(unsigned*)(oq + 4 * lane + 256 * j) = o; }
        if (lane == 0) WSP(float, WS_OUTSC)[row] = am * (1.0f / 127.0f);
    }
}

using pg8::Unit;
typedef const f32x4 (&AccRef)[2][2][4][2];
template <int NN, int LDA_, int LDB_> struct ProbBase { static constexpr int LDA = LDA_, LDB = LDB_; int G, c, nM; const char* gA; const char* gB;
    __device__ __forceinline__ bool next(int i, Unit& u) const { return pg8::tile_order(i, G, c, nM, NN, u); } };

struct ProbF2 : ProbBase<576, 256, D> {
    __device__ __forceinline__ unsigned a_off(const Unit& u) const { return (unsigned)u.pm * 256 * 256 * 2; }
    __device__ __forceinline__ unsigned b_off(const Unit& u) const {
        if (u.pn < 512) { const int b = u.pn >> 5, g = (u.pn >> 3) & 3, tt = u.pn & 7; return (unsigned)((b * TX + 256 * tt) * D + 256 * g) * 2u; }
        const int q = u.pn - 512, b = q >> 2, g = q & 3; return (unsigned)((NXR + b * TCX) * D + 256 * g) * 2u; }
    __device__ __forceinline__ int nt(const Unit&) const { return 4; } };
struct EpiF2 { static constexpr bool PERM = true; bf16_t* YT; bf16_t* YTC;
    __device__ __forceinline__ void operator()(AccRef acc, const Unit& u, int wr, int wc, int fr, int fq) const {
        bf16_t* base; int ld;
        if (u.pn < 512) { const int b = u.pn >> 5, g = (u.pn >> 3) & 3, tt = u.pn & 7; base = YT + ((size_t)(b * 1024 + 256 * g) * 2 + u.pm) * 2048 + 256 * tt; ld = 4096; }
        else { const int q = u.pn - 512, b = q >> 2, g = q & 3; base = YTC + ((size_t)(b * 1024 + 256 * g) * 2 + u.pm) * 256; ld = 512; }
        const int col0 = wc * 32 + 8 * fq;
#pragma unroll
        for (int ai = 0; ai < 2; ++ai)
#pragma unroll
            for (int m = 0; m < 4; ++m) { bf16_t* rowp = base + (size_t)(wr * 64 + fr + ai * 128 + m * 16) * ld + col0;
#pragma unroll
                for (int bj = 0; bj < 2; ++bj) pg8::st8(rowp + bj * 128, acc[ai][bj][m][0], acc[ai][bj][m][1]); }
    } };
struct ProbF3X : ProbBase<4, 4096, 4096> {
    __device__ __forceinline__ unsigned a_off(const Unit& u) const { return (unsigned)(u.pm & 7) * 256 * 4096 * 2; }
    __device__ __forceinline__ unsigned b_off(const Unit& u) const { return (unsigned)((u.pm >> 3) * 1024 + 256 * u.pn) * 4096u * 2u; }
    __device__ __forceinline__ int nt(const Unit&) const { return 64; } };
struct ProbF3H : ProbBase<4, 4096, 4096> {
    __device__ __forceinline__ bool next(int i, Unit& u) const { const int pair = (i >> 1) * G + c; if (pair >= 256) return false; u.pm = pair >> 2; u.pn = (pair & 3) | ((i & 1) << 2); return true; }
    __device__ __forceinline__ unsigned a_off(const Unit& u) const { return (unsigned)(u.pm & 3) * 256u * 4096u * 2u + ((u.pn & 4) ? 4096u : 0u); }
    __device__ __forceinline__ unsigned b_off(const Unit& u) const { return (unsigned)((u.pm >> 2) * 1024 + 256 * (u.pn & 3)) * 4096u * 2u + ((u.pn & 4) ? 4096u : 0u); }
    __device__ __forceinline__ int nt(const Unit&) const { return 32; } };
struct EpiF3H { static constexpr bool PERM = true; bf16_t* OUT; f32x4* scratch; int bid;
    __device__ __forceinline__ void operator()(AccRef acc, const Unit& u, int wr, int wc, int fr, int fq) const {
        int tid = (wr * 4 + wc) * 64 + fq * 16 + fr; asm volatile("" : "+v"(tid));
        u32x4* sp = (u32x4*)scratch + (size_t)bid * 16 * 512 + tid;
        if (!(u.pn & 4)) {
#pragma unroll
            for (int ai = 0; ai < 2; ++ai)
#pragma unroll
                for (int bj = 0; bj < 2; ++bj)
#pragma unroll
                    for (int m = 0; m < 4; ++m) { const f32x4 c0 = acc[ai][bj][m][0], c1 = acc[ai][bj][m][1];
                        u32x4 w; w.x = pg8::cvt_pk_bf16(c0[0], c0[1]); w.y = pg8::cvt_pk_bf16(c0[2], c0[3]); w.z = pg8::cvt_pk_bf16(c1[0], c1[1]); w.w = pg8::cvt_pk_bf16(c1[2], c1[3]);
                        sp[((ai * 2 + bj) * 4 + m) * 512] = w; }
            return;
        }
        asm volatile("s_waitcnt vmcnt(0)" ::: "memory");
        int fr2 = fr; asm volatile("" : "+v"(fr2));
        const int b = u.pm >> 2, kt = u.pm & 3, col0 = 256 * (u.pn & 3) + wc * 32 + 8 * fq;
#pragma unroll
        for (int ai = 0; ai < 2; ++ai)
#pragma unroll
            for (int m = 0; m < 4; ++m) { const int k = 256 * kt + wr * 64 + fr2 + ai * 128 + m * 16;
                bf16_t* r1 = OUT + (size_t)(b * TX + k) * D + col0; bf16_t* r2 = OUT + (size_t)(b * TX + ((TX - k) & (TX - 1))) * D + col0;
#pragma unroll
                for (int bj = 0; bj < 2; ++bj) { const u32x4 pw = sp[((ai * 2 + bj) * 4 + m) * 512];
                    const f32x4 p0 = (f32x4){bf2f(pw.x & 0xffffu), bf2f(pw.x >> 16), bf2f(pw.y & 0xffffu), bf2f(pw.y >> 16)}, p1 = (f32x4){bf2f(pw.z & 0xffffu), bf2f(pw.z >> 16), bf2f(pw.w & 0xffffu), bf2f(pw.w >> 16)};
                    pg8::st8(r1 + bj * 128, p0 + acc[ai][bj][m][0], p1 + acc[ai][bj][m][1]);
                    if (k > 0) pg8::st8(r2 + bj * 128, p0 - acc[ai][bj][m][0], p1 - acc[ai][bj][m][1]); }
                __builtin_amdgcn_sched_barrier(0); }
    } };
struct ProbF3C : ProbBase<4, 512, 512> {
    __device__ __forceinline__ unsigned a_off(const Unit&) const { return 0u; }
    __device__ __forceinline__ unsigned b_off(const Unit& u) const { return (unsigned)(u.pm * 1024 + 256 * u.pn) * 512u * 2u; }
    __device__ __forceinline__ int nt(const Unit&) const { return 8; } };
struct EpiRows { static constexpr bool PERM = true; bf16_t* OUT; int row0, ld;
    __device__ __forceinline__ void operator()(AccRef acc, const Unit& u, int wr, int wc, int fr, int fq) const {
        bf16_t* base = OUT + (size_t)(row0 + 256 * u.pm) * ld + 256 * u.pn; const int col0 = wc * 32 + 8 * fq;
#pragma unroll
        for (int ai = 0; ai < 2; ++ai)
#pragma unroll
            for (int m = 0; m < 4; ++m) { bf16_t* rowp = base + (size_t)(wr * 64 + fr + ai * 128 + m * 16) * ld + col0;
#pragma unroll
                for (int bj = 0; bj < 2; ++bj) pg8::st8(rowp + bj * 128, acc[ai][bj][m][0], acc[ai][bj][m][1]); }
    } };
template <int NN, int LDA_, int LDB_, int NT> struct ProbRM : ProbBase<NN, LDA_, LDB_> {
    __device__ __forceinline__ unsigned a_off(const Unit& u) const { return (unsigned)u.pm * 256u * LDA_ * 2u; }
    __device__ __forceinline__ unsigned b_off(const Unit& u) const { return (unsigned)u.pn * 256u * LDB_ * 2u; }
    __device__ __forceinline__ int nt(const Unit&) const { return NT; } };
struct ProbRG1A : ProbBase<12, D, 2048> {
    __device__ __forceinline__ unsigned a_off(const Unit& u) const { const int grp = u.pn >> 2; return (grp == 2 ? (unsigned)(WS_XV - WS_XR) : (unsigned)grp * (unsigned)(WS_XK - WS_XR)) + (unsigned)u.pm * 256u * D * 2u; }
    __device__ __forceinline__ unsigned b_off(const Unit& u) const { return (unsigned)u.pn * 256u * 2048u * 2u; }
    __device__ __forceinline__ int nt(const Unit&) const { return 16; } };
struct ProbRG1A8 : ProbBase<12, 512, 2048> {
    __device__ __forceinline__ unsigned a_off(const Unit& u) const { const int grp = u.pn >> 2; return (grp == 2 ? (unsigned)(WS_XV - WS_XR) : (unsigned)grp * (unsigned)(WS_XK - WS_XR)) + (unsigned)u.pm * 256u * 1024u; }
    __device__ __forceinline__ unsigned b_off(const Unit& u) const { return (unsigned)u.pn * 256u * 4096u; }
    __device__ __forceinline__ int nt(const Unit&) const { return 8; } };
struct EpiRG1A8 { static constexpr bool PERM = true; unsigned char* ws; size_t voff; const float* XSC; const float* WSC;
    __device__ __forceinline__ void operator()(const pg8::i32x4 (&acc)[2][2][4][2], const Unit& u, int wr, int wc, int fr, int fq) const {
        const int which = u.pn >> 2; const size_t off = (which == 2) ? voff : WS_R + (size_t)which * (WS_K - WS_R);
        bf16_t* base = (bf16_t*)(ws + off) + (size_t)u.pm * 256 * D + (u.pn & 3) * 256 + wc * 32 + 8 * fq;
        const float* wsp = WSC + u.pn * 256 + wc * 32 + 8 * fq;
        f32x4 sw[2][2];
#pragma unroll
        for (int bj = 0; bj < 2; ++bj)
#pragma unroll
            for (int n = 0; n < 2; ++n) sw[bj][n] = *(const f32x4*)(wsp + 128 * bj + 4 * n);
        float sxv[2][4];
#pragma unroll
        for (int ai = 0; ai < 2; ++ai)
#pragma unroll
            for (int m = 0; m < 4; ++m) sxv[ai][m] = XSC[(size_t)which * NR + (size_t)u.pm * 256 + wr * 64 + fr + ai * 128 + m * 16];
#pragma unroll
        for (int ai = 0; ai < 2; ++ai)
#pragma unroll
            for (int m = 0; m < 4; ++m) { const int r = wr * 64 + fr + ai * 128 + m * 16; const float sx = sxv[ai][m];
#pragma unroll
                for (int bj = 0; bj < 2; ++bj) { f32x4 v0, v1;
#pragma unroll
                    for (int i = 0; i < 4; ++i) { v0[i] = (float)acc[ai][bj][m][0][i] * (sx * sw[bj][0][i]); v1[i] = (float)acc[ai][bj][m][1][i] * (sx * sw[bj][1][i]); }
                    pg8::st8(base + (size_t)r * D + 128 * bj, v0, v1); } }
    } };
struct ProbRG1B : ProbBase<2, 2048, 2048> {
    __device__ __forceinline__ bool next(int i, Unit& u) const { if (!pg8::tile_order(i, G, c, nM, 2, u)) return false; u.pn += 12; return true; }
    __device__ __forceinline__ unsigned a_off(const Unit& u) const { return (unsigned)u.pm * 256u * 2048u * 2u; }
    __device__ __forceinline__ unsigned b_off(const Unit& u) const { return (unsigned)u.pn * 256u * 2048u * 2u; }
    __device__ __forceinline__ int nt(const Unit&) const { return 32; } };
struct ProbRG1B8 : ProbBase<2, 2048, 1024> {
    __device__ __forceinline__ bool next(int i, Unit& u) const { if (!pg8::tile_order(i, G, c, nM, 2, u)) return false; u.pn += 12; return true; }
    __device__ __forceinline__ unsigned a_off(const Unit& u) const { return (unsigned)u.pm * 256u * 4096u + 2048u; }
    __device__ __forceinline__ unsigned b_off(const Unit& u) const { return (unsigned)(u.pn - 12) * 256u * 2048u; }
    __device__ __forceinline__ int nt(const Unit&) const { return 16; } };
struct EpiRG1B8 { static constexpr bool PERM = true; unsigned char* ws; const float* XSC; const float* WSC;
    __device__ __forceinline__ void operator()(const pg8::i32x4 (&acc)[2][2][4][2], const Unit& u, int wr, int wc, int fr, int fq) const {
        bf16_t* base = (bf16_t*)(ws + WS_A23) + (size_t)u.pm * 256 * 512 + (u.pn - 12) * 256; const int act = u.pn - 11;
        const int col0 = wc * 32 + 8 * fq;
        const float* wsp = WSC + (u.pn - 12) * 256 + col0;
        f32x4 sw[2][2];
#pragma unroll
        for (int bj = 0; bj < 2; ++bj)
#pragma unroll
            for (int n = 0; n < 2; ++n) sw[bj][n] = *(const f32x4*)(wsp + 128 * bj + 4 * n);
        float sxv[2][4];
#pragma unroll
        for (int ai = 0; ai < 2; ++ai)
#pragma unroll
            for (int m = 0; m < 4; ++m) sxv[ai][m] = XSC[(size_t)u.pm * 256 + wr * 64 + fr + ai * 128 + m * 16];
#pragma unroll
        for (int ai = 0; ai < 2; ++ai)
#pragma unroll
            for (int m = 0; m < 4; ++m) { bf16_t* rowp = base + (size_t)(wr * 64 + fr + ai * 128 + m * 16) * 512 + col0; const float sx = sxv[ai][m];
                f32x4 v0, v1, u0, u1;
#pragma unroll
                for (int i = 0; i < 4; ++i) { v0[i] = (float)acc[ai][0][m][0][i] * (sx * sw[0][0][i]); v1[i] = (float)acc[ai][0][m][1][i] * (sx * sw[0][1][i]);
                    u0[i] = (float)acc[ai][1][m][0][i] * (sx * sw[1][0][i]); u1[i] = (float)acc[ai][1][m][1][i] * (sx * sw[1][1][i]); }
                if (act == 1) {
#pragma unroll
                    for (int i = 0; i < 4; ++i) { v0[i] = tanhf_(v0[i]); v1[i] = tanhf_(v1[i]); } }
                else {
#pragma unroll
                    for (int i = 0; i < 4; ++i) { v0[i] = sigmoidf_(v0[i]); v1[i] = sigmoidf_(v1[i]); } }
                pg8::st8(rowp, v0, v1);
                pg8::st8(rowp + 128, u0, u1); }
    } };
struct EpiWO { static constexpr bool PERM = true; bf16_t* DELTA; const float* mod; const float* bias;
    __device__ __forceinline__ void operator()(AccRef acc, const Unit& u, int wr, int wc, int fr, int fq) const {
        const int b = u.pm < 128 ? (u.pm >> 3) : 16;
        const int col0 = u.pn * 256 + wc * 32 + 8 * fq; const float* gate = mod + (size_t)b * 6144 + 2 * 1024;
        f32x4 gv[2][2], bv[2][2];
#pragma unroll
        for (int bj = 0; bj < 2; ++bj)
#pragma unroll
            for (int n = 0; n < 2; ++n) { gv[bj][n] = *(const f32x4*)(gate + col0 + bj * 128 + 4 * n); bv[bj][n] = *(const f32x4*)(bias + col0 + bj * 128 + 4 * n); }
#pragma unroll
        for (int ai = 0; ai < 2; ++ai)
#pragma unroll
            for (int m = 0; m < 4; ++m) { bf16_t* rowp = DELTA + (size_t)(u.pm * 256 + wr * 64 + fr + ai * 128 + m * 16) * D + col0;
#pragma unroll
                for (int bj = 0; bj < 2; ++bj) pg8::st8(rowp + bj * 128, gv[bj][0] * (acc[ai][bj][m][0] + bv[bj][0]), gv[bj][1] * (acc[ai][bj][m][1] + bv[bj][1])); }
    } };
struct ProbWO8 : ProbBase<4, 512, 512> {
    __device__ __forceinline__ unsigned a_off(const Unit& u) const { return (unsigned)u.pm * 256u * 1024u; }
    __device__ __forceinline__ unsigned b_off(const Unit& u) const { return (unsigned)u.pn * 256u * 1024u; }
    __device__ __forceinline__ int nt(const Unit&) const { return 8; } };
struct EpiWO8 { static constexpr bool PERM = true; bf16_t* DELTA; const float* mod; const float* bias; const float* XSC; const float* WSC;
    __device__ __forceinline__ void operator()(const pg8::i32x4 (&acc)[2][2][4][2], const Unit& u, int wr, int wc, int fr, int fq) const {
        const int b = u.pm < 128 ? (u.pm >> 3) : 16;
        const int col0 = u.pn * 256 + wc * 32 + 8 * fq; const float* gate = mod + (size_t)b * 6144 + 2 * 1024;
        f32x4 gs[2][2], gb[2][2];
#pragma unroll
        for (int bj = 0; bj < 2; ++bj)
#pragma unroll
            for (int n = 0; n < 2; ++n) { const f32x4 g = *(const f32x4*)(gate + col0 + bj * 128 + 4 * n); gs[bj][n] = g * *(const f32x4*)(WSC + col0 + bj * 128 + 4 * n); gb[bj][n] = g * *(const f32x4*)(bias + col0 + bj * 128 + 4 * n); }
        float sxv[2][4];
#pragma unroll
        for (int ai = 0; ai < 2; ++ai)
#pragma unroll
            for (int m = 0; m < 4; ++m) sxv[ai][m] = XSC[(size_t)u.pm * 256 + wr * 64 + fr + ai * 128 + m * 16];
#pragma unroll
        for (int ai = 0; ai < 2; ++ai)
#pragma unroll
            for (int m = 0; m < 4; ++m) { bf16_t* rowp = DELTA + (size_t)(u.pm * 256 + wr * 64 + fr + ai * 128 + m * 16) * D + col0; const float sx = sxv[ai][m];
#pragma unroll
                for (int bj = 0; bj < 2; ++bj) { f32x4 v0, v1;
#pragma unroll
                    for (int i = 0; i < 4; ++i) { v0[i] = (float)acc[ai][bj][m][0][i] * (sx * gs[bj][0][i]) + gb[bj][0][i]; v1[i] = (float)acc[ai][bj][m][1][i] * (sx * gs[bj][1][i]) + gb[bj][1][i]; }
                    pg8::st8(rowp + bj * 128, v0, v1); } }
    } };
struct EpiRG1 { static constexpr bool PERM = true; unsigned char* ws; size_t voff;
    __device__ __forceinline__ void operator()(AccRef acc, const Unit& u, int wr, int wc, int fr, int fq) const {
        bf16_t* base; int ld; int act = 0;
        if (u.pn < 12) { const int which = u.pn >> 2; const size_t off = (which == 2) ? voff : WS_R + (size_t)which * (WS_K - WS_R);
            base = (bf16_t*)(ws + off) + (size_t)u.pm * 256 * D + (u.pn & 3) * 256; ld = D; }
        else { base = (bf16_t*)(ws + WS_A23) + (size_t)u.pm * 256 * 512 + (u.pn - 12) * 256; ld = 512; act = u.pn - 11; }
        const int col0 = wc * 32 + 8 * fq;
#pragma unroll
        for (int ai = 0; ai < 2; ++ai)
#pragma unroll
            for (int m = 0; m < 4; ++m) { bf16_t* rowp = base + (size_t)(wr * 64 + fr + ai * 128 + m * 16) * ld + col0;
                f32x4 v0 = acc[ai][0][m][0], v1 = acc[ai][0][m][1];
                if (act == 1) {
#pragma unroll
                    for (int i = 0; i < 4; ++i) { v0[i] = tanhf_(v0[i]); v1[i] = tanhf_(v1[i]); } }
                else if (act == 2) {
#pragma unroll
                    for (int i = 0; i < 4; ++i) { v0[i] = sigmoidf_(v0[i]); v1[i] = sigmoidf_(v1[i]); } }
                pg8::st8(rowp, v0, v1);
                pg8::st8(rowp + 128, acc[ai][1][m][0], acc[ai][1][m][1]); }
    } };
struct ProbRG2 : ProbBase<24, 512, 256> { int nn;
    __device__ __forceinline__ bool next(int i, Unit& u) const { return pg8::tile_order(i, G, c, nM, nn, u); }
    __device__ __forceinline__ unsigned a_off(const Unit& u) const { return ((unsigned)u.pm * 256u * 512u + (u.pn >= 16 ? 256u : 0u)) * 2u; }
    __device__ __forceinline__ unsigned b_off(const Unit& u) const { return (unsigned)u.pn * 256u * 256u * 2u; }
    __device__ __forceinline__ int nt(const Unit&) const { return 4; } };
struct EpiRG2 { static constexpr bool PERM = true; unsigned char* ws; const float *w0, *a0, *v0;
    __device__ __forceinline__ void operator()(AccRef acc, const Unit& u, int wr, int wc, int fr, int fq) const {
        const int grp = u.pn >> 2, colb = (u.pn & 3) * 256;
        size_t doff = WS_W0; if (grp == 1) doff = WS_W1; if (grp == 2) doff = WS_A0; if (grp == 3) doff = WS_A1; if (grp == 4) doff = WS_G; if (grp == 5) doff = WS_VB;
        bf16_t* dst = (bf16_t*)(ws + doff); bf16_t* Vb = (bf16_t*)(ws + WS_VB); const bf16_t* VF = (const bf16_t*)(ws + WS_VFIRST);
        const float* bias = w0 + grp * 1024; if (grp >= 2) bias = a0 + (grp - 2) * 1024; if (grp >= 4) bias = v0;
        const int col0 = colb + wc * 32 + 8 * fq;
        f32x4 bv[2][2];
#pragma unroll
        for (int bj = 0; bj < 2; ++bj)
#pragma unroll
            for (int n = 0; n < 2; ++n) bv[bj][n] = (grp == 4) ? (f32x4){0.f, 0.f, 0.f, 0.f} : *(const f32x4*)(bias + col0 + bj * 128 + 4 * n);
#pragma unroll
        for (int ai = 0; ai < 2; ++ai)
#pragma unroll
            for (int m = 0; m < 4; ++m) { const size_t ro = (size_t)(u.pm * 256 + wr * 64 + fr + ai * 128 + m * 16) * D + col0;
#pragma unroll
                for (int bj = 0; bj < 2; ++bj) {
                    f32x4 v0v = acc[ai][bj][m][0] + bv[bj][0], v1v = acc[ai][bj][m][1] + bv[bj][1];
                    if (grp < 2) {
#pragma unroll
                        for (int i = 0; i < 4; ++i) { v0v[i] = -0.60653066f * sigmoidf_(v0v[i]); v1v[i] = -0.60653066f * sigmoidf_(v1v[i]); } }
                    else if (grp < 4) {
#pragma unroll
                        for (int i = 0; i < 4; ++i) { v0v[i] = sigmoidf_(v0v[i]); v1v[i] = sigmoidf_(v1v[i]); } }
                    else if (grp == 5) {
                        const u32x4 vp = *(const u32x4*)(Vb + ro + bj * 128), vf = *(const u32x4*)(VF + ro + bj * 128);
                        const unsigned vpw[4] = {vp.x, vp.y, vp.z, vp.w}, vfw[4] = {vf.x, vf.y, vf.z, vf.w};
                        float pv[8], fv[8];
#pragma unroll
                        for (int i = 0; i < 4; ++i) { pv[2 * i] = bf2f(vpw[i] & 0xffffu); pv[2 * i + 1] = bf2f(vpw[i] >> 16); fv[2 * i] = bf2f(vfw[i] & 0xffffu); fv[2 * i + 1] = bf2f(vfw[i] >> 16); }
#pragma unroll
                        for (int i = 0; i < 4; ++i) { v0v[i] = pv[i] + (fv[i] - pv[i]) * sigmoidf_(v0v[i]); v1v[i] = pv[4 + i] + (fv[4 + i] - pv[4 + i]) * sigmoidf_(v1v[i]); } }
                    pg8::st8(dst + ro + bj * 128, v0v, v1v);
                } }
    } };
__device__ __forceinline__ void lora2_phase(Frame& F, const ProbRG2& P, const EpiRG2& E) {
    const int wid = F.wave, lane = F.lane, wr = wid >> 2, wc = wid & 3, fr = lane & 15, fq = lane >> 4;
    const bf16_t* A23 = (const bf16_t*)P.gA; const bf16_t* W2 = (const bf16_t*)P.gB;
    Unit u;
    for (int i = 0; P.next(i, u); ++i) {
        const int grp = u.pn >> 2;
        const int acol0 = grp < 4 ? 64 * grp : (grp == 4 ? 256 : 384), bcol0 = grp < 4 ? 64 * grp : (grp == 4 ? 0 : 128), K = grp < 4 ? 64 : (grp == 4 ? 128 : 32);
        f32x4 acc[2][2][4][2];
#pragma unroll
        for (int a = 0; a < 2; ++a)
#pragma unroll
            for (int b = 0; b < 2; ++b)
#pragma unroll
                for (int m = 0; m < 4; ++m)
#pragma unroll
                    for (int n = 0; n < 2; ++n) acc[a][b][m][n] = (f32x4){0.f, 0.f, 0.f, 0.f};
        const bf16_t* arow = A23 + (size_t)(u.pm * 256 + wr * 64 + fr) * 512 + acol0 + 8 * fq;
        const bf16_t* brow[2][2];
#pragma unroll
        for (int bj = 0; bj < 2; ++bj)
#pragma unroll
            for (int n = 0; n < 2; ++n) { const int rho = 128 * bj + 32 * wc + 16 * n + fr; brow[bj][n] = W2 + (size_t)(u.pn * 256 + (rho & ~31) + pg8::perm32(rho & 31)) * 256 + bcol0 + 8 * fq; }
#pragma unroll 1
        for (int k0 = 0; k0 < K; k0 += 64) {
            const bool two = (K - k0) >= 64;
            bf16x8 Bf[2][2][2];
#pragma unroll
            for (int bj = 0; bj < 2; ++bj)
#pragma unroll
                for (int n = 0; n < 2; ++n) { Bf[bj][n][0] = *(const bf16x8*)(brow[bj][n] + k0); Bf[bj][n][1] = two ? *(const bf16x8*)(brow[bj][n] + k0 + 32) : (bf16x8){0, 0, 0, 0, 0, 0, 0, 0}; }
#pragma unroll
            for (int ai = 0; ai < 2; ++ai) {
                bf16x8 Af[4][2];
#pragma unroll
                for (int m = 0; m < 4; ++m) { const bf16_t* ap = arow + (size_t)(128 * ai + 16 * m) * 512 + k0; Af[m][0] = *(const bf16x8*)ap; Af[m][1] = two ? *(const bf16x8*)(ap + 32) : (bf16x8){0, 0, 0, 0, 0, 0, 0, 0}; }
#pragma unroll
                for (int bj = 0; bj < 2; ++bj)
#pragma unroll
                    for (int m = 0; m < 4; ++m)
#pragma unroll
                        for (int n = 0; n < 2; ++n) {
                            acc[ai][bj][m][n] = __builtin_amdgcn_mfma_f32_16x16x32_bf16(Bf[bj][n][0], Af[m][0], acc[ai][bj][m][n], 0, 0, 0);
                            acc[ai][bj][m][n] = __builtin_amdgcn_mfma_f32_16x16x32_bf16(Bf[bj][n][1], Af[m][1], acc[ai][bj][m][n], 0, 0, 0);
                        }
            }
        }
        E(acc, u, wr, wc, fr, fq);
    }
}
template <int NN, int ROWS_PER_E> struct ProbMoE : ProbBase<NN, D, D> {
    __device__ __forceinline__ bool next(int i, Unit& u) const { if (!pg8::tile_order(i, this->G, this->c, this->nM, NN, u)) return false;
        if (this->nM == NS / 256) { const int e = u.pm / 18, r = u.pm % 18; u.pm = r < 16 ? r * 16 + e : 256 + 2 * e + (r - 16); } else { const int e = u.pm >> 4, r = u.pm & 15; u.pm = r * 16 + e; }
        return true; }
    __device__ __forceinline__ unsigned a_off(const Unit& u) const { return (unsigned)u.pm * 256u * D * 2u; }
    __device__ __forceinline__ unsigned b_off(const Unit& u) const { const int e = u.pm < 256 ? (u.pm & 15) : ((u.pm - 256) >> 1); return (unsigned)(e * ROWS_PER_E + 256 * u.pn) * D * 2u; }
    __device__ __forceinline__ int nt(const Unit&) const { return 16; } };
template <int NN> struct ProbMoE8 : ProbBase<NN, 512, 512> {
    __device__ __forceinline__ bool next(int i, Unit& u) const { if (!pg8::tile_order(i, this->G, this->c, this->nM, NN, u)) return false;
        if (this->nM == NS / 256) { const int e = u.pm / 18, r = u.pm % 18; u.pm = r < 16 ? r * 16 + e : 256 + 2 * e + (r - 16); } else { const int e = u.pm >> 4, r = u.pm & 15; u.pm = r * 16 + e; }
        return true; }
    __device__ __forceinline__ unsigned a_off(const Unit& u) const { return (unsigned)u.pm * 256u * 1024u; }
    __device__ __forceinline__ unsigned b_off(const Unit& u) const { const int e = u.pm < 256 ? (u.pm & 15) : ((u.pm - 256) >> 1); return (unsigned)(e * 2048 + 256 * u.pn) * 1024u; }
    __device__ __forceinline__ int nt(const Unit&) const { return 8; } };
struct EpiGU8 { static constexpr bool PERM = true; bf16_t* HID; const float* XSC; const float* WSC;
    __device__ __forceinline__ void operator()(const pg8::i32x4 (&acc)[2][2][4][2], const Unit& u, int wr, int wc, int fr, int fq) const {
        const int e = u.pm < 256 ? (u.pm & 15) : ((u.pm - 256) >> 1);
        const float* wsp = WSC + e * 2048 + 256 * u.pn + wc * 32 + 8 * fq;
        const f32x4 sg0 = *(const f32x4*)(wsp), sg1 = *(const f32x4*)(wsp + 4), su0 = *(const f32x4*)(wsp + 128), su1 = *(const f32x4*)(wsp + 132);
        bf16_t* base = HID + (size_t)u.pm * 256 * D + 128 * u.pn + wc * 32 + 8 * fq;
        float sxv[2][4];
#pragma unroll
        for (int ai = 0; ai < 2; ++ai)
#pragma unroll
            for (int m = 0; m < 4; ++m) sxv[ai][m] = XSC[(size_t)u.pm * 256 + wr * 64 + fr + ai * 128 + m * 16];
#pragma unroll
        for (int ai = 0; ai < 2; ++ai)
#pragma unroll
            for (int m = 0; m < 4; ++m) { const int r = wr * 64 + fr + ai * 128 + m * 16; const float sx = sxv[ai][m]; f32x4 h0, h1;
#pragma unroll
                for (int i = 0; i < 4; ++i) { const float g0 = (float)acc[ai][0][m][0][i] * (sx * sg0[i]), g1 = (float)acc[ai][0][m][1][i] * (sx * sg1[i]);
                    h0[i] = g0 * sigmoidf_(g0) * ((float)acc[ai][1][m][0][i] * (sx * su0[i])); h1[i] = g1 * sigmoidf_(g1) * ((float)acc[ai][1][m][1][i] * (sx * su1[i])); }
                pg8::st8(base + (size_t)r * D, h0, h1); }
    } };
struct EpiGU { static constexpr bool PERM = true; bf16_t* HID;
    __device__ __forceinline__ void operator()(AccRef acc, const Unit& u, int wr, int wc, int fr, int fq) const {
        bf16_t* base = HID + (size_t)u.pm * 256 * D + 128 * u.pn + wc * 32 + 8 * fq;
#pragma unroll
        for (int ai = 0; ai < 2; ++ai)
#pragma unroll
            for (int m = 0; m < 4; ++m) { f32x4 h0, h1;
#pragma unroll
                for (int i = 0; i < 4; ++i) { const float g0 = acc[ai][0][m][0][i], g1 = acc[ai][0][m][1][i]; h0[i] = g0 * sigmoidf_(g0) * acc[ai][1][m][0][i]; h1[i] = g1 * sigmoidf_(g1) * acc[ai][1][m][1][i]; }
                pg8::st8(base + (size_t)(wr * 64 + fr + ai * 128 + m * 16) * D, h0, h1); }
    } };
struct EpiDN { static constexpr bool PERM = true; bf16_t* YS; const float* GATE;
    __device__ __forceinline__ void operator()(AccRef acc, const Unit& u, int wr, int wc, int fr, int fq) const {
        const int col0 = 256 * u.pn + wc * 32 + 8 * fq;
#pragma unroll
        for (int ai = 0; ai < 2; ++ai)
#pragma unroll
            for (int m = 0; m < 4; ++m) { const size_t row = (size_t)u.pm * 256 + wr * 64 + fr + ai * 128 + m * 16;
#pragma unroll
                for (int bj = 0; bj < 2; ++bj) pg8::st8(YS + row * D + col0 + bj * 128, acc[ai][bj][m][0], acc[ai][bj][m][1]); }
    } };

__device__ __forceinline__ void f3_nyquist_row(Frame& F) {
    const int skip = (F.G == 256) ? 64 : 0;
    if (F.bid < skip) return;
    const int gw = (F.bid - skip) * NWAVES + F.wave, NGW = (F.G - skip) * NWAVES, lane = F.lane;
    const bf16_t* YT = WSP(bf16_t, WS_YT); bf16_t* OUT = WSP(bf16_t, WS_OUTB);
    for (int task0 = gw; task0 < NB * D; task0 += 4 * NGW) {
        u32x4 w[4][4];
#pragma unroll
        for (int q = 0; q < 4; ++q) { const int task = (task0 + q * NGW < NB * D) ? task0 + q * NGW : task0;
            const u32x4* yp = (const u32x4*)(YT + (size_t)task * 4096);
#pragma unroll
            for (int j = 0; j < 4; ++j) w[q][j] = yp[lane + 64 * j]; }
#pragma unroll
        for (int q = 0; q < 4; ++q) { const int task = task0 + q * NGW;
            float se = 0.f, so = 0.f;
#pragma unroll
            for (int j = 0; j < 4; ++j) { const u32x4 ww = w[q][j];
                se += (bf2f(ww.x & 0xffffu) + bf2f(ww.y & 0xffffu)) + (bf2f(ww.z & 0xffffu) + bf2f(ww.w & 0xffffu));
                so += (bf2f(ww.x >> 16) + bf2f(ww.y >> 16)) + (bf2f(ww.z >> 16) + bf2f(ww.w >> 16)); }
            const float tot = wave_sum(se - so) * 0.022097087f;
            if (lane == 0 && task < NB * D) OUT[(size_t)((task >> 10) * TX + TX / 2) * D + (task & 1023)] = (bf16_t)f2bf(tot); }
    }
}

constexpr int STEPS_PER_LAYER = 11, STEP_FINAL = 1 + 4 * STEPS_PER_LAYER, NSTEPS = STEP_FINAL + 1;
#ifndef SCAN_IMPL
#define SCAN_IMPL 1
#endif
#define SCAN_FN scan_pipe
#ifndef PH_MASK
#define PH_MASK 0xFFFFFFFFu
#endif
#define EN(k) (((PH_MASK) >> (k)) & 1u)
#ifndef PROBE_DUP
#define PROBE_DUP -1
#endif
#define REP(k) _Pragma("unroll 1") for (int _rep = 0; _rep < ((PROBE_DUP) == (k) ? 2 : 1); ++_rep)

__device__ __forceinline__ bool relaunder(Frame& F) { unsigned long long v = (unsigned long long)F.ws; asm volatile("" : "+s"(v)); F.ws = (unsigned char*)(__attribute__((address_space(1))) unsigned char*)v;
    int w = F.wave; asm volatile("" : "+s"(w)); F.wave = w;
    int ln = (int)__builtin_amdgcn_mbcnt_hi(~0u, __builtin_amdgcn_mbcnt_lo(~0u, 0u)); asm volatile("" : "+v"(ln)); F.lane = ln; F.tid = w * 64 + ln; return true; }
__device__ __forceinline__ void grid_sync(unsigned char* ws, LAS unsigned char* lds) {
    XcdBarrier bar; bar.bar = (unsigned*)(ws + WS_CTL); bar.x = xb_xcc_id(); bar.st = (volatile LAS unsigned*)(lds + MISC_OFF);
    xcd_barrier(bar);
}

__global__ void __launch_bounds__(NTHR, 2) fwd(Args a_unused) {
    extern __shared__ __attribute__((aligned(16))) unsigned char lds_raw[];
    Frame F;
    F.lds = (LAS unsigned char*)lds_raw;
    F.tid = threadIdx.x; F.lane = F.tid & 63; F.wave = __builtin_amdgcn_readfirstlane(F.tid >> 6);
    CArgs* ap0 = (CArgs*)__builtin_amdgcn_kernarg_segment_ptr();
    F.G = gridDim.x; F.bid = blockIdx.x; F.ws = ap0->ws;
    const int lo = ap0->ph_lo, hi = ap0->ph_hi;
#define a (*launder_args(ap0))
    if (hi - lo > 1) {
        volatile LAS unsigned* MISC = (volatile LAS unsigned*)(F.lds + MISC_OFF);
        if (F.tid < 4) MISC[F.tid] = 0u;
        __syncthreads();
        (void)xcd_barrier_post((unsigned*)(F.ws + WS_CTL), MISC);
    }
#define IN(s) ((lo <= (s) && (s) < hi) && relaunder(F))
#define END(s) do { if (hi > (s) + 1) grid_sync(F.ws, F.lds); } while (0)
#define PINIT(P, nm, abase, bbase) do { P.G = F.G; P.c = F.bid; P.nM = (nm); P.gA = (const char*)(F.ws + (abase)); P.gB = (const char*)(F.ws + (bbase)); } while (0)

    if (EN(0) && IN(0)) { REP(0) p0_prologue(F, a); END(0); }

#pragma unroll 1
    for (int l = 0; l < 4; ++l) {
        const int s0 = 1 + l * STEPS_PER_LAYER;
        if (EN(1) && IN(s0 + 0)) {
            if (l & 1) row_pass<1>(F, a, l, true, NR); else row_pass<0>(F, a, l, l > 0, NR);
            END(s0 + 0);
        }
        if (!(l & 1)) {
            if (EN(2) && IN(s0 + 1)) {
                ProbF2 P; PINIT(P, 2, WS_CH, WS_HB);
                EpiF2 E; E.YT = WSP(bf16_t, WS_YT); E.YTC = WSP(bf16_t, WS_YTC);
                REP(2) pg8::gemm_phase(F.lds, F.tid, P, E);
                END(s0 + 1);
            }
            if (EN(3) && IN(s0 + 2)) {
                { ProbF3H P; PINIT(P, 64, WS_SEQX, WS_YT);
                  EpiF3H E; E.OUT = WSP(bf16_t, WS_OUTB); E.scratch = WSP(f32x4, WS_END); E.bid = F.bid;
                  pg8::gemm_phase(F.lds, F.tid, P, E);
                  f3_nyquist_row(F); }
                { ProbF3C P; PINIT(P, 16, WS_SEQC, WS_YTC);
                  EpiRows E; E.OUT = WSP(bf16_t, WS_OUTB); E.row0 = NXR; E.ld = D;
                  pg8::gemm_phase(F.lds, F.tid, P, E); }
                END(s0 + 2);
            }
        } else {
            if (EN(4) && IN(s0 + 1)) { shift_pass(F, a, l >> 1); END(s0 + 1); }
            if (EN(5) && IN(s0 + 2)) {
                EpiRG1 E; E.ws = F.ws; E.voff = (l == 1) ? WS_VFIRST : WS_VB;
                { ProbRG1B8 P; PINIT(P, NR / 256, WS_HB2, WS_WL8 + (size_t)(l >> 1) * 512 * 2048);
                  EpiRG1B8 EB; EB.ws = F.ws; EB.XSC = WSP(float, WS_HXS); EB.WSC = WSP(float, WS_WL8S) + (l >> 1) * 512;
                  pg8::gemm_phase<ProbRG1B8, EpiRG1B8, true>(F.lds, F.tid, P, EB); }
                { ProbRG1A8 P; PINIT(P, NR / 256, WS_XR, WS_WCAT + (size_t)(l >> 1) * 3584 * 2048 * 2); P.c = (F.bid + 192) & 255; if (F.G != 256) P.c = F.bid;
                  EpiRG1A8 E8; E8.ws = F.ws; E8.voff = (l == 1) ? WS_VFIRST : WS_VB; E8.XSC = WSP(float, WS_RKVXS); E8.WSC = WSP(float, WS_RKVWS) + (l >> 1) * 3072;
                  pg8::gemm_phase<ProbRG1A8, EpiRG1A8, true>(F.lds, F.tid, P, E8); }
                END(s0 + 2);
            }
            if (EN(6) && IN(s0 + 3)) {
                const int ri = l >> 1;
                ProbRG2 P; PINIT(P, NR / 256, WS_A23, WS_W2CAT + (size_t)ri * 6144 * 256 * 2); P.nn = (l == 1) ? 20 : 24;
                EpiRG2 E; E.ws = F.ws; E.w0 = a.in[I_W0] + ri * 2048; E.a0 = a.in[I_A0] + ri * 2048; E.v0 = a.in[I_V0];
                lora2_phase(F, P, E);
                END(s0 + 3);
            }
            if (EN(7) && IN(s0 + 4)) { REP(7) SCAN_FN(F, a, l >> 1, (l == 1) ? WSP(bf16_t, WS_VFIRST) : WSP(bf16_t, WS_VB), (l == 1) ? WSP(bf16_t, WS_VB) : WSP(bf16_t, WS_VFIRST)); END(s0 + 4); }
            if (EN(8) && IN(s0 + 5)) { rwkv_out_pass(F, a, l >> 1, (l == 1) ? WSP(bf16_t, WS_VFIRST) : WSP(bf16_t, WS_VB), (l == 1) ? WSP(bf16_t, WS_VB) : WSP(bf16_t, WS_VFIRST), (l < 3) ? NR : NXR); END(s0 + 5); }
        }
        if (EN(9) && IN(s0 + 6)) {
            ProbRM<4, D, D, 16> P; PINIT(P, (l < 3) ? NR / 256 : NXR / 256, WS_OUTB, WS_WOT + (size_t)l * D * D * 2);
            EpiWO E; E.DELTA = WSP(bf16_t, WS_DELTA); E.mod = WSP(float, WS_MOD) + (size_t)l * 17 * 6144; E.bias = WSP(float, WS_WOB) + l * 1024;
            if (l & 1) {
                ProbWO8 P8; PINIT(P8, (l < 3) ? NR / 256 : NXR / 256, WS_OUTB, WS_WO8 + (size_t)(l >> 1) * 1048576);
                EpiWO8 E8; E8.DELTA = E.DELTA; E8.mod = E.mod; E8.bias = E.bias; E8.XSC = WSP(float, WS_OUTSC); E8.WSC = WSP(float, WS_WO8S) + (l >> 1) * 1024;
                if (F.bid & 1) { moe_weight_conv(F, a, l, (l < 3) ? 576 : 512); __syncthreads(); pg8::gemm_phase<ProbWO8, EpiWO8, true>(F.lds, F.tid, P8, E8); }
                else { pg8::gemm_phase<ProbWO8, EpiWO8, true>(F.lds, F.tid, P8, E8); moe_weight_conv(F, a, l, (l < 3) ? 576 : 512); }
            } else {
            if (F.bid & 1) { moe_weight_conv(F, a, l, (l < 3) ? 576 : 512); __syncthreads(); pg8::gemm_phase(F.lds, F.tid, P, E); }
            else { pg8::gemm_phase(F.lds, F.tid, P, E); moe_weight_conv(F, a, l, (l < 3) ? 576 : 512); }
            }
            END(s0 + 6);
        }
        if (EN(10) && IN(s0 + 7)) { row_pass<2>(F, a, l, false, (l < 3) ? NR : NXR); END(s0 + 7); }
        if (EN(11) && IN(s0 + 8)) { REP(11) topk_phase(F, l < 3); END(s0 + 8); }
        if (EN(12) && IN(s0 + 9)) {
            ProbMoE8<8> P; PINIT(P, (l < 3) ? NS / 256 : NSX / 256, WS_XS, WS_MOEW_GU);
            EpiGU8 E; E.HID = WSP(bf16_t, WS_HID); E.XSC = WSP(float, WS_XSCALE); E.WSC = WSP(float, WS_WSCALE);
            pg8::gemm_phase<ProbMoE8<8>, EpiGU8, true>(F.lds, F.tid, P, E);
            END(s0 + 9);
        }
        if (EN(13) && IN(s0 + 10)) {
            ProbMoE<4, 1024> P; PINIT(P, (l < 3) ? NS / 256 : NSX / 256, WS_HID, WS_MOEW_DN);
            EpiDN E; E.YS = WSP(bf16_t, WS_YS); E.GATE = WSP(float, WS_GATE);
            REP(13) pg8::gemm_phase(F.lds, F.tid, P, E);
            END(s0 + 10);
        }
    }
    if (EN(14) && IN(STEP_FINAL)) { row_pass<3>(F, a, 3, true, NXR); }
#undef IN
#undef END
#undef PINIT
#undef a
}

extern "C" void kernel_launch(void* const* d_in, const int* in_sizes, int n_in, void* d_out, int out_size, void* d_ws, size_t ws_size, hipStream_t stream) {
    static int grid = 0;
    if (grid == 0) {
        if (n_in != 35 || out_size != NXR * D || ws_size < WS_TOTAL) { fprintf(stderr, "kernel_launch: unexpected shapes (n_in %d out %d ws %zu need %zu)\n", n_in, out_size, ws_size, (size_t)WS_TOTAL); grid = -1; return; }
        int dev = 0, cus = 0, per_cu = 0;
        if (hipGetDevice(&dev) != hipSuccess || hipDeviceGetAttribute(&cus, hipDeviceAttributeMultiprocessorCount, dev) != hipSuccess) { grid = -1; return; }
        if (hipFuncSetAttribute((const void*)fwd, hipFuncAttributeMaxDynamicSharedMemorySize, LDS_BYTES) != hipSuccess) { fprintf(stderr, "kernel_launch: hipFuncSetAttribute failed\n"); grid = -1; return; }
        if (hipOccupancyMaxActiveBlocksPerMultiprocessor(&per_cu, (const void*)fwd, NTHR, LDS_BYTES) != hipSuccess || per_cu < 1) fprintf(stderr, "kernel_launch: occupancy query says %d\n", per_cu);
        (void)hipGetLastError();
        grid = cus > 0 ? cus : 256;
    }
    if (grid < 0) return;
    if (hipMemsetAsync((char*)d_ws + WS_CTL, 0, WS_ZERO_BYTES, stream) != hipSuccess) return;
    Args a{};
    for (int i = 0; i < 35; ++i) a.in[i] = (const float*)d_in[i];
    a.out = (float*)d_out; a.ws = (unsigned char*)d_ws;
#if MK_SINGLE
    a.ph_lo = 0; a.ph_hi = NSTEPS;
    hipLaunchKernelGGL(fwd, dim3(grid), dim3(NTHR), LDS_BYTES, stream, a);
#else
    for (int s = 0; s < NSTEPS; ++s) {
        if (s >= 1 && s < STEP_FINAL) { const int l = (s - 1) / STEPS_PER_LAYER, k = (s - 1) % STEPS_PER_LAYER; if (!(l & 1) && k >= 3 && k <= 5) continue; }
        a.ph_lo = s; a.ph_hi = s + 1;
        hipLaunchKernelGGL(fwd, dim3(grid), dim3(NTHR), LDS_BYTES, stream, a);
    }
#endif
}
```

```cpp
#include <hip/hip_runtime.h>
#include <cstdio>
#include <cstdint>
#include <type_traits>

#ifndef MK_SINGLE
#define MK_SINGLE 1
#endif

#define LAS __attribute__((address_space(3)))
typedef unsigned short bf16_t;
typedef short bf16x8 __attribute__((ext_vector_type(8)));
typedef float f32x4 __attribute__((ext_vector_type(4)));
typedef float f32x2 __attribute__((ext_vector_type(2)));
typedef unsigned u32x4 __attribute__((ext_vector_type(4)));
typedef unsigned u32x2 __attribute__((ext_vector_type(2)));

constexpr int D = 1024, NB = 16, TX = 2048, TCX = 256, NXR = NB * TX, NCR = NB * TCX, NR = NXR + NCR;
constexpr int NE = 16, CAPX = 256, CAPC = 32, NSX = NB * NE * CAPX, NSC = NB * NE * CAPC, NS = NSX + NSC;
constexpr int NWAVES = 8, NTHR = 512;
constexpr int LDS_BYTES = 147456, MISC_OFF = LDS_BYTES - 256;

constexpr size_t MiB = 1u << 20;
constexpr size_t WS_CTL = 0, WS_W2CAT = 1 * MiB, WS_WCAT = 7 * MiB, WS_ZERO_BYTES = 35 * MiB;
constexpr size_t WS_MOD = 35 * MiB, WS_CTXR = 37 * MiB, WS_WOT = 53 * MiB, WS_CH = 61 * MiB, WS_SEQC = 61 * MiB + 512 * 1024, WS_SEQX = 62 * MiB;
constexpr size_t WS_AFF = 78 * MiB, WS_GATE = 81 * MiB, WS_IDX = 81 * MiB + 512 * 1024, WS_INV = 82 * MiB, WS_BONUS = 84 * MiB, WS_WOB = 89 * MiB;
constexpr size_t WS_HXS = 41 * MiB, WS_WL8 = 42 * MiB, WS_WL8S = 44 * MiB;
constexpr size_t WS_WO8 = 37 * MiB, WS_WO8S = 39 * MiB, WS_OUTSC = 40 * MiB;
constexpr size_t WS_RKVWS = 89 * MiB + 64 * 1024;
constexpr size_t WS_RKVXS = 78 * MiB;
constexpr size_t WS_HBSCALE = 83 * MiB + 256 * 1024;
constexpr size_t WS_XSCALE = 89 * MiB + 256 * 1024, WS_WSCALE = 89 * MiB + 640 * 1024;
constexpr size_t WS_MOEW = 90 * MiB, WS_MOEW_GU = WS_MOEW, WS_MOEW_DN = WS_MOEW + 64 * MiB, WS_G = WS_MOEW;
constexpr size_t WS_VFIRST = 186 * MiB, WS_ARENA = 258 * MiB;
constexpr size_t WS_HB2 = WS_ARENA, WS_HB = WS_ARENA, WS_OUTB = WS_ARENA, WS_W0 = WS_ARENA, WS_W1 = WS_ARENA + 72 * MiB;
constexpr size_t WS_YS = WS_ARENA + 144 * MiB, WS_A0 = WS_ARENA + 144 * MiB, WS_A1 = WS_ARENA + 216 * MiB;
constexpr size_t WS_XS = WS_ARENA + 288 * MiB, WS_YT = WS_ARENA + 288 * MiB, WS_YTC = WS_ARENA + 416 * MiB, WS_R = WS_ARENA + 288 * MiB, WS_K = WS_ARENA + 360 * MiB;
constexpr size_t WS_HID = WS_ARENA + 432 * MiB, WS_VB = WS_ARENA + 432 * MiB, WS_A23 = WS_ARENA + 504 * MiB, WS_Y0 = WS_ARENA + 504 * MiB;
constexpr size_t WS_XR = WS_ARENA + 144 * MiB, WS_XK = WS_ARENA + 216 * MiB, WS_XV = WS_ARENA + 576 * MiB;
constexpr size_t WS_DELTA = WS_XV;
constexpr size_t WS_END = WS_ARENA + 648 * MiB;
constexpr size_t WS_XB = WS_END + 64 * MiB, WS_TOTAL = WS_XB + (size_t)NR * D * 2;

__device__ __forceinline__ float bf2f(unsigned b) { return __uint_as_float(b << 16); }
typedef __bf16 bf16x2_t __attribute__((ext_vector_type(2)));
__device__ __forceinline__ unsigned pk2(float lo, float hi) { const f32x2 v = {lo, hi}; const bf16x2_t b = __builtin_convertvector(v, bf16x2_t); return __builtin_bit_cast(unsigned, b); }
__device__ __forceinline__ unsigned f2bf(float f) { return pk2(f, 0.f) & 0xffffu; }
#define DPP_F(v, ctrl) __int_as_float(__builtin_amdgcn_update_dpp(0, __float_as_int(v), (ctrl), 0xF, 0xF, true))
__device__ __forceinline__ float row16_sum(float v) {
    v += DPP_F(v, 0xB1); v += DPP_F(v, 0x4E); v += DPP_F(v, 0x141); v += DPP_F(v, 0x140); return v; }
__device__ __forceinline__ float wave_sum(float v) {
    v = row16_sum(v);
    return (__int_as_float(__builtin_amdgcn_readlane(__float_as_int(v), 0)) + __int_as_float(__builtin_amdgcn_readlane(__float_as_int(v), 16))) + (__int_as_float(__builtin_amdgcn_readlane(__float_as_int(v), 32)) + __int_as_float(__builtin_amdgcn_readlane(__float_as_int(v), 48))); }
__device__ __forceinline__ float wave_max(float v) {
    v = fmaxf(v, DPP_F(v, 0xB1)); v = fmaxf(v, DPP_F(v, 0x4E)); v = fmaxf(v, DPP_F(v, 0x141)); v = fmaxf(v, DPP_F(v, 0x140));
    return fmaxf(fmaxf(__int_as_float(__builtin_amdgcn_readlane(__float_as_int(v), 0)), __int_as_float(__builtin_amdgcn_readlane(__float_as_int(v), 16))), fmaxf(__int_as_float(__builtin_amdgcn_readlane(__float_as_int(v), 32)), __int_as_float(__builtin_amdgcn_readlane(__float_as_int(v), 48)))); }
__device__ __forceinline__ float lane_xor(float v, int mask, int lane) { return __int_as_float(__builtin_amdgcn_ds_bpermute((lane ^ mask) << 2, __float_as_int(v))); }
__device__ __forceinline__ float sigmoidf_(float x) { return __builtin_amdgcn_rcpf(1.0f + __expf(-x)); }
__device__ __forceinline__ float tanhf_(float x) { const float e = __expf(-2.0f * fabsf(x)); const float t = (1.0f - e) * __builtin_amdgcn_rcpf(1.0f + e); return x < 0.f ? -t : t; }

#define XB_TMO      128
#define XB_XCNT(j)  (256  + 64 * (j))
#define XB_XSUB(j)  (1280 + 64 * (j))
#define XB_XGEN(j)  (2304 + 64 * (j))
#define XB_TOP      3328
#define XB_TOPGEN   3392
#define XCD_BAR_WORDS 3456
#define XB_SPIN_CAP (1u << 22)
__device__ __forceinline__ unsigned xb_ld(unsigned* p)              { return __hip_atomic_load(p, __ATOMIC_RELAXED, __HIP_MEMORY_SCOPE_AGENT); }
__device__ __forceinline__ unsigned xb_add(unsigned* p, unsigned v) { return __hip_atomic_fetch_add(p, v, __ATOMIC_RELAXED, __HIP_MEMORY_SCOPE_AGENT); }
__device__ __forceinline__ unsigned xb_xcc_id() { return (unsigned)__builtin_amdgcn_s_getreg((3 << 11) | 20) & 0xFu; }
#define XB_SPIN(cond, bar) do { unsigned _sp = 0; while (cond) { __builtin_amdgcn_s_sleep(1); \
    if ((++_sp & 255u) == 0u) { if (xb_ld(&(bar)[XB_TMO])) break; if (_sp > XB_SPIN_CAP) { atomicAdd(&(bar)[XB_TMO], 1u); break; } } } } while (0)
struct XcdBarrier { unsigned* bar; unsigned x; volatile LAS unsigned* st; };
__device__ __forceinline__ XcdBarrier xcd_barrier_post(unsigned* bar, volatile LAS unsigned* st) {
    XcdBarrier b; b.bar = bar; b.x = xb_xcc_id(); b.st = st;
    if (threadIdx.x == 0) (void)xb_add(&bar[XB_XCNT(b.x)], 1u);
    return b;
}
__device__ __forceinline__ void xcd_barrier_complete(unsigned* bar, unsigned x, unsigned& nloc, unsigned& nx) {
    const unsigned G = gridDim.x * gridDim.y * gridDim.z;
    unsigned sum, cnt, mine, sp = 0u;
    for (;;) {
        sum = 0u; cnt = 0u; mine = 0u;
#pragma unroll
        for (unsigned j = 0; j < 16; ++j) { const unsigned c = xb_ld(&bar[XB_XCNT(j)]); sum += c; cnt += (c > 0u) ? 1u : 0u; mine = (j == x) ? c : mine; }
        if (sum == G) break;
        __builtin_amdgcn_s_sleep(1);
        if ((++sp & 255u) == 0u) { if (xb_ld(&bar[XB_TMO])) break; if (sp > XB_SPIN_CAP) { atomicAdd(&bar[XB_TMO], 1u); break; } }
    }
    nloc = mine > 0u ? mine : 1u; nx = cnt > 0u ? cnt : 1u;
}
__device__ __forceinline__ void xcd_barrier(const XcdBarrier& b) {
    asm volatile("s_waitcnt vmcnt(0)" ::: "memory");
    __syncthreads();
    if (threadIdx.x == 0) {
        unsigned* bar = b.bar;
        __builtin_amdgcn_s_waitcnt(0);
        unsigned nloc = b.st[0], nx = b.st[1];
        if (nloc == 0u) { xcd_barrier_complete(bar, b.x, nloc, nx); b.st[0] = nloc; b.st[1] = nx; }
        const unsigned old = xb_add(&bar[XB_XSUB(b.x)], 1u);
        const unsigned gen = old / nloc;
        if (old + 1u == (gen + 1u) * nloc) {
            __builtin_amdgcn_fence(__ATOMIC_RELEASE, "agent");
            asm volatile("s_waitcnt vmcnt(0)" ::: "memory");
            const unsigned og = xb_add(&bar[XB_TOP], 1u);
            const unsigned tg = og / nx;
            if (og + 1u == (tg + 1u) * nx) xb_add(&bar[XB_TOPGEN], 1u);
            else XB_SPIN(xb_ld(&bar[XB_TOPGEN]) == tg, bar);
            __builtin_amdgcn_fence(__ATOMIC_ACQUIRE, "agent");
            xb_add(&bar[XB_XGEN(b.x)], 1u);
            asm volatile("s_waitcnt vmcnt(0)" ::: "memory");
        } else {
            XB_SPIN(xb_ld(&bar[XB_XGEN(b.x)]) == gen, bar);
            __builtin_amdgcn_fence(__ATOMIC_ACQUIRE, "agent");
            asm volatile("s_waitcnt vmcnt(0)" ::: "memory");
        }
    }
    __syncthreads();
}

namespace pg8 {
constexpr int BM = 256, BK = 64, HALF = 128, HTB = HALF * BK * 2, STAGE_BYTES = 8 * HTB, NXCD = 8, WGM = 8;
__device__ __forceinline__ int lds_byte(int r, int c) { const int st = (r >> 4) * 2 + (c >> 5), rr = r & 15, cc = c & 31, ob = rr * 64 + cc * 2; return st * 1024 + (ob ^ (((ob >> 9) & 1) << 5)); }
__device__ __forceinline__ void stage_rc(int b, int& R, int& C) { const int st = b / 1024, sb = b % 1024, swz = sb ^ (((sb >> 9) & 1) << 5); R = (st >> 1) * 16 + swz / 64; C = (st & 1) * 32 + (swz % 64) / 2; }
__device__ __forceinline__ int perm32(int rho) { const int n = rho >> 4, i = rho & 15; return 8 * (i >> 2) + 4 * n + (i & 3); }
struct Unit { int pm, pn; };
__device__ __forceinline__ bool tile_order(int i, int G, int c, int nM, int nN, Unit& u) {
    const int nwg = nM * nN; const long L = (long)i * G + c; if (L >= nwg) return false;
    int wgid = (int)L; { const int q = nwg / NXCD, r = nwg % NXCD, xcd = wgid % NXCD, off = wgid / NXCD; wgid = (xcd < r ? xcd * (q + 1) : r * (q + 1) + (xcd - r) * q) + off; }
    const int nig = WGM * nN, gid = wgid / nig, fm = gid * WGM, gsz = (nM - fm) < WGM ? (nM - fm) : WGM;
    u.pm = fm + ((wgid % nig) % gsz); u.pn = (wgid % nig) / gsz; return true;
}
__device__ __forceinline__ unsigned cvt_pk_bf16(float lo, float hi) { const f32x2 v = {lo, hi}; const bf16x2_t b = __builtin_convertvector(v, bf16x2_t); return __builtin_bit_cast(unsigned, b); }

__device__ __forceinline__ const char* uni_ptr(const char* p) { const unsigned long long v = (unsigned long long)p;
    const unsigned lo = __builtin_amdgcn_readfirstlane((unsigned)v), hi = __builtin_amdgcn_readfirstlane((unsigned)(v >> 32)); return (const char*)(((unsigned long long)hi << 32) | lo); }
typedef int i32x4 __attribute__((ext_vector_type(4)));
template <bool I8> __device__ __forceinline__ f32x4 mma_step(const bf16x8 b, const bf16x8 a, const f32x4 c) { return __builtin_amdgcn_mfma_f32_16x16x32_bf16(b, a, c, 0, 0, 0); }
template <bool I8> __device__ __forceinline__ i32x4 mma_step(const bf16x8 b, const bf16x8 a, const i32x4 c) { return __builtin_amdgcn_mfma_i32_16x16x64_i8(__builtin_bit_cast(i32x4, b), __builtin_bit_cast(i32x4, a), c, 0, 0, 0); }
template <class Prob, class Epi, bool I8 = false>
__device__ __forceinline__ void gemm_phase(LAS unsigned char* lds, int tid, const Prob& P, const Epi& E) {
    typedef typename std::conditional<I8, i32x4, f32x4>::type acc_t;
    asm volatile("" : "+v"(tid));
    const int wid = __builtin_amdgcn_readfirstlane(tid >> 6), lane = tid & 63, wr = wid >> 2, wc = wid & 3, fr = lane & 15, fq = lane >> 4;
    constexpr int lda = Prob::LDA, ldb = Prob::LDB;
    unsigned voffA[2], voffB[2];
#pragma unroll
    for (int i = 0; i < 2; ++i) { int R, C; stage_rc(tid * 16 + i * 8192, R, C); const int Rb = Epi::PERM ? ((R & ~31) + perm32(R & 31)) : R;
        voffA[i] = (unsigned)(R * lda + C) * 2u; voffB[i] = (unsigned)(Rb * ldb + C) * 2u; }
    constexpr unsigned kstep = (unsigned)(BK * 2);
    constexpr unsigned hstepA = (unsigned)HALF * lda * 2, hstepB = (unsigned)HALF * ldb * 2;
    const unsigned ldsw = (unsigned)wid * 1024u;
    const int aoff = lds_byte(wr * 64 + fr, fq * 8), boff = lds_byte(wc * 32 + fr, fq * 8);
    typedef const __attribute__((address_space(1))) char* gptr_t;
    const gptr_t gA = (gptr_t)uni_ptr(P.gA), gB = (gptr_t)uni_ptr(P.gB);
#define PG8_SA(b, h) (((b) * 2 + (h)) * HTB)
#define PG8_SB(b, h) ((4 + (b) * 2 + (h)) * HTB)
#define PG8_STAGE(bufoff, gbase, uoff, voff) do { _Pragma("unroll") for (int _i = 0; _i < 2; ++_i) \
        __builtin_amdgcn_global_load_lds((const __attribute__((address_space(1))) unsigned*)((gbase) + (unsigned)((uoff) + (voff)[_i])), (LAS unsigned*)(lds + (bufoff) + ldsw + _i * 8192), 16, 0, 0); } while (0)
#define PG8_STA(bufoff, uoff) PG8_STAGE(bufoff, gA, uoff, voffA)
#define PG8_STB(bufoff, uoff) PG8_STAGE(bufoff, gB, uoff, voffB)
#define PG8_LDA(dst, b, h) do { _Pragma("unroll") for (int m = 0; m < 4; ++m) _Pragma("unroll") for (int k = 0; k < 2; ++k) dst[m][k] = *(const LAS bf16x8*)(lds + PG8_SA(b, h) + aoff + m * 2048 + k * 1024); } while (0)
#define PG8_LDB(dst, b, h) do { _Pragma("unroll") for (int n = 0; n < 2; ++n) _Pragma("unroll") for (int k = 0; k < 2; ++k) dst[n][k] = *(const LAS bf16x8*)(lds + PG8_SB(b, h) + boff + n * 2048 + k * 1024); } while (0)
#define PG8_MMA(ai, bj, At, Bt) do { __builtin_amdgcn_s_setprio(1); _Pragma("unroll") for (int m = 0; m < 4; ++m) _Pragma("unroll") for (int n = 0; n < 2; ++n) _Pragma("unroll") for (int k = 0; k < 2; ++k) \
        acc[ai][bj][m][n] = mma_step<I8>(Bt[n][k], At[m][k], acc[ai][bj][m][n]); __builtin_amdgcn_s_setprio(0); } while (0)
#define PG8_WAIT_V(n) asm volatile("s_waitcnt vmcnt(" #n ")" ::: "memory")
#define PG8_WAIT_L(n) asm volatile("s_waitcnt lgkmcnt(" #n ")" ::: "memory")
#define PG8_BAR __builtin_amdgcn_s_barrier()
#define PG8_SCHED __builtin_amdgcn_sched_barrier(0)
    Unit cur, nxt; int ui = 0;
    if (!P.next(0, cur)) return;
    acc_t acc[2][2][4][2];
#pragma unroll
    for (int a = 0; a < 2; ++a)
#pragma unroll
        for (int b = 0; b < 2; ++b)
#pragma unroll
            for (int m = 0; m < 4; ++m)
#pragma unroll
                for (int n = 0; n < 2; ++n) acc[a][b][m][n] = (acc_t){0, 0, 0, 0};
    bf16x8 At[4][2], B0[2][2], B1[2][2];
    unsigned cA = __builtin_amdgcn_readfirstlane(P.a_off(cur)), cB = __builtin_amdgcn_readfirstlane(P.b_off(cur)); int nt = P.nt(cur);
    PG8_STB(PG8_SB(0, 0), cB); PG8_STB(PG8_SB(0, 1), cB + hstepB); PG8_STA(PG8_SA(0, 0), cA); PG8_STA(PG8_SA(0, 1), cA + hstepA);
    if (wr == 1) PG8_BAR;
    PG8_WAIT_V(2); PG8_BAR;
    PG8_STB(PG8_SB(1, 0), cB + kstep); PG8_STA(PG8_SA(1, 0), cA + kstep); PG8_STB(PG8_SB(1, 1), cB + hstepB + kstep);
    PG8_WAIT_V(6); PG8_BAR;
    for (;;) {
        const bool has_next = P.next(ui + 1, nxt);
        const unsigned nA = has_next ? __builtin_amdgcn_readfirstlane(P.a_off(nxt)) : cA, nB = has_next ? __builtin_amdgcn_readfirstlane(P.b_off(nxt)) : cB;
#pragma unroll 1
        for (int t = 0; t < nt; t += 2) {
            const bool last = (t == nt - 2);
            const unsigned a1 = cA + (unsigned)(t + 1) * kstep;
            const unsigned a2 = last ? nA : cA + (unsigned)(t + 2) * kstep, b2 = last ? nB : cB + (unsigned)(t + 2) * kstep;
            const unsigned a3 = a2 + kstep, b3 = b2 + kstep;
            PG8_LDB(B0, 0, 0); PG8_LDB(B1, 0, 1); PG8_SCHED; PG8_LDA(At, 0, 0); PG8_STA(PG8_SA(1, 1), a1 + hstepA);
            PG8_WAIT_V(8); PG8_WAIT_L(0); PG8_BAR; PG8_MMA(0, 0, At, B0); PG8_MMA(0, 1, At, B1); PG8_BAR; PG8_SCHED;
            PG8_LDA(At, 0, 1); PG8_STB(PG8_SB(0, 0), b2); PG8_STB(PG8_SB(0, 1), b2 + hstepB); PG8_STA(PG8_SA(0, 0), a2);
            PG8_WAIT_V(8); PG8_WAIT_L(0); PG8_BAR; PG8_MMA(1, 0, At, B0); PG8_MMA(1, 1, At, B1); PG8_BAR; PG8_SCHED;
            PG8_LDB(B0, 1, 0); PG8_LDB(B1, 1, 1); PG8_SCHED; PG8_LDA(At, 1, 0); PG8_STA(PG8_SA(0, 1), a2 + hstepA);
            PG8_WAIT_V(8); PG8_WAIT_L(0); PG8_BAR; PG8_MMA(0, 0, At, B0); PG8_MMA(0, 1, At, B1); PG8_BAR; PG8_SCHED;
            PG8_LDA(At, 1, 1); PG8_STB(PG8_SB(1, 0), b3); PG8_STB(PG8_SB(1, 1), b3 + hstepB); PG8_STA(PG8_SA(1, 0), a3);
            PG8_WAIT_V(8); PG8_WAIT_L(0); PG8_BAR; PG8_MMA(1, 0, At, B0); PG8_MMA(1, 1, At, B1); PG8_BAR; PG8_SCHED;
        }
        if (wr == 0) PG8_BAR;
        E(acc, cur, wr, wc, fr, fq);
        if (!has_next) break;
#pragma unroll
        for (int a = 0; a < 2; ++a)
#pragma unroll
            for (int b = 0; b < 2; ++b)
#pragma unroll
                for (int m = 0; m < 4; ++m)
#pragma unroll
                    for (int n = 0; n < 2; ++n) acc[a][b][m][n] = (acc_t){0, 0, 0, 0};
        cur = nxt; cA = nA; cB = nB; nt = P.nt(cur); ++ui;
        if (wr == 1) PG8_BAR;
    }
    PG8_WAIT_V(0);
    PG8_BAR;
#undef PG8_SA
#undef PG8_SB
#undef PG8_STAGE
#undef PG8_STA
#undef PG8_STB
#undef PG8_LDA
#undef PG8_LDB
#undef PG8_MMA
#undef PG8_WAIT_V
#undef PG8_WAIT_L
#undef PG8_BAR
#undef PG8_SCHED
}

__device__ __forceinline__ void st8(bf16_t* p, const f32x4 v0, const f32x4 v1) {
    u32x4 w; w.x = cvt_pk_bf16(v0[0], v0[1]); w.y = cvt_pk_bf16(v0[2], v0[3]); w.z = cvt_pk_bf16(v1[0], v1[1]); w.w = cvt_pk_bf16(v1[2], v1[3]);
    *(u32x4*)p = w;
}
}

struct Args { const float* in[35]; float* out; unsigned char* ws; int ph_lo, ph_hi; };
typedef const __attribute__((address_space(4))) Args CArgs;
__device__ __forceinline__ CArgs* launder_args(CArgs* p) { unsigned long long v = (unsigned long long)p; asm volatile("" : "+s"(v)); return (CArgs*)v; }
enum { I_X = 0, I_C, I_CTX, I_CCTX, I_ADAW, I_ADAB, I_NORMG, I_FWO, I_FBO, I_MIX, I_WR, I_WK, I_WV, I_WO, I_W0, I_W1, I_W2, I_A0, I_A1, I_A2, I_V0, I_V1, I_V2, I_G1, I_G2,
       I_KK, I_KA, I_RK, I_LNW, I_LNB, I_ROUTER, I_WG, I_WU, I_WD, I_FG };

struct JobDesc { int src, soff, scl, sclo, dbuf, doff, K, N, ldt; };
#define MJ(src, soff, scl, sclo, dbuf, doff, K, N, ldt) { src, soff, scl, sclo, dbuf, doff, K, N, ldt }
#define WCB(ri) ((ri) * 3584 * 2048)
#define W2B(ri) ((ri) * 6144 * 256)
#define JOBS_RI(ri) \
    MJ(I_W1, ((ri) * 2 + 0) * 65536, -1, 0, 1, WCB(ri) + 3072 * 2048, 1024, 64, 2048), MJ(I_W1, ((ri) * 2 + 0) * 65536, I_MIX, ((ri) * 6 + 1) * 1024, 1, WCB(ri) + 3072 * 2048 + 1024, 1024, 64, 2048), \
    MJ(I_W1, ((ri) * 2 + 1) * 65536, -1, 0, 1, WCB(ri) + 3136 * 2048, 1024, 64, 2048), MJ(I_W1, ((ri) * 2 + 1) * 65536, I_MIX, ((ri) * 6 + 1) * 1024, 1, WCB(ri) + 3136 * 2048 + 1024, 1024, 64, 2048), \
    MJ(I_A1, ((ri) * 2 + 0) * 65536, -1, 0, 1, WCB(ri) + 3200 * 2048, 1024, 64, 2048), MJ(I_A1, ((ri) * 2 + 0) * 65536, I_MIX, ((ri) * 6 + 4) * 1024, 1, WCB(ri) + 3200 * 2048 + 1024, 1024, 64, 2048), \
    MJ(I_A1, ((ri) * 2 + 1) * 65536, -1, 0, 1, WCB(ri) + 3264 * 2048, 1024, 64, 2048), MJ(I_A1, ((ri) * 2 + 1) * 65536, I_MIX, ((ri) * 6 + 4) * 1024, 1, WCB(ri) + 3264 * 2048 + 1024, 1024, 64, 2048), \
    MJ(I_G1, (ri) * 131072, -1, 0, 1, WCB(ri) + 3328 * 2048, 1024, 128, 2048),   MJ(I_G1, (ri) * 131072, I_MIX, ((ri) * 6 + 5) * 1024, 1, WCB(ri) + 3328 * 2048 + 1024, 1024, 128, 2048), \
    MJ(I_W2, ((ri) * 2 + 0) * 65536, -1, 0, 2, W2B(ri) + 0 * 256 + 0, 64, 1024, 256),      MJ(I_W2, ((ri) * 2 + 1) * 65536, -1, 0, 2, W2B(ri) + 1024 * 256 + 64, 64, 1024, 256), \
    MJ(I_A2, ((ri) * 2 + 0) * 65536, -1, 0, 2, W2B(ri) + 2048 * 256 + 128, 64, 1024, 256), MJ(I_A2, ((ri) * 2 + 1) * 65536, -1, 0, 2, W2B(ri) + 3072 * 256 + 192, 64, 1024, 256), \
    MJ(I_G2, (ri) * 131072, -1, 0, 2, W2B(ri) + 4096 * 256 + 0, 128, 1024, 256)
__device__ const JobDesc JOBS[] = {
    MJ(I_FWO, 0 * 1048576, -1, 0, 0, 0 * 1048576, 1024, 1024, 1024),
    MJ(I_FWO, 1 * 1048576, -1, 0, 0, 2 * 1048576, 1024, 1024, 1024),
    JOBS_RI(0), JOBS_RI(1),
    MJ(I_V1, 0, -1, 0, 1, WCB(1) + 3456 * 2048, 1024, 32, 2048), MJ(I_V1, 0, I_MIX, (1 * 6 + 3) * 1024, 1, WCB(1) + 3456 * 2048 + 1024, 1024, 32, 2048),
    MJ(I_V2, 0, -1, 0, 2, W2B(1) + 5120 * 256 + 128, 32, 1024, 256),
};
constexpr int NJOBS = 2 + 2 * 15 + 3;
static_assert(sizeof(JOBS) / sizeof(JobDesc) == NJOBS, "job count");

__host__ __device__ constexpr int job_items(int K, int N) { return ((K + 63) / 64) * ((N + 63) / 64); }
__device__ __forceinline__ void conv_item(const float* W, int ldw, int kvalid, int nvalid, const float* scale, bf16_t* dst, int ldt, LAS float* scr, int lane) {
    const int kr = lane >> 4, nc = 4 * (lane & 15);
    f32x4 v[16];
#pragma unroll
    for (int it = 0; it < 16; ++it) { const int k = 4 * it + kr; v[it] = (f32x4){0.f, 0.f, 0.f, 0.f};
        if (k < kvalid && nc < nvalid) { v[it] = *(const f32x4*)(W + (size_t)k * ldw + nc); if (scale) v[it] = v[it] * scale[k]; } }
#pragma unroll
    for (int it = 0; it < 16; ++it) *(LAS f32x4*)(scr + (4 * it + kr) * 68 + nc) = v[it];
    asm volatile("s_waitcnt lgkmcnt(0)" ::: "memory");
    if (lane < nvalid) {
#pragma unroll
        for (int c2 = 0; c2 < 8; c2 += 4) {
            float t[4][8];
#pragma unroll
            for (int c = 0; c < 4; ++c)
#pragma unroll
                for (int k = 0; k < 8; ++k) t[c][k] = scr[(8 * (c2 + c) + k) * 68 + lane];
            asm volatile("s_waitcnt lgkmcnt(0)" ::: "memory");
#pragma unroll
            for (int c = 0; c < 4; ++c) { u32x4 o; o.x = pg8::cvt_pk_bf16(t[c][0], t[c][1]); o.y = pg8::cvt_pk_bf16(t[c][2], t[c][3]); o.z = pg8::cvt_pk_bf16(t[c][4], t[c][5]); o.w = pg8::cvt_pk_bf16(t[c][6], t[c][7]);
                *(u32x4*)(dst + (size_t)lane * ldt + 8 * (c2 + c)) = o; } }
    }
    asm volatile("s_waitcnt lgkmcnt(0)" ::: "memory");
}

struct Frame {
    LAS unsigned char* lds;
    int tid, lane, wave, G, bid;
    unsigned char* ws;
};
#define WSP(T, off) ((T*)(F.ws + (off)))

__device__ __forceinline__ void quant_strip(Frame& F, const float* W, signed char* dst, int dst_pitch, float* scl, int drow0) {
    LAS float* T = (LAS float*)F.lds;
    { const int j4 = 4 * (F.tid & 7), kk = F.tid >> 3;
      f32x4 t[16];
#pragma unroll
      for (int p = 0; p < 16; ++p) t[p] = *(const f32x4*)(W + (size_t)(64 * p + kk) * 1024 + j4);
#pragma unroll
      for (int p = 0; p < 16; ++p) { LAS float* tp = T + (64 * p + kk) * 33 + j4; tp[0] = t[p][0]; tp[1] = t[p][1]; tp[2] = t[p][2]; tp[3] = t[p][3]; } }
    __syncthreads();
#pragma unroll 1
    for (int cq = 0; cq < 4; ++cq) {
        const int c = 4 * F.wave + cq;
        float am = 0.f;
        float tv[16];
#pragma unroll
        for (int i = 0; i < 16; ++i) tv[i] = T[(F.lane + 64 * i) * 33 + c];
        asm volatile("s_waitcnt lgkmcnt(0)" ::: "memory");
#pragma unroll
        for (int i = 0; i < 16; ++i) am = fmaxf(am, fabsf(tv[i]));
#pragma unroll
        for (int i = 0; i < 16; ++i) tv[i] = T[(16 * F.lane + i) * 33 + c];
        am = wave_max(am);
        const float inv = am > 0.f ? 127.0f / am : 0.f;
        asm volatile("s_waitcnt lgkmcnt(0)" ::: "memory");
        unsigned q[4];
#pragma unroll
        for (int i = 0; i < 4; ++i) { unsigned o = 0u;
#pragma unroll
            for (int jj = 0; jj < 4; ++jj) { const int qi = (int)__builtin_rintf(tv[4 * i + jj] * inv); o |= ((unsigned)qi & 255u) << (8 * jj); }
            q[i] = o; }
        *(u32x4*)(dst + (size_t)(drow0 + c) * dst_pitch + 16 * F.lane) = (u32x4){q[0], q[1], q[2], q[3]};
        if (F.lane == 0) scl[drow0 + c] = am * (1.0f / 127.0f);
    }
    __syncthreads();
}
__device__ __forceinline__ void p0_prologue(Frame& F, CArgs& a) {
    const int gw = F.bid * NWAVES + F.wave, NGW = F.G * NWAVES;
    const size_t gt = (size_t)F.bid * NTHR + F.tid, GT = (size_t)F.G * NTHR;
    {
        LAS float* SIL = (LAS float*)F.lds;
        LAS float* RED = (LAS float*)(F.lds + 69632);
        float* MOD = WSP(float, WS_MOD);
        if (F.bid < 192) {
            for (int idx = F.tid; idx < 17 * 1024; idx += NTHR) { const int r = idx >> 10, k = idx & 1023; const float cv = (r < 16) ? a.in[I_C][r * 1024 + k] : a.in[I_CCTX][k]; SIL[idx] = cv / (1.0f + __expf(-cv)); }
            __syncthreads();
        }
        for (int u = F.bid; u < 192; u += F.G) {
            const int l = u / 48, col0 = (u % 48) * 128;
            const float* W = a.in[I_ADAW] + (size_t)l * 1024 * 6144 + col0 + 2 * F.lane;
            float acc[17][2];
#pragma unroll
            for (int r = 0; r < 17; ++r) { acc[r][0] = 0.f; acc[r][1] = 0.f; }
            const int kbase = F.wave * 128;
            f32x2 wn[8];
#pragma unroll
            for (int q = 0; q < 8; ++q) wn[q] = *(const f32x2*)(W + (size_t)(kbase + q) * 6144);
#pragma unroll 1
            for (int k8 = 0; k8 < 16; ++k8) {
                const int k = kbase + 8 * k8;
                f32x2 w[8];
#pragma unroll
                for (int q = 0; q < 8; ++q) w[q] = wn[q];
                if (k8 + 1 < 16) {
#pragma unroll
                    for (int q = 0; q < 8; ++q) wn[q] = *(const f32x2*)(W + (size_t)(k + 8 + q) * 6144); }
#pragma unroll
                for (int r = 0; r < 17; ++r) { const f32x4 s0 = *(const LAS f32x4*)(SIL + r * 1024 + k), s1 = *(const LAS f32x4*)(SIL + r * 1024 + k + 4);
#pragma unroll
                    for (int q = 0; q < 4; ++q) { acc[r][0] += s0[q] * w[q].x; acc[r][1] += s0[q] * w[q].y; }
#pragma unroll
                    for (int q = 0; q < 4; ++q) { acc[r][0] += s1[q] * w[4 + q].x; acc[r][1] += s1[q] * w[4 + q].y; } }
            }
#pragma unroll
            for (int r = 0; r < 17; ++r) { RED[(F.wave * 17 + r) * 128 + 2 * F.lane] = acc[r][0]; RED[(F.wave * 17 + r) * 128 + 2 * F.lane + 1] = acc[r][1]; }
            __syncthreads();
            for (int o = F.tid; o < 17 * 128; o += NTHR) { const int r = o >> 7, cc = o & 127; float s = a.in[I_ADAB][l * 6144 + col0 + cc];
#pragma unroll
                for (int w = 0; w < 8; ++w) s += RED[(w * 17 + r) * 128 + cc];
                MOD[(size_t)(l * 17 + r) * 6144 + col0 + cc] = s; }
            __syncthreads();
        }
        __syncthreads();
    }
    for (int sidx = F.bid; sidx < 2 * 3 * 32; sidx += F.G) {
        const int ri = sidx / 96, rem = sidx % 96, which = rem >> 5, n0 = 32 * (rem & 31);
        const float* W = (which == 0 ? a.in[I_WR] : (which == 1 ? a.in[I_WK] : a.in[I_WV])) + (size_t)ri * 1048576 + n0;
        quant_strip(F, W, WSP(signed char, WS_WCAT) + (size_t)ri * 3584 * 4096, 4096, WSP(float, WS_RKVWS) + ri * 3072, which * 1024 + n0);
    }
    for (int sidx = (F.bid + 64) % F.G; sidx < 2 * 32; sidx += F.G) { const int ri = sidx >> 5, n0 = 32 * (sidx & 31);
        quant_strip(F, a.in[I_WO] + (size_t)ri * 1048576 + n0, WSP(signed char, WS_WO8) + (size_t)ri * 1048576, 1024, WSP(float, WS_WO8S) + ri * 1024, n0); }
    {
        LAS float* scr = (LAS float*)(F.lds + F.wave * 17408);
        int total = 0;
#pragma unroll 1
        for (int j = 0; j < NJOBS; ++j) total += job_items(JOBS[j].K, JOBS[j].N);
        for (int it = gw; it < total; it += NGW) {
            int j = 0, r = it;
#pragma unroll 1
            for (; j < NJOBS; ++j) { const int n = job_items(JOBS[j].K, JOBS[j].N); if (r < n) break; r -= n; }
            const JobDesc jd = JOBS[j];
            const int nblk = (jd.N + 63) / 64, kb = r / nblk, nb = r % nblk, k0 = 64 * kb, n0 = 64 * nb;
            const float* src = nullptr; const float* scl = nullptr;
#define SEL_IN(idx, out) do { switch (idx) { case I_FWO: out = a.in[I_FWO]; break; case I_WO: out = a.in[I_WO]; break; case I_WR: out = a.in[I_WR]; break; case I_WK: out = a.in[I_WK]; break; \
                case I_WV: out = a.in[I_WV]; break; case I_W1: out = a.in[I_W1]; break; case I_W2: out = a.in[I_W2]; break; case I_A1: out = a.in[I_A1]; break; case I_A2: out = a.in[I_A2]; break; \
                case I_G1: out = a.in[I_G1]; break; case I_G2: out = a.in[I_G2]; break; case I_V1: out = a.in[I_V1]; break; case I_V2: out = a.in[I_V2]; break; case I_MIX: out = a.in[I_MIX]; break; default: out = nullptr; } } while (0)
            SEL_IN(jd.src, src); if (jd.scl >= 0) SEL_IN(jd.scl, scl);
            bf16_t* dbase = jd.dbuf == 0 ? WSP(bf16_t, WS_WOT) : (jd.dbuf == 1 ? WSP(bf16_t, WS_WCAT) : WSP(bf16_t, WS_W2CAT));
            const int kvalid = (jd.K - k0) < 64 ? (jd.K - k0) : 64, nvalid = (jd.N - n0) < 64 ? (jd.N - n0) : 64;
            conv_item(src + jd.soff + (size_t)k0 * jd.N + n0, jd.N, kvalid, nvalid, scl ? scl + jd.sclo + k0 : nullptr, dbase + jd.doff + (size_t)n0 * jd.ldt + k0, jd.ldt, scr, F.lane);
        }
    }
    {
        float* wob = WSP(float, WS_WOB);
        for (size_t i = gt; i < 4 * 1024; i += GT) { const int l = (int)(i >> 10); wob[i] = (l & 1) ? 0.f : a.in[I_FBO][(l >> 1) * 1024 + (i & 1023)]; }
    }
    {
        bf16_t* CH = WSP(bf16_t, WS_CH);
        for (size_t i = gt; i < 512 * 256; i += GT) { const int m = (int)(i >> 8), c = (int)(i & 255), l = m & 255; const float ang = (float)((l * c) & 255) * (2.0f / 256.0f);
            CH[i] = (bf16_t)f2bf((m < 256 ? cospif(ang) : sinpif(ang)) * 0.0625f); }
        bf16_t* SX = WSP(bf16_t, WS_SEQX);
        for (size_t i = gt; i < (size_t)2048 * 4096; i += GT) { const int k = (int)(i >> 12), j = (int)(i & 4095), t = j & 2047; const float ang = (float)((k * t) & 2047) * (2.0f / 2048.0f);
            SX[i] = (bf16_t)f2bf((j < 2048 ? cospif(ang) : -sinpif(ang)) * 0.022097087f); }
        bf16_t* SC = WSP(bf16_t, WS_SEQC);
        for (size_t i = gt; i < 256 * 512; i += GT) { const int k = (int)(i >> 9), j = (int)(i & 511), t = j & 255; const float ang = (float)((k * t) & 255) * (2.0f / 256.0f);
            SC[i] = (bf16_t)f2bf((j < 256 ? cospif(ang) : -sinpif(ang)) * 0.0625f); }
    }
}

template <int MODE>
__device__ __forceinline__ void row_pass(Frame& F, CArgs& a, int l, bool combine, int nrows) {
    const int gw = F.bid * NWAVES + F.wave, NGW = F.G * NWAVES, lane = F.lane;
    const float* MOD = WSP(float, WS_MOD);
    const short* INV = WSP(short, WS_INV);
    const bf16_t* YS = WSP(bf16_t, WS_YS);
    LAS float* RT = (LAS float*)F.lds;
    if (MODE == 2) {
        const float* rt = a.in[I_ROUTER] + (size_t)l * 1024 * 16;
        for (int i = F.tid; i < 16384; i += NTHR) { const int k = i >> 4, e = i & 15; RT[e * 1024 + k] = rt[i]; }
        __syncthreads();
    }
    const float* ng = (MODE == 3) ? a.in[I_FG] : a.in[I_NORMG] + (size_t)(l * 2 + (MODE == 2 ? 1 : 0)) * 1024;
    f32x4 gv[4];
#pragma unroll
    for (int j = 0; j < 4; ++j) gv[j] = *(const f32x4*)(ng + 4 * lane + 256 * j);
    const int RPW = (nrows + NGW - 1) / NGW, r0 = gw * RPW, r1 = (r0 + RPW < nrows) ? r0 + RPW : nrows;
    int bcur = -1; f32x4 shv[4], scv[4], g2v[4];
    u32x2 nv[4], nd[4];
    if (MODE == 2 && r0 < r1) { const bf16_t* xs0 = WSP(bf16_t, WS_XB) + (size_t)r0 * D + 4 * lane; const bf16_t* dp0 = WSP(bf16_t, WS_DELTA) + (size_t)r0 * D + 4 * lane;
#pragma unroll
        for (int j = 0; j < 4; ++j) { nv[j] = *(const u32x2*)(xs0 + 256 * j); nd[j] = *(const u32x2*)(dp0 + 256 * j); } }
    for (int row = r0; row < r1; ++row) {
        const bool isx = row < NXR;
        const int b = isx ? (row >> 11) : 16;
        if (b != bcur) { bcur = b;
            if (MODE != 3) { const float* mrow = MOD + (size_t)(l * 17 + b) * 6144 + 4 * lane; const int shi = (MODE == 2) ? 3 : 0, sci = (MODE == 2) ? 4 : 1;
#pragma unroll
                for (int j = 0; j < 4; ++j) { shv[j] = *(const f32x4*)(mrow + shi * 1024 + 256 * j); scv[j] = *(const f32x4*)(mrow + sci * 1024 + 256 * j) + 1.0f; } }
            if (combine) { const int lp = (MODE == 3) ? 3 : l - 1; const float* g2 = MOD + (size_t)(lp * 17 + b) * 6144 + 5 * 1024 + 4 * lane;
#pragma unroll
                for (int j = 0; j < 4; ++j) g2v[j] = *(const f32x4*)(g2 + 256 * j); } }
        bf16_t* xb = WSP(bf16_t, WS_XB) + (size_t)row * D + 4 * lane;
        float* xr = a.out + (size_t)row * D;
        f32x4 v[4];
        const bool first = (MODE == 0) && (l == 0);
        if (MODE == 2) {
#pragma unroll
            for (int j = 0; j < 4; ++j) { const u32x2 w = nd[j], xw = nv[j]; v[j] = (f32x4){bf2f(xw.x & 0xffffu), bf2f(xw.x >> 16), bf2f(xw.y & 0xffffu), bf2f(xw.y >> 16)};
                v[j][0] += bf2f(w.x & 0xffffu); v[j][1] += bf2f(w.x >> 16); v[j][2] += bf2f(w.y & 0xffffu); v[j][3] += bf2f(w.y >> 16); }
            if (row + 1 < r1) { const int rn = row + 1; const bf16_t* xsn = WSP(bf16_t, WS_XB) + (size_t)rn * D + 4 * lane; const bf16_t* dpn = WSP(bf16_t, WS_DELTA) + (size_t)rn * D + 4 * lane;
#pragma unroll
                for (int j = 0; j < 4; ++j) { nv[j] = *(const u32x2*)(xsn + 256 * j); nd[j] = *(const u32x2*)(dpn + 256 * j); } }
        } else {
        if (first) { const float* xs = isx ? a.in[I_X] + (size_t)row * D : a.in[I_CTX] + (size_t)(row - NXR) * D;
#pragma unroll
            for (int j = 0; j < 4; ++j) v[j] = *(const f32x4*)(xs + 4 * lane + 256 * j); }
        else {
#pragma unroll
            for (int j = 0; j < 4; ++j) { const u32x2 xw = *(const u32x2*)(xb + 256 * j); v[j] = (f32x4){bf2f(xw.x & 0xffffu), bf2f(xw.x >> 16), bf2f(xw.y & 0xffffu), bf2f(xw.y >> 16)}; } }
        if (combine) {
            const bf16_t* dp = WSP(bf16_t, WS_DELTA) + (size_t)row * D + 4 * lane;
#pragma unroll
            for (int j = 0; j < 4; ++j) { const u32x2 w = *(const u32x2*)(dp + 256 * j); v[j][0] += bf2f(w.x & 0xffffu); v[j][1] += bf2f(w.x >> 16); v[j][2] += bf2f(w.y & 0xffffu); v[j][3] += bf2f(w.y >> 16); }
        }
        }
        if (first) {
#pragma unroll
            for (int j = 0; j < 4; ++j) { u32x2 w; w.x = pk2(v[j][0], v[j][1]); w.y = pk2(v[j][2], v[j][3]); *(u32x2*)(xb + 256 * j) = w; }
        }
        if (combine) {
            int myinv = -1; if (lane < 16) myinv = INV[(size_t)row * 16 + lane];
            f32x4 s[4];
#pragma unroll
            for (int j = 0; j < 4; ++j) s[j] = (f32x4){0.f, 0.f, 0.f, 0.f};
            unsigned em = (unsigned)__builtin_amdgcn_ballot_w64(myinv >= 0);
#pragma unroll 1
            while (em) {
                const int e0 = __builtin_ctz(em); em &= em - 1u;
                const bool two = em != 0u; const int e1 = two ? __builtin_ctz(em) : e0; em &= em - 1u;
                const int slot0 = __builtin_amdgcn_readlane(myinv, e0), slot1 = __builtin_amdgcn_readlane(myinv, e1);
                const size_t sr0 = isx ? ((size_t)((row >> 11) * 16 + e0) * CAPX + slot0) : ((size_t)NSX + (size_t)(e0 * 16 + ((row - NXR) >> 8)) * CAPC + slot0);
                const size_t sr1 = isx ? ((size_t)((row >> 11) * 16 + e1) * CAPX + slot1) : ((size_t)NSX + (size_t)(e1 * 16 + ((row - NXR) >> 8)) * CAPC + slot1);
                const bf16_t* yp0 = YS + sr0 * D + 4 * lane; const bf16_t* yp1 = YS + sr1 * D + 4 * lane;
                const float gt0 = WSP(float, WS_GATE)[sr0]; const float gt1 = two ? WSP(float, WS_GATE)[sr1] : 0.f;
                u32x2 w0[4], w1[4];
#pragma unroll
                for (int j = 0; j < 4; ++j) { w0[j] = *(const u32x2*)(yp0 + 256 * j); w1[j] = *(const u32x2*)(yp1 + 256 * j); }
#pragma unroll
                for (int j = 0; j < 4; ++j) {
                    s[j][0] += gt0 * bf2f(w0[j].x & 0xffffu); s[j][1] += gt0 * bf2f(w0[j].x >> 16); s[j][2] += gt0 * bf2f(w0[j].y & 0xffffu); s[j][3] += gt0 * bf2f(w0[j].y >> 16);
                    s[j][0] += gt1 * bf2f(w1[j].x & 0xffffu); s[j][1] += gt1 * bf2f(w1[j].x >> 16); s[j][2] += gt1 * bf2f(w1[j].y & 0xffffu); s[j][3] += gt1 * bf2f(w1[j].y >> 16); }
            }
#pragma unroll
            for (int j = 0; j < 4; ++j) v[j] = v[j] + g2v[j] * s[j];
            if (MODE != 3) {
#pragma unroll
                for (int j = 0; j < 4; ++j) { u32x2 w; w.x = pk2(v[j][0], v[j][1]); w.y = pk2(v[j][2], v[j][3]); *(u32x2*)(xb + 256 * j) = w; }
            }
        }
        float ss = 0.f;
#pragma unroll
        for (int j = 0; j < 4; ++j) ss += (v[j][0] * v[j][0] + v[j][1] * v[j][1]) + (v[j][2] * v[j][2] + v[j][3] * v[j][3]);
        ss = wave_sum(ss);
        const float rs = 1.0f / sqrtf(ss * (1.0f / 1024.0f) + 1e-6f);
        if (MODE == 3) {
#pragma unroll
            for (int j = 0; j < 4; ++j) *(f32x4*)(xr + 4 * lane + 256 * j) = v[j] * rs * gv[j];
            continue;
        }
        f32x4 h[4];
#pragma unroll
        for (int j = 0; j < 4; ++j) h[j] = v[j] * rs * gv[j] * scv[j] + shv[j];
        if (MODE == 2) {
            float am = 0.f;
#pragma unroll
            for (int j = 0; j < 4; ++j) am = fmaxf(am, fmaxf(fmaxf(fabsf(h[j][0]), fabsf(h[j][1])), fmaxf(fabsf(h[j][2]), fabsf(h[j][3]))));
            am = wave_max(am); const float inv = am > 0.f ? 127.0f / am : 0.f;
            signed char* hq = WSP(signed char, WS_HB) + (size_t)row * D;
#pragma unroll
            for (int j = 0; j < 4; ++j) { unsigned o = 0u;
#pragma unroll
                for (int i = 0; i < 4; ++i) { const int qi = (int)__builtin_rintf(h[j][i] * inv); o |= ((unsigned)qi & 255u) << (8 * i); }
                *(unsigned*)(hq + 4 * lane + 256 * j) = o; }
            if (lane == 0) WSP(float, WS_HBSCALE)[row] = am * (1.0f / 127.0f);
        } else {
        bf16_t* hb = (MODE == 1) ? WSP(bf16_t, WS_HB2) + (size_t)row * 2048 : WSP(bf16_t, WS_HB) + (size_t)row * 1024;
#pragma unroll
        for (int j = 0; j < 4; ++j) { u32x2 w; w.x = pk2(h[j][0], h[j][1]); w.y = pk2(h[j][2], h[j][3]); *(u32x2*)(hb + 4 * lane + 256 * j) = w; }
        }
        if (MODE == 2) {
            float lg[16];
            int rto = 4 * lane; asm volatile("" : "+v"(rto));
#pragma unroll
            for (int e4 = 0; e4 < 16; e4 += 4) {
                f32x4 r4[4][4];
#pragma unroll
                for (int q = 0; q < 4; ++q)
#pragma unroll
                    for (int j = 0; j < 4; ++j) r4[q][j] = *(const LAS f32x4*)(RT + (e4 + q) * 1024 + rto + 256 * j);
                asm volatile("s_waitcnt lgkmcnt(0)" ::: "memory");
#pragma unroll
                for (int q = 0; q < 4; ++q) { f32x2 p2 = (f32x2){0.f, 0.f};
#pragma unroll
                    for (int j = 0; j < 4; ++j) { const f32x4 rr = r4[q][j], hh = h[j];
                        p2 = __builtin_shufflevector(hh, hh, 0, 1) * __builtin_shufflevector(rr, rr, 0, 1) + p2;
                        p2 = __builtin_shufflevector(hh, hh, 2, 3) * __builtin_shufflevector(rr, rr, 2, 3) + p2; }
                    lg[e4 + q] = p2[0] + p2[1]; } }
            float lgx;
            { const bool b0 = (lane & 1) != 0, b1 = (lane & 2) != 0, b2 = (lane & 4) != 0, b3 = (lane & 8) != 0;
              float q8[8], q4[4], q2[2];
#pragma unroll
              for (int i = 0; i < 8; ++i) { const float keep = b0 ? lg[2 * i + 1] : lg[2 * i], send = b0 ? lg[2 * i] : lg[2 * i + 1]; q8[i] = keep + DPP_F(send, 0xB1); }
#pragma unroll
              for (int i = 0; i < 4; ++i) { const float keep = b1 ? q8[2 * i + 1] : q8[2 * i], send = b1 ? q8[2 * i] : q8[2 * i + 1]; q4[i] = keep + DPP_F(send, 0x4E); }
#pragma unroll
              for (int i = 0; i < 2; ++i) { const float keep = b2 ? q4[2 * i + 1] : q4[2 * i], send = b2 ? q4[2 * i] : q4[2 * i + 1]; q2[i] = keep + DPP_F(send, 0x124); }
              { const float keep = b3 ? q2[1] : q2[0], send = b3 ? q2[0] : q2[1]; lgx = keep + DPP_F(send, 0x128); }
              lgx += lane_xor(lgx, 16, lane); lgx += lane_xor(lgx, 32, lane); }
            float mx = lgx; mx = fmaxf(mx, DPP_F(mx, 0xB1)); mx = fmaxf(mx, DPP_F(mx, 0x4E)); mx = fmaxf(mx, DPP_F(mx, 0x141)); mx = fmaxf(mx, DPP_F(mx, 0x140));
            const float ex = __expf(lgx - mx); const float sum = row16_sum(ex); const float inv = 1.0f / sum;
            if (lane < 16) WSP(float, WS_AFF)[(size_t)row * 16 + lane] = ex * inv;
        }
    }
    if (MODE == 2) __syncthreads();
}

__device__ __forceinline__ void moe_weight_conv(Frame& F, CArgs& a, int l, int gemm_units) {
    for (int sidx = F.bid; sidx < 16 * 2 * 32; sidx += F.G) {
        const int e = sidx >> 6, which = (sidx >> 5) & 1, n0 = 32 * (sidx & 31);
        quant_strip(F, (which ? a.in[I_WU] : a.in[I_WG]) + ((size_t)(l * 16 + e) << 20) + n0, WSP(signed char, WS_MOEW_GU), 1024, WSP(float, WS_WSCALE), e * 2048 + 256 * (n0 >> 7) + 128 * which + (n0 & 127));
    }
    constexpr int NIT = 16 * 256;
    LAS float* scr = (LAS float*)(F.lds + F.wave * 17408);
    int first, count;
    if (F.G == 256) {
        const int nbig = gemm_units % 256;
        const int lo = (nbig > 0) ? 4 : 16, hi = (nbig > 0) ? (NIT - nbig * lo + (256 - nbig) - 1) / (256 - nbig) : 16;
        if (F.bid < nbig) { first = F.bid * lo; count = lo; } else { first = nbig * lo + (F.bid - nbig) * hi; count = hi; }
        if (first > NIT) first = NIT; if (first + count > NIT) count = NIT - first;
    } else { const int per = (NIT + F.G - 1) / F.G; first = F.bid * per; count = per; if (first > NIT) first = NIT; if (first + count > NIT) count = NIT - first; }
    for (int q = F.wave; q < count; q += NWAVES) {
        const int it = first + q;
        const int e = it >> 8, blk = it & 255, kb = blk >> 4, nb = blk & 15, k0 = 64 * kb, n0 = 64 * nb;
        const float* src = a.in[I_WD] + ((size_t)(l * 16 + e) << 20) + (size_t)k0 * 1024 + n0;
        bf16_t* dst = WSP(bf16_t, WS_MOEW_DN) + ((size_t)e * 1024 + n0) * 1024 + k0;
        conv_item(src, 1024, 64, 64, nullptr, dst, 1024, scr, F.lane);
    }
}

__device__ __forceinline__ void shift_pass(Frame& F, CArgs& a, int ri) {
    const int gw = F.bid * NWAVES + F.wave, NGW = F.G * NWAVES, lane = F.lane;
    bf16_t* HB2 = WSP(bf16_t, WS_HB2);
    float* XSC = WSP(float, WS_RKVXS);
    const float* mix = a.in[I_MIX] + (size_t)ri * 6 * 1024;
    if (gw < 512) {
        const u32x4* wrow = (const u32x4*)(F.ws + WS_WCAT + ((size_t)ri * 3584 + 3072 + gw) * 4096);
        u32x4 wv[4];
#pragma unroll
        for (int q = 0; q < 4; ++q) wv[q] = wrow[lane + 64 * q];
        float wf[4][8]; float wam = 0.f;
#pragma unroll
        for (int q = 0; q < 4; ++q) { const unsigned ww[4] = {wv[q].x, wv[q].y, wv[q].z, wv[q].w};
#pragma unroll
            for (int i = 0; i < 4; ++i) { wf[q][2 * i] = bf2f(ww[i] & 0xffffu); wf[q][2 * i + 1] = bf2f(ww[i] >> 16); wam = fmaxf(wam, fmaxf(fabsf(wf[q][2 * i]), fabsf(wf[q][2 * i + 1]))); } }
        wam = wave_max(wam); const float winv = wam > 0.f ? 127.0f / wam : 0.f;
        unsigned char* wdst = F.ws + WS_WL8 + ((size_t)ri * 512 + gw) * 2048;
#pragma unroll
        for (int q = 0; q < 4; ++q) { unsigned o[2];
#pragma unroll
            for (int hh = 0; hh < 2; ++hh) { unsigned oo = 0u;
#pragma unroll
                for (int i = 0; i < 4; ++i) { const int qi = (int)__builtin_rintf(wf[q][4 * hh + i] * winv); oo |= ((unsigned)qi & 255u) << (8 * i); }
                o[hh] = oo; }
            *(u32x2*)(wdst + 8 * (lane + 64 * q)) = (u32x2){o[0], o[1]}; }
        if (lane == 0) WSP(float, WS_WL8S)[ri * 512 + gw] = wam * (1.0f / 127.0f);
    }
    f32x4 mzv[3][4];
#pragma unroll
    for (int z = 0; z < 3; ++z)
#pragma unroll
        for (int j = 0; j < 4; ++j) mzv[z][j] = *(const f32x4*)(mix + (z == 0 ? 0 : (z == 1 ? 2 : 3)) * 1024 + 4 * lane + 256 * j);
    for (int row = gw; row < NR; row += NGW) {
        bf16_t* hp = HB2 + (size_t)row * 2048;
        f32x4 xv3[3][4]; float am[3] = {0.f, 0.f, 0.f};
        f32x4 h4v[4], xxv[4]; float amh = 0.f;
        u32x2 hc[4], hn[4]; bool okj[4];
#pragma unroll
        for (int j = 0; j < 4; ++j) {
            int nrow; bool ok;
            if (row < NXR) { const int t = row & 2047, col = t & 63, rg = t >> 6;
                if (j == 0) { ok = col > 0; nrow = row - 1; } else if (j == 1) { ok = col < 63; nrow = row + 1; } else if (j == 2) { ok = rg > 0; nrow = row - 64; } else { ok = rg < 31; nrow = row + 64; } }
            else { const int t = (row - NXR) & 255; if (j < 2) { ok = t > 0; nrow = row - 1; } else { ok = t < 255; nrow = row + 1; } }
            const int c0 = 4 * lane + 256 * j;
            okj[j] = ok;
            hc[j] = *(const u32x2*)(hp + c0);
            hn[j] = *(const u32x2*)(HB2 + (size_t)(ok ? nrow : row) * 2048 + c0);
        }
#pragma unroll
        for (int j = 0; j < 4; ++j) {
            const int c0 = 4 * lane + 256 * j;
            const u32x2 hcj = hc[j]; u32x2 hnj = hn[j]; if (!okj[j]) hnj = (u32x2){0u, 0u};
            const f32x4 h4 = (f32x4){bf2f(hcj.x & 0xffffu), bf2f(hcj.x >> 16), bf2f(hcj.y & 0xffffu), bf2f(hcj.y >> 16)};
            const f32x4 xx = (f32x4){bf2f(hnj.x & 0xffffu), bf2f(hnj.x >> 16), bf2f(hnj.y & 0xffffu), bf2f(hnj.y >> 16)} - h4;
            h4v[j] = h4; xxv[j] = xx;
            amh = fmaxf(amh, fmaxf(fmaxf(fmaxf(fabsf(h4[0]), fabsf(h4[1])), fmaxf(fabsf(h4[2]), fabsf(h4[3]))), fmaxf(fmaxf(fabsf(xx[0]), fabsf(xx[1])), fmaxf(fabsf(xx[2]), fabsf(xx[3])))));
#pragma unroll
            for (int z = 0; z < 3; ++z) { const f32x4 v = h4 + xx * mzv[z][j]; xv3[z][j] = v;
                am[z] = fmaxf(am[z], fmaxf(fmaxf(fabsf(v[0]), fabsf(v[1])), fmaxf(fabsf(v[2]), fabsf(v[3])))); }
        }
        { const float amx = wave_max(amh); const float inv = amx > 0.f ? 127.0f / amx : 0.f;
          signed char* hq = (signed char*)hp + 2048;
#pragma unroll
          for (int j = 0; j < 4; ++j) { unsigned oh = 0u, ox = 0u;
#pragma unroll
              for (int i = 0; i < 4; ++i) { const int qh = (int)__builtin_rintf(h4v[j][i] * inv), qx = (int)__builtin_rintf(xxv[j][i] * inv); oh |= ((unsigned)qh & 255u) << (8 * i); ox |= ((unsigned)qx & 255u) << (8 * i); }
              *(unsigned*)(hq + 4 * lane + 256 * j) = oh; *(unsigned*)(hq + 1024 + 4 * lane + 256 * j) = ox; }
          if (lane == 0) WSP(float, WS_HXS)[row] = amx * (1.0f / 127.0f); }
#pragma unroll
        for (int z = 0; z < 3; ++z) {
            const float amz = wave_max(am[z]); const float inv = amz > 0.f ? 127.0f / amz : 0.f;
            signed char* xq = (signed char*)(F.ws + (z == 0 ? WS_XR : (z == 1 ? WS_XK : WS_XV))) + (size_t)row * D;
#pragma unroll
            for (int j = 0; j < 4; ++j) { unsigned o = 0u;
#pragma unroll
                for (int i = 0; i < 4; ++i) { const int qi = (int)__builtin_rintf(xv3[z][j][i] * inv); o |= ((unsigned)qi & 255u) << (8 * i); }
                *(unsigned*)(xq + 4 * lane + 256 * j) = o; }
            if (lane == 0) XSC[(size_t)z * NR + row] = amz * (1.0f / 127.0f);
        }
    }
}

__device__ __forceinline__ int block_excl_scan(Frame& F, int v, LAS int* wsum, int& total) {
    int x = v;
#pragma unroll
    for (int o = 1; o < 64; o <<= 1) { const int y = __builtin_amdgcn_ds_bpermute((F.lane - o) << 2, x); if (F.lane >= o) x += y; }
    if (F.lane == 63) wsum[F.wave] = x;
    __syncthreads();
    int off = 0; total = 0;
#pragma unroll
    for (int w = 0; w < 8; ++w) { const int s = wsum[w]; if (w < F.wave) off += s; total += s; }
    __syncthreads();
    return off + x - v;
}
__device__ __forceinline__ void topk_phase(Frame& F, bool with_ctx) {
    LAS unsigned* hist = (LAS unsigned*)F.lds;
    LAS int* wsum = (LAS int*)(F.lds + 1024);
    LAS int* sel = (LAS int*)(F.lds + 1536);
    LAS int* selrow = (LAS int*)(F.lds + 2048);
    const float* AFF = WSP(float, WS_AFF);
    float* GATE = WSP(float, WS_GATE); int* IDX = WSP(int, WS_IDX); short* INV = WSP(short, WS_INV);
    const bf16_t* HB = WSP(bf16_t, WS_HB); unsigned char* XS8 = WSP(unsigned char, WS_XS);
    const int ntask = with_ctx ? 512 : 256;
    for (int task = F.bid; task < ntask; task += F.G) {
        int n, C, row0, e, sr0;
        if (task < 256) { const int b = task >> 4; e = task & 15; n = TX; C = CAPX; row0 = b * TX; sr0 = (b * 16 + e) * CAPX; }
        else { const int q = task - 256, b = q >> 4; e = q & 15; n = TCX; C = CAPC; row0 = NXR + b * TCX; sr0 = NSX + (e * 16 + b) * CAPC; }
        unsigned key[4]; float val[4];
#pragma unroll
        for (int j = 0; j < 4; ++j) { const int t = F.tid * 4 + j; val[j] = AFF[(size_t)(row0 + (t < n ? t : n - 1)) * 16 + e]; }
#pragma unroll
        for (int j = 0; j < 4; ++j) { const int t = F.tid * 4 + j; if (t < n) key[j] = __float_as_uint(val[j]); else { val[j] = 0.f; key[j] = 0u; } }
        unsigned prefix = 0u, mask = 0u; int remaining = C;
#pragma unroll 1
        for (int pass = 0; pass < 4; ++pass) {
            const int shift = 24 - 8 * pass;
            if (F.tid < 256) hist[F.tid] = 0u;
            __syncthreads();
#pragma unroll
            for (int j = 0; j < 4; ++j) { const int t = F.tid * 4 + j; if (t < n && (key[j] & mask) == prefix) __hip_atomic_fetch_add(&hist[(key[j] >> shift) & 255u], 1u, __ATOMIC_RELAXED, __HIP_MEMORY_SCOPE_WORKGROUP); }
            __syncthreads();
            if (F.wave == 0) {
                const u32x4 hq = *(const LAS u32x4*)(hist + 4 * F.lane);
                const int h0 = (int)hq.x, h1 = (int)hq.y, h2 = (int)hq.z, h3 = (int)hq.w, tot = (h0 + h1) + (h2 + h3);
                int xs = tot;
#pragma unroll
                for (int o = 1; o < 64; o <<= 1) { const int y = __builtin_amdgcn_ds_bpermute((F.lane + o) << 2, xs); if (F.lane + o < 64) xs += y; }
                const int excl = xs - tot;
                const int c3 = excl + h3, c2 = c3 + h2, c1 = c2 + h1, c0 = c1 + h0;
                if (excl < remaining && c0 >= remaining) {
                    int d = 4 * F.lane, above = c1;
                    if (c3 >= remaining) { d += 3; above = excl; } else if (c2 >= remaining) { d += 2; above = c3; } else if (c1 >= remaining) { d += 1; above = c2; }
                    sel[0] = d; sel[1] = remaining - above;
                }
            }
            __syncthreads();
            const int d = sel[0]; remaining = sel[1]; prefix |= ((unsigned)d) << shift; mask |= 0xFFu << shift;
            __syncthreads();
        }
        const unsigned thr = prefix; const int need_eq = remaining;
        int ceq = 0;
#pragma unroll
        for (int j = 0; j < 4; ++j) { const int t = F.tid * 4 + j; ceq += (t < n && key[j] == thr) ? 1 : 0; }
        int tot; int req = block_excl_scan(F, ceq, wsum, tot);
        bool s[4]; int cnt = 0;
#pragma unroll
        for (int j = 0; j < 4; ++j) { const int t = F.tid * 4 + j; const bool valid = t < n; const bool gt = valid && key[j] > thr; const bool eq = valid && key[j] == thr;
            bool take = gt; if (eq) { take = req < need_eq; ++req; } s[j] = take; cnt += take ? 1 : 0; }
        int slot = block_excl_scan(F, cnt, wsum, tot);
#pragma unroll
        for (int j = 0; j < 4; ++j) { const int t = F.tid * 4 + j;
            if (t < n) { const int row = row0 + t;
                if (s[j]) { if (slot < C) { IDX[sr0 + slot] = row; GATE[sr0 + slot] = val[j]; selrow[slot] = row; } INV[(size_t)row * 16 + e] = (short)slot; ++slot; }
                else INV[(size_t)row * 16 + e] = (short)-1; } }
        __syncthreads();
        for (int sidx = F.wave; sidx < C; sidx += NWAVES) { const int row = selrow[sidx];
            const u32x4* src = (const u32x4*)(WSP(unsigned char, WS_HB) + (size_t)row * D);
            const u32x4 w = src[F.lane];
            *((u32x4*)(XS8 + (size_t)(sr0 + sidx) * D) + F.lane) = w;
            if (F.lane == 0) WSP(float, WS_XSCALE)[sr0 + sidx] = WSP(float, WS_HBSCALE)[row]; }
        __syncthreads();
    }
}

__device__ __forceinline__ float dpp_row_shr(float v, const int n) {
    int r;
    if (n == 1) r = __builtin_amdgcn_update_dpp(0, __float_as_int(v), 0x111, 0xF, 0xF, true);
    else if (n == 2) r = __builtin_amdgcn_update_dpp(0, __float_as_int(v), 0x112, 0xF, 0xF, true);
    else if (n == 4) r = __builtin_amdgcn_update_dpp(0, __float_as_int(v), 0x114, 0xF, 0xF, true);
    else r = __builtin_amdgcn_update_dpp(0, __float_as_int(v), 0x118, 0xF, 0xF, true);
    return __int_as_float(r);
}
__device__ __forceinline__ bf16x8 pack_2(const f32x4 d0, const f32x4 d1) {
    u32x4 w; w.x = pg8::cvt_pk_bf16(d0[0], d0[1]); w.y = pg8::cvt_pk_bf16(d0[2], d0[3]); w.z = pg8::cvt_pk_bf16(d1[0], d1[1]); w.w = pg8::cvt_pk_bf16(d1[2], d1[3]); return __builtin_bit_cast(bf16x8, w); }
typedef short bf16x4 __attribute__((ext_vector_type(4)));
__device__ __forceinline__ bf16x4 pack4(const f32x4 d) { u32x2 w; w.x = pg8::cvt_pk_bf16(d[0], d[1]); w.y = pg8::cvt_pk_bf16(d[2], d[3]); return __builtin_bit_cast(bf16x4, w); }
#define MFMA16(a, b, c) __builtin_amdgcn_mfma_f32_16x16x32_bf16((a), (b), (c), 0, 0, 0)
__device__ __forceinline__ bf16x8 widen4(const bf16x4 v) { const u32x2 t = __builtin_bit_cast(u32x2, v); u32x4 w; w.x = t.x; w.y = t.y; w.z = 0u; w.w = 0u; return __builtin_bit_cast(bf16x8, w); }
#define MFMA4(a, b, c) __builtin_amdgcn_mfma_f32_16x16x32_bf16(widen4(a), widen4(b), (c), 0, 0, 0)
__device__ __forceinline__ float dpp_row_last(float v) { return __int_as_float(__builtin_amdgcn_update_dpp(0, __float_as_int(v), 0x15F, 0xF, 0xF, false)); }
__device__ __forceinline__ f32x4 unpk4(const u32x2 w) { return (f32x4){__uint_as_float(w.x << 16), __uint_as_float(w.x & 0xffff0000u), __uint_as_float(w.y << 16), __uint_as_float(w.y & 0xffff0000u)}; }
__device__ __forceinline__ void scan_pipe(Frame& F, CArgs& a, int ri, const bf16_t* Vsrc, bf16_t* Y1buf) {
    const int lane = F.lane, x = lane & 15, g = lane >> 4;
    const f32x4 zero4 = (f32x4){0.f, 0.f, 0.f, 0.f};
    constexpr int NCH = (TCX + TX) / 16, NCH0 = TCX / 16;
    const int dir = F.wave >> 2, role = dir ? 3 - (F.wave & 3) : (F.wave & 3);
    if (role >= 2) __builtin_amdgcn_s_setprio(2);
    bf16_t* Yb = dir ? Y1buf : WSP(bf16_t, WS_Y0);
    float* BON = WSP(float, WS_BONUS) + (size_t)dir * NR * 16;
    LAS unsigned char* DB = F.lds + dir * 66560;
    LAS float* CST = (LAS float*)DB;
    LAS unsigned char* RINGQ = DB + 1024;
    LAS unsigned char* RINGV = DB + 17408;
    LAS unsigned char* OPS = DB + 23552;
    LAS unsigned char* C2 = DB + 40960;
    typedef const __attribute__((address_space(1))) char* gptr_t;
    size_t z0 = WS_R, z1 = WS_K; if (role == 1) { z0 = dir ? WS_A1 : WS_A0; z1 = dir ? WS_W1 : WS_W0; }
    const gptr_t gZ0 = (gptr_t)pg8::uni_ptr((const char*)(F.ws + z0)), gZ1 = (gptr_t)pg8::uni_ptr((const char*)(F.ws + z1)), gV = (gptr_t)pg8::uni_ptr((const char*)Vsrc);
    bf16x8 E0, E1;
    { u32x4 w0 = (u32x4){0u, 0u, 0u, 0u}, w1 = w0; const int d = x - 4 * g;
      const unsigned lo = (d == 0 || d == 2) ? 0x3F80u : 0u, hi = (d == 1 || d == 3) ? 0x3F800000u : 0u;
      if (d == 0 || d == 1) { w0.x = lo | hi; w1.z = lo | hi; } if (d == 2 || d == 3) { w0.y = lo | hi; w1.w = lo | hi; }
      E0 = __builtin_bit_cast(bf16x8, w0); E1 = __builtin_bit_cast(bf16x8, w1); }
    const bf16x4 E4 = __builtin_shufflevector(E0, E0, 0, 1, 2, 3);
    for (int task = F.bid; task < 256; task += F.G) {
        const int b = task >> 4, h = task & 15;
        if (role == 2) { CST[lane] = a.in[I_KK][ri * 1024 + 64 * h + lane]; CST[64 + lane] = a.in[I_KA][ri * 1024 + 64 * h + lane]; CST[128 + lane] = a.in[I_RK][ri * 1024 + 64 * h + lane]; }
        f32x4 ST[4][4];
#pragma unroll
        for (int vq = 0; vq < 4; ++vq)
#pragma unroll
            for (int q = 0; q < 4; ++q) ST[vq][q] = zero4;
#define SCAN_ROW(cc, tok) ((cc) < NCH0 ? (NXR + b * TCX + (dir ? (TCX - 1 - ((cc) * 16 + (tok))) : ((cc) * 16 + (tok)))) : (b * TX + (dir ? (TX - 1 - (((cc) - NCH0) * 16 + (tok))) : (((cc) - NCH0) * 16 + (tok)))))
#define SCAN_DMA(cc) do { LAS unsigned char* _dq = RINGQ + ((cc) & 1) * 8192 + role * 4096; LAS unsigned char* _dv = RINGV + ((cc) % 3) * 2048 + role * 1024; int _ln = lane; asm volatile("" : "+v"(_ln)); \
            const unsigned _r0 = (unsigned)(SCAN_ROW(cc, (_ln >> 3)) * D + 64 * h + 8 * (_ln & 7)) * 2u, _r1 = (unsigned)(SCAN_ROW(cc, (_ln >> 3) + 8) * D + 64 * h + 8 * (_ln & 7)) * 2u; \
            __builtin_amdgcn_global_load_lds((const __attribute__((address_space(1))) unsigned*)(gZ0 + _r0), (LAS unsigned*)(_dq), 16, 0, 0); \
            __builtin_amdgcn_global_load_lds((const __attribute__((address_space(1))) unsigned*)(gZ0 + _r1), (LAS unsigned*)(_dq + 1024), 16, 0, 0); \
            __builtin_amdgcn_global_load_lds((const __attribute__((address_space(1))) unsigned*)(gZ1 + _r0), (LAS unsigned*)(_dq + 2048), 16, 0, 0); \
            __builtin_amdgcn_global_load_lds((const __attribute__((address_space(1))) unsigned*)(gZ1 + _r1), (LAS unsigned*)(_dq + 3072), 16, 0, 0); \
            __builtin_amdgcn_global_load_lds((const __attribute__((address_space(1))) unsigned*)(gV + (role ? _r1 : _r0)), (LAS unsigned*)(_dv), 16, 0, 0); } while (0)
        if (role < 2) SCAN_DMA(0);
#pragma unroll 1
        for (int t = 0; t < NCH + 2; ++t) {
            if (role < 2) asm volatile("s_waitcnt vmcnt(0)" ::: "memory");
            asm volatile("s_waitcnt lgkmcnt(0)" ::: "memory");
            __builtin_amdgcn_s_barrier();
            asm volatile("" ::: "memory");
            if (role < 2) {
                if (t < NCH) {
                    const int cc = t;
                    if (cc + 1 < NCH) SCAN_DMA(cc + 1);
                    const LAS unsigned char* rw = RINGQ + (cc & 1) * 8192 + x * 128 + 8 * g;
                    LAS unsigned char* ob = OPS + (cc & 1) * 8704;
                    int cso = 4 * g; asm volatile("" : "+v"(cso));
                    float ssq = 0.f;
                    float bon = 0.f;
#pragma unroll
                    for (int u = 0; u < 2; ++u) {
                        const int q = 2 * role + u;
                        const f32x4 kkc = *(const LAS f32x4*)(CST + 16 * q + cso), kac = *(const LAS f32x4*)(CST + 64 + 16 * q + cso), rkc = *(const LAS f32x4*)(CST + 128 + 16 * q + cso);
                        const f32x4 rr = unpk4(*(const LAS u32x2*)(rw + 32 * q)), kv = unpk4(*(const LAS u32x2*)(rw + 2048 + 32 * q)), aa = unpk4(*(const LAS u32x2*)(rw + 4096 + 32 * q));
                        const f32x4 l2 = unpk4(*(const LAS u32x2*)(rw + 6144 + 32 * q)) * 1.44269504f;
                        const f32x4 kn = kv * kkc;
                        ssq += (kn[0] * kn[0] + kn[1] * kn[1]) + (kn[2] * kn[2] + kn[3] * kn[3]);
                        const f32x4 kd = kv * ((aa - 1.0f) * kac + 1.0f);
                        const f32x4 bq = rr * kd * rkc;
                        bon += (bq[0] + bq[1]) + (bq[2] + bq[3]);
                        f32x4 glq, at, bt, kt, rt;
#pragma unroll
                        for (int e = 0; e < 4; ++e) { float c = l2[e]; c += dpp_row_shr(c, 1); c += dpp_row_shr(c, 2); c += dpp_row_shr(c, 4); c += dpp_row_shr(c, 8);
                            const float e1 = __builtin_amdgcn_exp2f(c), e0 = __builtin_amdgcn_exp2f(c - l2[e]), e2 = __builtin_amdgcn_rcpf(e1);
                            glq[e] = dpp_row_last(e1); at[e] = -kn[e] * e0; bt[e] = kn[e] * aa[e] * e2; kt[e] = kd[e] * e2; rt[e] = rr[e] * e1; }
                        if (x == 0) *(LAS f32x4*)(ob + 8192 + (16 * g + 4 * q) * 4) = glq;
                        LAS unsigned char* op = ob + q * 512 + lane * 8;
                        *(LAS bf16x4*)(op) = pack4(at); *(LAS bf16x4*)(op + 2048) = pack4(bt); *(LAS bf16x4*)(op + 4096) = pack4(kt); *(LAS bf16x4*)(op + 6144) = pack4(rt);
                    }
                    bon += lane_xor(bon, 16, lane); bon += lane_xor(bon, 32, lane);
                    ssq += lane_xor(ssq, 16, lane); ssq += lane_xor(ssq, 32, lane);
                    if (g == 0) { *(LAS float*)(ob + 8192 + 256 + (role * 16 + x) * 4) = bon; *(LAS float*)(ob + 8192 + 384 + (role * 16 + x) * 4) = ssq; }
                }
            } else if (role == 2) {
                if (t >= 1 && t <= NCH) {
                    const int cc = t - 1;
                    const LAS unsigned char* ob = OPS + (cc & 1) * 8704;
                    LAS unsigned char* cb = C2 + (cc & 1) * 12544;
                    bf16x8 aP[2], bP[2], kP[2], rP[2];
                    { const LAS unsigned char* op = ob + lane * 8;
#pragma unroll
                      for (int s2 = 0; s2 < 2; ++s2) {
                          const u32x2 a0 = *(const LAS u32x2*)(op + (2 * s2) * 512), a1 = *(const LAS u32x2*)(op + (2 * s2 + 1) * 512);
                          const u32x2 b0 = *(const LAS u32x2*)(op + 2048 + (2 * s2) * 512), b1 = *(const LAS u32x2*)(op + 2048 + (2 * s2 + 1) * 512);
                          const u32x2 k0 = *(const LAS u32x2*)(op + 4096 + (2 * s2) * 512), k1 = *(const LAS u32x2*)(op + 4096 + (2 * s2 + 1) * 512);
                          const u32x2 r0 = *(const LAS u32x2*)(op + 6144 + (2 * s2) * 512), r1 = *(const LAS u32x2*)(op + 6144 + (2 * s2 + 1) * 512);
                          aP[s2] = __builtin_bit_cast(bf16x8, (u32x4){a0.x, a0.y, a1.x, a1.y}); bP[s2] = __builtin_bit_cast(bf16x8, (u32x4){b0.x, b0.y, b1.x, b1.y});
                          kP[s2] = __builtin_bit_cast(bf16x8, (u32x4){k0.x, k0.y, k1.x, k1.y}); rP[s2] = __builtin_bit_cast(bf16x8, (u32x4){r0.x, r0.y, r1.x, r1.y}); } }
                    *(LAS float*)(cb + 12288 + lane * 4) = *(const LAS float*)(ob + 8192 + lane * 4);
                    if (g == 0) { const LAS float* bp = (const LAS float*)(ob + 8192 + 256) + x; ((__attribute__((address_space(1))) float*)BON)[(size_t)SCAN_ROW(cc, x) * 16 + h] = bp[0] + bp[16]; }
                    LAS unsigned char* cl = cb + lane * 192;
                    *(LAS bf16x8*)(cl) = rP[0]; *(LAS bf16x8*)(cl + 16) = rP[1];
                    { const LAS unsigned char* vr = RINGV + (cc % 3) * 2048 + x * 128 + 8 * g;
#pragma unroll
                      for (int vq = 0; vq < 4; ++vq) *(LAS bf16x4*)(cl + 160 + 8 * vq) = pack4(MFMA4(__builtin_bit_cast(bf16x4, *(const LAS u32x2*)(vr + 32 * vq)), E4, zero4)); }
                    float rx; f32x4 r4;
                    { const LAS float* sq = (const LAS float*)(ob + 8192 + 384);
                      rx = __builtin_amdgcn_rsqf(sq[x] + sq[16 + x] + 1e-12f);
                      const f32x4 s0 = *(const LAS f32x4*)(sq + 4 * g), s1 = *(const LAS f32x4*)(sq + 16 + 4 * g);
#pragma unroll
                      for (int e = 0; e < 4; ++e) r4[e] = __builtin_amdgcn_rsqf(s0[e] + s1[e] + 1e-12f); }
                    f32x4 nA = MFMA16(bP[0], aP[0], zero4); nA = MFMA16(bP[1], aP[1], nA);
                    f32x4 nB = MFMA16(aP[0], bP[0], zero4); nB = MFMA16(aP[1], bP[1], nB);
                    f32x4 mak = MFMA16(kP[0], aP[0], zero4); mak = MFMA16(kP[1], aP[1], mak);
                    f32x4 mrb = MFMA16(bP[0], rP[0], zero4); mrb = MFMA16(bP[1], rP[1], mrb);
                    f32x4 mrk = MFMA16(kP[0], rP[0], zero4); mrk = MFMA16(kP[1], rP[1], mrk);
                    bf16x4 atT[4];
#pragma unroll
                    for (int q = 0; q < 4; ++q) { atT[q] = pack4(MFMA16(aP[q >> 1], (q & 1) ? E1 : E0, zero4) * r4);
                        *(LAS bf16x8*)(cl + 64 + 16 * q) = pack_2(MFMA16(bP[q >> 1], (q & 1) ? E1 : E0, zero4) * r4, MFMA16(kP[q >> 1], (q & 1) ? E1 : E0, zero4)); }
                    f32x4 eye;
#pragma unroll
                    for (int e = 0; e < 4; ++e) { const int j = 4 * g + e; const float rr2 = rx * r4[e]; nA[e] = (j < x) ? nA[e] * rr2 : 0.f; nB[e] = (j > x) ? nB[e] * rr2 : 0.f; mak[e] = (j < x) ? mak[e] * rx : 0.f; mrb[e] = (j <= x) ? mrb[e] * r4[e] : 0.f; mrk[e] = (j <= x) ? mrk[e] : 0.f; eye[e] = (j == x) ? 1.f : 0.f; }
                    const bf16x4 nAo = pack4(nA), nBo = pack4(nB);
                    *(LAS bf16x8*)(cl + 128) = pack_2(mrb, mrk);
                    *(LAS bf16x4*)(cl + 144) = pack4(mak);
                    const f32x4 m2B = MFMA4(nBo, nAo, zero4), m2A = MFMA4(nAo, nBo, zero4);
                    const bf16x4 m2Bo = pack4(m2B), m2Ao = pack4(m2A);
                    const f32x4 m4B = MFMA4(m2Ao, m2Bo, zero4), m4A = MFMA4(m2Bo, m2Ao, zero4);
                    const bf16x4 m4Bo = pack4(m4B), m4Ao = pack4(m4A);
                    const f32x4 m8A = MFMA4(m4Bo, m4Ao, zero4);
                    f32x4 X1 = eye + m2B; X1 = MFMA4(nBo, pack4(X1), X1);
                    X1 = MFMA4(m4Ao, pack4(X1), X1);
                    X1 = MFMA4(pack4(m8A), pack4(X1), X1);
                    const bf16x4 tA = pack4(X1);
                    *(LAS bf16x4*)(cl + 152) = tA;
                    { f32x4 ah[4];
#pragma unroll
                      for (int q = 0; q < 4; ++q) ah[q] = MFMA4(atT[q], tA, zero4);
                      *(LAS bf16x8*)(cl + 32) = pack_2(ah[0], ah[1]); *(LAS bf16x8*)(cl + 48) = pack_2(ah[2], ah[3]); }
                }
            } else {
                if (t >= 2) {
                    const int cc = t - 2;
                    const LAS unsigned char* cb = C2 + (cc & 1) * 12544;
                    const LAS unsigned char* cl = cb + lane * 192;
                    const bf16x8 rP0 = *(const LAS bf16x8*)(cl), rP1 = *(const LAS bf16x8*)(cl + 16), ahP0 = *(const LAS bf16x8*)(cl + 32), ahP1 = *(const LAS bf16x8*)(cl + 48);
                    bf16x8 bkT[4];
#pragma unroll
                    for (int q = 0; q < 4; ++q) bkT[q] = *(const LAS bf16x8*)(cl + 64 + 16 * q);
                    const bf16x8 mrbk = *(const LAS bf16x8*)(cl + 128);
                    const bf16x4 makA = *(const LAS bf16x4*)(cl + 144), tA = *(const LAS bf16x4*)(cl + 152);
                    f32x4 GL[4];
#pragma unroll
                    for (int q = 0; q < 4; ++q) GL[q] = *(const LAS f32x4*)(cb + 12288 + (16 * g + 4 * q) * 4);
#pragma unroll
                    for (int vq = 0; vq < 4; ++vq) {
                        const bf16x4 vT4 = *(const LAS bf16x4*)(cl + 160 + 8 * vq);
                        const f32x4 X = MFMA4(makA, vT4, zero4);
                        f32x4 U = MFMA4(tA, pack4(X), zero4);
                        const bf16x8 s0 = pack_2(ST[vq][0], ST[vq][1]), s1 = pack_2(ST[vq][2], ST[vq][3]);
                        U = MFMA16(ahP0, s0, U); U = MFMA16(ahP1, s1, U);
                        const u32x2 uu = __builtin_bit_cast(u32x2, pack4(U)), vv = __builtin_bit_cast(u32x2, vT4);
                        const bf16x8 uv = __builtin_bit_cast(bf16x8, (u32x4){uu.x, uu.y, vv.x, vv.y});
                        f32x4 Y = MFMA16(rP0, s0, zero4); Y = MFMA16(rP1, s1, Y); Y = MFMA16(mrbk, uv, Y);
#pragma unroll
                        for (int e = 0; e < 4; ++e) ((__attribute__((address_space(1))) bf16_t*)Yb)[(size_t)SCAN_ROW(cc, 4 * g + e) * D + 64 * h + 16 * vq + x] = (bf16_t)f2bf(Y[e]);
#pragma unroll
                        for (int q = 0; q < 4; ++q) ST[vq][q] = MFMA16(bkT[q], uv, ST[vq][q]) * GL[q];
                    }
                }
            }
        }
        asm volatile("s_waitcnt vmcnt(0) lgkmcnt(0)" ::: "memory");
        __builtin_amdgcn_s_barrier();
#undef SCAN_ROW
#undef SCAN_DMA
    }
    __builtin_amdgcn_s_setprio(0);
}
#undef MFMA16
#undef MFMA4

__device__ __forceinline__ void rwkv_out_pass(Frame& F, CArgs& a, int ri, const bf16_t* Vsrc, const bf16_t* Y1buf, int nrows) {
    const int gw = F.bid * NWAVES + F.wave, NGW = F.G * NWAVES, lane = F.lane;
    const bf16_t* Y0 = WSP(bf16_t, WS_Y0); const bf16_t* Gb = WSP(bf16_t, WS_G); bf16_t* OUTB = WSP(bf16_t, WS_OUTB);
    const float* BON = WSP(float, WS_BONUS);
    f32x4 lw[4], lb[4];
#pragma unroll
    for (int j = 0; j < 4; ++j) { lw[j] = *(const f32x4*)(a.in[I_LNW] + ri * 1024 + 4 * lane + 256 * j); lb[j] = *(const f32x4*)(a.in[I_LNB] + ri * 1024 + 4 * lane + 256 * j); }
    for (int row = gw; row < nrows; row += NGW) {
        const size_t base = (size_t)row * D + 4 * lane;
        u32x2 y0v[4], y1v[4], vvv[4], ggv[4]; float bonv[4]; float ov[4][4]; float am = 0.f;
#pragma unroll
        for (int j = 0; j < 4; ++j) { y0v[j] = *(const u32x2*)(Y0 + base + 256 * j); y1v[j] = *(const u32x2*)(Y1buf + base + 256 * j); vvv[j] = *(const u32x2*)(Vsrc + base + 256 * j); ggv[j] = *(const u32x2*)(Gb + base + 256 * j);
            const int head = 4 * j + (lane >> 4); bonv[j] = BON[(size_t)row * 16 + head] + BON[(size_t)NR * 16 + (size_t)row * 16 + head]; }
#pragma unroll
        for (int j = 0; j < 4; ++j) {
            const u32x2 y0 = y0v[j], y1 = y1v[j], vv = vvv[j], gg = ggv[j];
            float y[4] = { bf2f(y0.x & 0xffffu) + bf2f(y1.x & 0xffffu), bf2f(y0.x >> 16) + bf2f(y1.x >> 16), bf2f(y0.y & 0xffffu) + bf2f(y1.y & 0xffffu), bf2f(y0.y >> 16) + bf2f(y1.y >> 16) };
            float s = (y[0] + y[1]) + (y[2] + y[3]);
            s = row16_sum(s);
            const float mu = s * (1.0f / 64.0f);
            float q = 0.f;
#pragma unroll
            for (int i = 0; i < 4; ++i) { y[i] -= mu; q += y[i] * y[i]; }
            q = row16_sum(q);
            const float rstd = 1.0f / sqrtf(q * (1.0f / 64.0f) + 64e-5f);
            const float bon = bonv[j];
            const float v4[4] = { bf2f(vv.x & 0xffffu), bf2f(vv.x >> 16), bf2f(vv.y & 0xffffu), bf2f(vv.y >> 16) };
            const float g4[4] = { bf2f(gg.x & 0xffffu), bf2f(gg.x >> 16), bf2f(gg.y & 0xffffu), bf2f(gg.y >> 16) };
#pragma unroll
            for (int i = 0; i < 4; ++i) { ov[j][i] = (y[i] * rstd * lw[j][i] + lb[j][i] + bon * v4[i]) * g4[i]; am = fmaxf(am, fabsf(ov[j][i])); }
        }
        am = wave_max(am); const float inv = am > 0.f ? 127.0f / am : 0.f;
        signed char* oq = (signed char*)OUTB + (size_t)row * D;
#pragma unroll
        for (int j = 0; j < 4; ++j) { unsigned o = 0u;
#pragma unroll
            for (int i = 0; i < 4; ++i) { const int qi = (int)__builtin_rintf(ov[j][i] * inv); o |= ((unsigned)qi & 255u) << (8 * i); }
            *(unsigned*)(oq + 4 * lane + 256 * j) = o; }
        if (lane == 0) WSP(float, WS_OUTSC)[row] = am * (1.0f / 127.0f);
    }
}

using pg8::Unit;
typedef const f32x4 (&AccRef)[2][2][4][2];
template <int NN, int LDA_, int LDB_> struct ProbBase { static constexpr int LDA = LDA_, LDB = LDB_; int G, c, nM; const char* gA; const char* gB;
    __device__ __forceinline__ bool next(int i, Unit& u) const { return pg8::tile_order(i, G, c, nM, NN, u); } };

struct ProbF2 : ProbBase<576, 256, D> {
    __device__ __forceinline__ unsigned a_off(const Unit& u) const { return (unsigned)u.pm * 256 * 256 * 2; }
    __device__ __forceinline__ unsigned b_off(const Unit& u) const {
        if (u.pn < 512) { const int b = u.pn >> 5, g = (u.pn >> 3) & 3, tt = u.pn & 7; return (unsigned)((b * TX + 256 * tt) * D + 256 * g) * 2u; }
        const int q = u.pn - 512, b = q >> 2, g = q & 3; return (unsigned)((NXR + b * TCX) * D + 256 * g) * 2u; }
    __device__ __forceinline__ int nt(const Unit&) const { return 4; } };
struct EpiF2 { static constexpr bool PERM = true; bf16_t* YT; bf16_t* YTC;
    __device__ __forceinline__ void operator()(AccRef acc, const Unit& u, int wr, int wc, int fr, int fq) const {
        bf16_t* base; int ld;
        if (u.pn < 512) { const int b = u.pn >> 5, g = (u.pn >> 3) & 3, tt = u.pn & 7; base = YT + ((size_t)(b * 1024 + 256 * g) * 2 + u.pm) * 2048 + 256 * tt; ld = 4096; }
        else { const int q = u.pn - 512, b = q >> 2, g = q & 3; base = YTC + ((size_t)(b * 1024 + 256 * g) * 2 + u.pm) * 256; ld = 512; }
        const int col0 = wc * 32 + 8 * fq;
#pragma unroll
        for (int ai = 0; ai < 2; ++ai)
#pragma unroll
            for (int m = 0; m < 4; ++m) { bf16_t* rowp = base + (size_t)(wr * 64 + fr + ai * 128 + m * 16) * ld + col0;
#pragma unroll
                for (int bj = 0; bj < 2; ++bj) pg8::st8(rowp + bj * 128, acc[ai][bj][m][0], acc[ai][bj][m][1]); }
    } };
struct ProbF3X : ProbBase<4, 4096, 4096> {
    __device__ __forceinline__ unsigned a_off(const Unit& u) const { return (unsigned)(u.pm & 7) * 256 * 4096 * 2; }
    __device__ __forceinline__ unsigned b_off(const Unit& u) const { return (unsigned)((u.pm >> 3) * 1024 + 256 * u.pn) * 4096u * 2u; }
    __device__ __forceinline__ int nt(const Unit&) const { return 64; } };
struct ProbF3H : ProbBase<4, 4096, 4096> {
    __device__ __forceinline__ bool next(int i, Unit& u) const { const int pair = (i >> 1) * G + c; if (pair >= 256) return false; u.pm = pair >> 2; u.pn = (pair & 3) | ((i & 1) << 2); return true; }
    __device__ __forceinline__ unsigned a_off(const Unit& u) const { return (unsigned)(u.pm & 3) * 256u * 4096u * 2u + ((u.pn & 4) ? 4096u : 0u); }
    __device__ __forceinline__ unsigned b_off(const Unit& u) const { return (unsigned)((u.pm >> 2) * 1024 + 256 * (u.pn & 3)) * 4096u * 2u + ((u.pn & 4) ? 4096u : 0u); }
    __device__ __forceinline__ int nt(const Unit&) const { return 32; } };
struct EpiF3H { static constexpr bool PERM = true; bf16_t* OUT; f32x4* scratch; int bid;
    __device__ __forceinline__ void operator()(AccRef acc, const Unit& u, int wr, int wc, int fr, int fq) const {
        int tid = (wr * 4 + wc) * 64 + fq * 16 + fr; asm volatile("" : "+v"(tid));
        u32x4* sp = (u32x4*)scratch + (size_t)bid * 16 * 512 + tid;
        if (!(u.pn & 4)) {
#pragma unroll
            for (int ai = 0; ai < 2; ++ai)
#pragma unroll
                for (int bj = 0; bj < 2; ++bj)
#pragma unroll
                    for (int m = 0; m < 4; ++m) { const f32x4 c0 = acc[ai][bj][m][0], c1 = acc[ai][bj][m][1];
                        u32x4 w; w.x = pg8::cvt_pk_bf16(c0[0], c0[1]); w.y = pg8::cvt_pk_bf16(c0[2], c0[3]); w.z = pg8::cvt_pk_bf16(c1[0], c1[1]); w.w = pg8::cvt_pk_bf16(c1[2], c1[3]);
                        sp[((ai * 2 + bj) * 4 + m) * 512] = w; }
            return;
        }
        asm volatile("s_waitcnt vmcnt(0)" ::: "memory");
        int fr2 = fr; asm volatile("" : "+v"(fr2));
        const int b = u.pm >> 2, kt = u.pm & 3, col0 = 256 * (u.pn & 3) + wc * 32 + 8 * fq;
#pragma unroll
        for (int ai = 0; ai < 2; ++ai)
#pragma unroll
            for (int m = 0; m < 4; ++m) { const int k = 256 * kt + wr * 64 + fr2 + ai * 128 + m * 16;
                bf16_t* r1 = OUT + (size_t)(b * TX + k) * D + col0; bf16_t* r2 = OUT + (size_t)(b * TX + ((TX - k) & (TX - 1))) * D + col0;
#pragma unroll
                for (int bj = 0; bj < 2; ++bj) { const u32x4 pw = sp[((ai * 2 + bj) * 4 + m) * 512];
                    const f32x4 p0 = (f32x4){bf2f(pw.x & 0xffffu), bf2f(pw.x >> 16), bf2f(pw.y & 0xffffu), bf2f(pw.y >> 16)}, p1 = (f32x4){bf2f(pw.z & 0xffffu), bf2f(pw.z >> 16), bf2f(pw.w & 0xffffu), bf2f(pw.w >> 16)};
                    pg8::st8(r1 + bj * 128, p0 + acc[ai][bj][m][0], p1 + acc[ai][bj][m][1]);
                    if (k > 0) pg8::st8(r2 + bj * 128, p0 - acc[ai][bj][m][0], p1 - acc[ai][bj][m][1]); }
                __builtin_amdgcn_sched_barrier(0); }
    } };
struct ProbF3C : ProbBase<4, 512, 512> {
    __device__ __forceinline__ unsigned a_off(const Unit&) const { return 0u; }
    __device__ __forceinline__ unsigned b_off(const Unit& u) const { return (unsigned)(u.pm * 1024 + 256 * u.pn) * 512u * 2u; }
    __device__ __forceinline__ int nt(const Unit&) const { return 8; } };
struct EpiRows { static constexpr bool PERM = true; bf16_t* OUT; int row0, ld;
    __device__ __forceinline__ void operator()(AccRef acc, const Unit& u, int wr, int wc, int fr, int fq) const {
        bf16_t* base = OUT + (size_t)(row0 + 256 * u.pm) * ld + 256 * u.pn; const int col0 = wc * 32 + 8 * fq;
#pragma unroll
        for (int ai = 0; ai < 2; ++ai)
#pragma unroll
            for (int m = 0; m < 4; ++m) { bf16_t* rowp = base + (size_t)(wr * 64 + fr + ai * 128 + m * 16) * ld + col0;
#pragma unroll
                for (int bj = 0; bj < 2; ++bj) pg8::st8(rowp + bj * 128, acc[ai][bj][m][0], acc[ai][bj][m][1]); }
    } };
template <int NN, int LDA_, int LDB_, int NT> struct ProbRM : ProbBase<NN, LDA_, LDB_> {
    __device__ __forceinline__ unsigned a_off(const Unit& u) const { return (unsigned)u.pm * 256u * LDA_ * 2u; }
    __device__ __forceinline__ unsigned b_off(const Unit& u) const { return (unsigned)u.pn * 256u * LDB_ * 2u; }
    __device__ __forceinline__ int nt(const Unit&) const { return NT; } };
struct ProbRG1A : ProbBase<12, D, 2048> {
    __device__ __forceinline__ unsigned a_off(const Unit& u) const { const int grp = u.pn >> 2; return (grp == 2 ? (unsigned)(WS_XV - WS_XR) : (unsigned)grp * (unsigned)(WS_XK - WS_XR)) + (unsigned)u.pm * 256u * D * 2u; }
    __device__ __forceinline__ unsigned b_off(const Unit& u) const { return (unsigned)u.pn * 256u * 2048u * 2u; }
    __device__ __forceinline__ int nt(const Unit&) const { return 16; } };
struct ProbRG1A8 : ProbBase<12, 512, 2048> {
    __device__ __forceinline__ unsigned a_off(const Unit& u) const { const int grp = u.pn >> 2; return (grp == 2 ? (unsigned)(WS_XV - WS_XR) : (unsigned)grp * (unsigned)(WS_XK - WS_XR)) + (unsigned)u.pm * 256u * 1024u; }
    __device__ __forceinline__ unsigned b_off(const Unit& u) const { return (unsigned)u.pn * 256u * 4096u; }
    __device__ __forceinline__ int nt(const Unit&) const { return 8; } };
struct EpiRG1A8 { static constexpr bool PERM = true; unsigned char* ws; size_t voff; const float* XSC; const float* WSC;
    __device__ __forceinline__ void operator()(const pg8::i32x4 (&acc)[2][2][4][2], const Unit& u, int wr, int wc, int fr, int fq) const {
        const int which = u.pn >> 2; const size_t off = (which == 2) ? voff : WS_R + (size_t)which * (WS_K - WS_R);
        bf16_t* base = (bf16_t*)(ws + off) + (size_t)u.pm * 256 * D + (u.pn & 3) * 256 + wc * 32 + 8 * fq;
        const float* wsp = WSC + u.pn * 256 + wc * 32 + 8 * fq;
        f32x4 sw[2][2];
#pragma unroll
        for (int bj = 0; bj < 2; ++bj)
#pragma unroll
            for (int n = 0; n < 2; ++n) sw[bj][n] = *(const f32x4*)(wsp + 128 * bj + 4 * n);
        float sxv[2][4];
#pragma unroll
        for (int ai = 0; ai < 2; ++ai)
#pragma unroll
            for (int m = 0; m < 4; ++m) sxv[ai][m] = XSC[(size_t)which * NR + (size_t)u.pm * 256 + wr * 64 + fr + ai * 128 + m * 16];
#pragma unroll
        for (int ai = 0; ai < 2; ++ai)
#pragma unroll
            for (int m = 0; m < 4; ++m) { const int r = wr * 64 + fr + ai * 128 + m * 16; const float sx = sxv[ai][m];
#pragma unroll
                for (int bj = 0; bj < 2; ++bj) { f32x4 v0, v1;
#pragma unroll
                    for (int i = 0; i < 4; ++i) { v0[i] = (float)acc[ai][bj][m][0][i] * (sx * sw[bj][0][i]); v1[i] = (float)acc[ai][bj][m][1][i] * (sx * sw[bj][1][i]); }
                    pg8::st8(base + (size_t)r * D + 128 * bj, v0, v1); } }
    } };
struct ProbRG1B : ProbBase<2, 2048, 2048> {
    __device__ __forceinline__ bool next(int i, Unit& u) const { if (!pg8::tile_order(i, G, c, nM, 2, u)) return false; u.pn += 12; return true; }
    __device__ __forceinline__ unsigned a_off(const Unit& u) const { return (unsigned)u.pm * 256u * 2048u * 2u; }
    __device__ __forceinline__ unsigned b_off(const Unit& u) const { return (unsigned)u.pn * 256u * 2048u * 2u; }
    __device__ __forceinline__ int nt(const Unit&) const { return 32; } };
struct ProbRG1B8 : ProbBase<2, 2048, 1024> {
    __device__ __forceinline__ bool next(int i, Unit& u) const { if (!pg8::tile_order(i, G, c, nM, 2, u)) return false; u.pn += 12; return true; }
    __device__ __forceinline__ unsigned a_off(const Unit& u) const { return (unsigned)u.pm * 256u * 4096u + 2048u; }
    __device__ __forceinline__ unsigned b_off(const Unit& u) const { return (unsigned)(u.pn - 12) * 256u * 2048u; }
    __device__ __forceinline__ int nt(const Unit&) const { return 16; } };
struct EpiRG1B8 { static constexpr bool PERM = true; unsigned char* ws; const float* XSC; const float* WSC;
    __device__ __forceinline__ void operator()(const pg8::i32x4 (&acc)[2][2][4][2], const Unit& u, int wr, int wc, int fr, int fq) const {
        bf16_t* base = (bf16_t*)(ws + WS_A23) + (size_t)u.pm * 256 * 512 + (u.pn - 12) * 256; const int act = u.pn - 11;
        const int col0 = wc * 32 + 8 * fq;
        const float* wsp = WSC + (u.pn - 12) * 256 + col0;
        f32x4 sw[2][2];
#pragma unroll
        for (int bj = 0; bj < 2; ++bj)
#pragma unroll
            for (int n = 0; n < 2; ++n) sw[bj][n] = *(const f32x4*)(wsp + 128 * bj + 4 * n);
        float sxv[2][4];
#pragma unroll
        for (int ai = 0; ai < 2; ++ai)
#pragma unroll
            for (int m = 0; m < 4; ++m) sxv[ai][m] = XSC[(size_t)u.pm * 256 + wr * 64 + fr + ai * 128 + m * 16];
#pragma unroll
        for (int ai = 0; ai < 2; ++ai)
#pragma unroll
            for (int m = 0; m < 4; ++m) { bf16_t* rowp = base + (size_t)(wr * 64 + fr + ai * 128 + m * 16) * 512 + col0; const float sx = sxv[ai][m];
                f32x4 v0, v1, u0, u1;
#pragma unroll
                for (int i = 0; i < 4; ++i) { v0[i] = (float)acc[ai][0][m][0][i] * (sx * sw[0][0][i]); v1[i] = (float)acc[ai][0][m][1][i] * (sx * sw[0][1][i]);
                    u0[i] = (float)acc[ai][1][m][0][i] * (sx * sw[1][0][i]); u1[i] = (float)acc[ai][1][m][1][i] * (sx * sw[1][1][i]); }
                if (act == 1) {
#pragma unroll
                    for (int i = 0; i < 4; ++i) { v0[i] = tanhf_(v0[i]); v1[i] = tanhf_(v1[i]); } }
                else {
#pragma unroll
                    for (int i = 0; i < 4; ++i) { v0[i] = sigmoidf_(v0[i]); v1[i] = sigmoidf_(v1[i]); } }
                pg8::st8(rowp, v0, v1);
                pg8::st8(rowp + 128, u0, u1); }
    } };
struct EpiWO { static constexpr bool PERM = true; bf16_t* DELTA; const float* mod; const float* bias;
    __device__ __forceinline__ void operator()(AccRef acc, const Unit& u, int wr, int wc, int fr, int fq) const {
        const int b = u.pm < 128 ? (u.pm >> 3) : 16;
        const int col0 = u.pn * 256 + wc * 32 + 8 * fq; const float* gate = mod + (size_t)b * 6144 + 2 * 1024;
        f32x4 gv[2][2], bv[2][2];
#pragma unroll
        for (int bj = 0; bj < 2; ++bj)
#pragma unroll
            for (int n = 0; n < 2; ++n) { gv[bj][n] = *(const f32x4*)(gate + col0 + bj * 128 + 4 * n); bv[bj][n] = *(const f32x4*)(bias + col0 + bj * 128 + 4 * n); }
#pragma unroll
        for (int ai = 0; ai < 2; ++ai)
#pragma unroll
            for (int m = 0; m < 4; ++m) { bf16_t* rowp = DELTA + (size_t)(u.pm * 256 + wr * 64 + fr + ai * 128 + m * 16) * D + col0;
#pragma unroll
                for (int bj = 0; bj < 2; ++bj) pg8::st8(rowp + bj * 128, gv[bj][0] * (acc[ai][bj][m][0] + bv[bj][0]), gv[bj][1] * (acc[ai][bj][m][1] + bv[bj][1])); }
    } };
struct ProbWO8 : ProbBase<4, 512, 512> {
    __device__ __forceinline__ unsigned a_off(const Unit& u) const { return (unsigned)u.pm * 256u * 1024u; }
    __device__ __forceinline__ unsigned b_off(const Unit& u) const { return (unsigned)u.pn * 256u * 1024u; }
    __device__ __forceinline__ int nt(const Unit&) const { return 8; } };
struct EpiWO8 { static constexpr bool PERM = true; bf16_t* DELTA; const float* mod; const float* bias; const float* XSC; const float* WSC;
    __device__ __forceinline__ void operator()(const pg8::i32x4 (&acc)[2][2][4][2], const Unit& u, int wr, int wc, int fr, int fq) const {
        const int b = u.pm < 128 ? (u.pm >> 3) : 16;
        const int col0 = u.pn * 256 + wc * 32 + 8 * fq; const float* gate = mod + (size_t)b * 6144 + 2 * 1024;
        f32x4 gs[2][2], gb[2][2];
#pragma unroll
        for (int bj = 0; bj < 2; ++bj)
#pragma unroll
            for (int n = 0; n < 2; ++n) { const f32x4 g = *(const f32x4*)(gate + col0 + bj * 128 + 4 * n); gs[bj][n] = g * *(const f32x4*)(WSC + col0 + bj * 128 + 4 * n); gb[bj][n] = g * *(const f32x4*)(bias + col0 + bj * 128 + 4 * n); }
        float sxv[2][4];
#pragma unroll
        for (int ai = 0; ai < 2; ++ai)
#pragma unroll
            for (int m = 0; m < 4; ++m) sxv[ai][m] = XSC[(size_t)u.pm * 256 + wr * 64 + fr + ai * 128 + m * 16];
#pragma unroll
        for (int ai = 0; ai < 2; ++ai)
#pragma unroll
            for (int m = 0; m < 4; ++m) { bf16_t* rowp = DELTA + (size_t)(u.pm * 256 + wr * 64 + fr + ai * 128 + m * 16) * D + col0; const float sx = sxv[ai][m];
#pragma unroll
                for (int bj = 0; bj < 2; ++bj) { f32x4 v0, v1;
#pragma unroll
                    for (int i = 0; i < 4; ++i) { v0[i] = (float)acc[ai][bj][m][0][i] * (sx * gs[bj][0][i]) + gb[bj][0][i]; v1[i] = (float)acc[ai][bj][m][1][i] * (sx * gs[bj][1][i]) + gb[bj][1][i]; }
                    pg8::st8(rowp + bj * 128, v0, v1); } }
    } };
struct EpiRG1 { static constexpr bool PERM = true; unsigned char* ws; size_t voff;
    __device__ __forceinline__ void operator()(AccRef acc, const Unit& u, int wr, int wc, int fr, int fq) const {
        bf16_t* base; int ld; int act = 0;
        if (u.pn < 12) { const int which = u.pn >> 2; const size_t off = (which == 2) ? voff : WS_R + (size_t)which * (WS_K - WS_R);
            base = (bf16_t*)(ws + off) + (size_t)u.pm * 256 * D + (u.pn & 3) * 256; ld = D; }
        else { base = (bf16_t*)(ws + WS_A23) + (size_t)u.pm * 256 * 512 + (u.pn - 12) * 256; ld = 512; act = u.pn - 11; }
        const int col0 = wc * 32 + 8 * fq;
#pragma unroll
        for (int ai = 0; ai < 2; ++ai)
#pragma unroll
            for (int m = 0; m < 4; ++m) { bf16_t* rowp = base + (size_t)(wr * 64 + fr + ai * 128 + m * 16) * ld + col0;
                f32x4 v0 = acc[ai][0][m][0], v1 = acc[ai][0][m][1];
                if (act == 1) {
#pragma unroll
                    for (int i = 0; i < 4; ++i) { v0[i] = tanhf_(v0[i]); v1[i] = tanhf_(v1[i]); } }
                else if (act == 2) {
#pragma unroll
                    for (int i = 0; i < 4; ++i) { v0[i] = sigmoidf_(v0[i]); v1[i] = sigmoidf_(v1[i]); } }
                pg8::st8(rowp, v0, v1);
                pg8::st8(rowp + 128, acc[ai][1][m][0], acc[ai][1][m][1]); }
    } };
struct ProbRG2 : ProbBase<24, 512, 256> { int nn;
    __device__ __forceinline__ bool next(int i, Unit& u) const { return pg8::tile_order(i, G, c, nM, nn, u); }
    __device__ __forceinline__ unsigned a_off(const Unit& u) const { return ((unsigned)u.pm * 256u * 512u + (u.pn >= 16 ? 256u : 0u)) * 2u; }
    __device__ __forceinline__ unsigned b_off(const Unit& u) const { return (unsigned)u.pn * 256u * 256u * 2u; }
    __device__ __forceinline__ int nt(const Unit&) const { return 4; } };
struct EpiRG2 { static constexpr bool PERM = true; unsigned char* ws; const float *w0, *a0, *v0;
    __device__ __forceinline__ void operator()(AccRef acc, const Unit& u, int wr, int wc, int fr, int fq) const {
        const int grp = u.pn >> 2, colb = (u.pn & 3) * 256;
        size_t doff = WS_W0; if (grp == 1) doff = WS_W1; if (grp == 2) doff = WS_A0; if (grp == 3) doff = WS_A1; if (grp == 4) doff = WS_G; if (grp == 5) doff = WS_VB;
        bf16_t* dst = (bf16_t*)(ws + doff); bf16_t* Vb = (bf16_t*)(ws + WS_VB); const bf16_t* VF = (const bf16_t*)(ws + WS_VFIRST);
        const float* bias = w0 + grp * 1024; if (grp >= 2) bias = a0 + (grp - 2) * 1024; if (grp >= 4) bias = v0;
        const int col0 = colb + wc * 32 + 8 * fq;
        f32x4 bv[2][2];
#pragma unroll
        for (int bj = 0; bj < 2; ++bj)
#pragma unroll
            for (int n = 0; n < 2; ++n) bv[bj][n] = (grp == 4) ? (f32x4){0.f, 0.f, 0.f, 0.f} : *(const f32x4*)(bias + col0 + bj * 128 + 4 * n);
#pragma unroll
        for (int ai = 0; ai < 2; ++ai)
#pragma unroll
            for (int m = 0; m < 4; ++m) { const size_t ro = (size_t)(u.pm * 256 + wr * 64 + fr + ai * 128 + m * 16) * D + col0;
#pragma unroll
                for (int bj = 0; bj < 2; ++bj) {
                    f32x4 v0v = acc[ai][bj][m][0] + bv[bj][0], v1v = acc[ai][bj][m][1] + bv[bj][1];
                    if (grp < 2) {
#pragma unroll
                        for (int i = 0; i < 4; ++i) { v0v[i] = -0.60653066f * sigmoidf_(v0v[i]); v1v[i] = -0.60653066f * sigmoidf_(v1v[i]); } }
                    else if (grp < 4) {
#pragma unroll
                        for (int i = 0; i < 4; ++i) { v0v[i] = sigmoidf_(v0v[i]); v1v[i] = sigmoidf_(v1v[i]); } }
                    else if (grp == 5) {
                        const u32x4 vp = *(const u32x4*)(Vb + ro + bj * 128), vf = *(const u32x4*)(VF + ro + bj * 128);
                        const unsigned vpw[4] = {vp.x, vp.y, vp.z, vp.w}, vfw[4] = {vf.x, vf.y, vf.z, vf.w};
                        float pv[8], fv[8];
#pragma unroll
                        for (int i = 0; i < 4; ++i) { pv[2 * i] = bf2f(vpw[i] & 0xffffu); pv[2 * i + 1] = bf2f(vpw[i] >> 16); fv[2 * i] = bf2f(vfw[i] & 0xffffu); fv[2 * i + 1] = bf2f(vfw[i] >> 16); }
#pragma unroll
                        for (int i = 0; i < 4; ++i) { v0v[i] = pv[i] + (fv[i] - pv[i]) * sigmoidf_(v0v[i]); v1v[i] = pv[4 + i] + (fv[4 + i] - pv[4 + i]) * sigmoidf_(v1v[i]); } }
                    pg8::st8(dst + ro + bj * 128, v0v, v1v);
                } }
    } };
__device__ __forceinline__ void lora2_phase(Frame& F, const ProbRG2& P, const EpiRG2& E) {
    const int wid = F.wave, lane = F.lane, wr = wid >> 2, wc = wid & 3, fr = lane & 15, fq = lane >> 4;
    const bf16_t* A23 = (const bf16_t*)P.gA; const bf16_t* W2 = (const bf16_t*)P.gB;
    Unit u;
    for (int i = 0; P.next(i, u); ++i) {
        const int grp = u.pn >> 2;
        const int acol0 = grp < 4 ? 64 * grp : (grp == 4 ? 256 : 384), bcol0 = grp < 4 ? 64 * grp : (grp == 4 ? 0 : 128), K = grp < 4 ? 64 : (grp == 4 ? 128 : 32);
        f32x4 acc[2][2][4][2];
#pragma unroll
        for (int a = 0; a < 2; ++a)
#pragma unroll
            for (int b = 0; b < 2; ++b)
#pragma unroll
                for (int m = 0; m < 4; ++m)
#pragma unroll
                    for (int n = 0; n < 2; ++n) acc[a][b][m][n] = (f32x4){0.f, 0.f, 0.f, 0.f};
        __builtin_amdgcn_s_setprio(1);
        const bf16_t* arow = A23 + (size_t)(u.pm * 256 + wr * 64 + fr) * 512 + acol0 + 8 * fq;
        const bf16_t* brow[2][2];
#pragma unroll
        for (int bj = 0; bj < 2; ++bj)
#pragma unroll
            for (int n = 0; n < 2; ++n) { const int rho = 128 * bj + 32 * wc + 16 * n + fr; brow[bj][n] = W2 + (size_t)(u.pn * 256 + (rho & ~31) + pg8::perm32(rho & 31)) * 256 + bcol0 + 8 * fq; }
#pragma unroll 1
        for (int k0 = 0; k0 < K; k0 += 64) {
            const bool two = (K - k0) >= 64;
            bf16x8 Bf[2][2][2];
#pragma unroll
            for (int bj = 0; bj < 2; ++bj)
#pragma unroll
                for (int n = 0; n < 2; ++n) { Bf[bj][n][0] = *(const bf16x8*)(brow[bj][n] + k0); Bf[bj][n][1] = two ? *(const bf16x8*)(brow[bj][n] + k0 + 32) : (bf16x8){0, 0, 0, 0, 0, 0, 0, 0}; }
#pragma unroll
            for (int ai = 0; ai < 2; ++ai) {
                bf16x8 Af[4][2];
#pragma unroll
                for (int m = 0; m < 4; ++m) { const bf16_t* ap = arow + (size_t)(128 * ai + 16 * m) * 512 + k0; Af[m][0] = *(const bf16x8*)ap; Af[m][1] = two ? *(const bf16x8*)(ap + 32) : (bf16x8){0, 0, 0, 0, 0, 0, 0, 0}; }
#pragma unroll
                for (int bj = 0; bj < 2; ++bj)
#pragma unroll
                    for (int m = 0; m < 4; ++m)
#pragma unroll
                        for (int n = 0; n < 2; ++n) {
                            acc[ai][bj][m][n] = __builtin_amdgcn_mfma_f32_16x16x32_bf16(Bf[bj][n][0], Af[m][0], acc[ai][bj][m][n], 0, 0, 0);
                            acc[ai][bj][m][n] = __builtin_amdgcn_mfma_f32_16x16x32_bf16(Bf[bj][n][1], Af[m][1], acc[ai][bj][m][n], 0, 0, 0);
                        }
            }
        }
        __builtin_amdgcn_s_setprio(0);
        E(acc, u, wr, wc, fr, fq);
    }
}
template <int NN, int ROWS_PER_E> struct ProbMoE : ProbBase<NN, D, D> {
    __device__ __forceinline__ bool next(int i, Unit& u) const { if (!pg8::tile_order(i, this->G, this->c, this->nM, NN, u)) return false;
        if (this->nM == NS / 256) { const int e = u.pm / 18, r = u.pm % 18; u.pm = r < 16 ? r * 16 + e : 256 + 2 * e + (r - 16); } else { const int e = u.pm >> 4, r = u.pm & 15; u.pm = r * 16 + e; }
        return true; }
    __device__ __forceinline__ unsigned a_off(const Unit& u) const { return (unsigned)u.pm * 256u * D * 2u; }
    __device__ __forceinline__ unsigned b_off(const Unit& u) const { const int e = u.pm < 256 ? (u.pm & 15) : ((u.pm - 256) >> 1); return (unsigned)(e * ROWS_PER_E + 256 * u.pn) * D * 2u; }
    __device__ __forceinline__ int nt(const Unit&) const { return 16; } };
template <int NN> struct ProbMoE8 : ProbBase<NN, 512, 512> {
    __device__ __forceinline__ bool next(int i, Unit& u) const { if (!pg8::tile_order(i, this->G, this->c, this->nM, NN, u)) return false;
        if (this->nM == NS / 256) { const int e = u.pm / 18, r = u.pm % 18; u.pm = r < 16 ? r * 16 + e : 256 + 2 * e + (r - 16); } else { const int e = u.pm >> 4, r = u.pm & 15; u.pm = r * 16 + e; }
        return true; }
    __device__ __forceinline__ unsigned a_off(const Unit& u) const { return (unsigned)u.pm * 256u * 1024u; }
    __device__ __forceinline__ unsigned b_off(const Unit& u) const { const int e = u.pm < 256 ? (u.pm & 15) : ((u.pm - 256) >> 1); return (unsigned)(e * 2048 + 256 * u.pn) * 1024u; }
    __device__ __forceinline__ int nt(const Unit&) const { return 8; } };
struct EpiGU8 { static constexpr bool PERM = true; bf16_t* HID; const float* XSC; const float* WSC;
    __device__ __forceinline__ void operator()(const pg8::i32x4 (&acc)[2][2][4][2], const Unit& u, int wr, int wc, int fr, int fq) const {
        const int e = u.pm < 256 ? (u.pm & 15) : ((u.pm - 256) >> 1);
        const float* wsp = WSC + e * 2048 + 256 * u.pn + wc * 32 + 8 * fq;
        const f32x4 sg0 = *(const f32x4*)(wsp), sg1 = *(const f32x4*)(wsp + 4), su0 = *(const f32x4*)(wsp + 128), su1 = *(const f32x4*)(wsp + 132);
        bf16_t* base = HID + (size_t)u.pm * 256 * D + 128 * u.pn + wc * 32 + 8 * fq;
        float sxv[2][4];
#pragma unroll
        for (int ai = 0; ai < 2; ++ai)
#pragma unroll
            for (int m = 0; m < 4; ++m) sxv[ai][m] = XSC[(size_t)u.pm * 256 + wr * 64 + fr + ai * 128 + m * 16];
#pragma unroll
        for (int ai = 0; ai < 2; ++ai)
#pragma unroll
            for (int m = 0; m < 4; ++m) { const int r = wr * 64 + fr + ai * 128 + m * 16; const float sx = sxv[ai][m]; f32x4 h0, h1;
#pragma unroll
                for (int i = 0; i < 4; ++i) { const float g0 = (float)acc[ai][0][m][0][i] * (sx * sg0[i]), g1 = (float)acc[ai][0][m][1][i] * (sx * sg1[i]);
                    h0[i] = g0 * sigmoidf_(g0) * ((float)acc[ai][1][m][0][i] * (sx * su0[i])); h1[i] = g1 * sigmoidf_(g1) * ((float)acc[ai][1][m][1][i] * (sx * su1[i])); }
                pg8::st8(base + (size_t)r * D, h0, h1); }
    } };
struct EpiGU { static constexpr bool PERM = true; bf16_t* HID;
    __device__ __forceinline__ void operator()(AccRef acc, const Unit& u, int wr, int wc, int fr, int fq) const {
        bf16_t* base = HID + (size_t)u.pm * 256 * D + 128 * u.pn + wc * 32 + 8 * fq;
#pragma unroll
        for (int ai = 0; ai < 2; ++ai)
#pragma unroll
            for (int m = 0; m < 4; ++m) { f32x4 h0, h1;
#pragma unroll
                for (int i = 0; i < 4; ++i) { const float g0 = acc[ai][0][m][0][i], g1 = acc[ai][0][m][1][i]; h0[i] = g0 * sigmoidf_(g0) * acc[ai][1][m][0][i]; h1[i] = g1 * sigmoidf_(g1) * acc[ai][1][m][1][i]; }
                pg8::st8(base + (size_t)(wr * 64 + fr + ai * 128 + m * 16) * D, h0, h1); }
    } };
struct EpiDN { static constexpr bool PERM = true; bf16_t* YS; const float* GATE;
    __device__ __forceinline__ void operator()(AccRef acc, const Unit& u, int wr, int wc, int fr, int fq) const {
        const int col0 = 256 * u.pn + wc * 32 + 8 * fq;
#pragma unroll
        for (int ai = 0; ai < 2; ++ai)
#pragma unroll
            for (int m = 0; m < 4; ++m) { const size_t row = (size_t)u.pm * 256 + wr * 64 + fr + ai * 128 + m * 16;
#pragma unroll
                for (int bj = 0; bj < 2; ++bj) pg8::st8(YS + row * D + col0 + bj * 128, acc[ai][bj][m][0], acc[ai][bj][m][1]); }
    } };

__device__ __forceinline__ void f3_nyquist_row(Frame& F) {
    const int gw = F.bid * NWAVES + F.wave, NGW = F.G * NWAVES, lane = F.lane;
    const bf16_t* YT = WSP(bf16_t, WS_YT); bf16_t* OUT = WSP(bf16_t, WS_OUTB);
    for (int task = gw; task < NB * D; task += NGW) {
        const u32x4* yp = (const u32x4*)(YT + (size_t)task * 4096);
        float se = 0.f, so = 0.f;
#pragma unroll
        for (int j = 0; j < 4; ++j) { const u32x4 w = yp[lane + 64 * j];
            se += (bf2f(w.x & 0xffffu) + bf2f(w.y & 0xffffu)) + (bf2f(w.z & 0xffffu) + bf2f(w.w & 0xffffu));
            so += (bf2f(w.x >> 16) + bf2f(w.y >> 16)) + (bf2f(w.z >> 16) + bf2f(w.w >> 16)); }
        const float tot = wave_sum(se - so) * 0.022097087f;
        if (lane == 0) OUT[(size_t)((task >> 10) * TX + TX / 2) * D + (task & 1023)] = (bf16_t)f2bf(tot);
    }
}

constexpr int STEPS_PER_LAYER = 11, STEP_FINAL = 1 + 4 * STEPS_PER_LAYER, NSTEPS = STEP_FINAL + 1;
#ifndef SCAN_IMPL
#define SCAN_IMPL 1
#endif
#define SCAN_FN scan_pipe
#ifndef PH_MASK
#define PH_MASK 0xFFFFFFFFu
#endif
#define EN(k) (((PH_MASK) >> (k)) & 1u)
#ifndef PROBE_DUP
#define PROBE_DUP -1
#endif
#define REP(k) _Pragma("unroll 1") for (int _rep = 0; _rep < ((PROBE_DUP) == (k) ? 2 : 1); ++_rep)

__device__ __forceinline__ bool relaunder(Frame& F) { unsigned long long v = (unsigned long long)F.ws; asm volatile("" : "+s"(v)); F.ws = (unsigned char*)(__attribute__((address_space(1))) unsigned char*)v;
    int w = F.wave; asm volatile("" : "+s"(w)); F.wave = w;
    int ln = (int)__builtin_amdgcn_mbcnt_hi(~0u, __builtin_amdgcn_mbcnt_lo(~0u, 0u)); asm volatile("" : "+v"(ln)); F.lane = ln; F.tid = w * 64 + ln; return true; }
__device__ __forceinline__ void grid_sync(unsigned char* ws, LAS unsigned char* lds) {
    XcdBarrier bar; bar.bar = (unsigned*)(ws + WS_CTL); bar.x = xb_xcc_id(); bar.st = (volatile LAS unsigned*)(lds + MISC_OFF);
    xcd_barrier(bar);
}

__global__ void __launch_bounds__(NTHR, 2) fwd(Args a_unused) {
    extern __shared__ __attribute__((aligned(16))) unsigned char lds_raw[];
    Frame F;
    F.lds = (LAS unsigned char*)lds_raw;
    F.tid = threadIdx.x; F.lane = F.tid & 63; F.wave = __builtin_amdgcn_readfirstlane(F.tid >> 6);
    CArgs* ap0 = (CArgs*)__builtin_amdgcn_kernarg_segment_ptr();
    F.G = gridDim.x; F.bid = blockIdx.x; F.ws = ap0->ws;
    const int lo = ap0->ph_lo, hi = ap0->ph_hi;
#define a (*launder_args(ap0))
    if (hi - lo > 1) {
        volatile LAS unsigned* MISC = (volatile LAS unsigned*)(F.lds + MISC_OFF);
        if (F.tid < 4) MISC[F.tid] = 0u;
        __syncthreads();
        (void)xcd_barrier_post((unsigned*)(F.ws + WS_CTL), MISC);
    }
#define IN(s) ((lo <= (s) && (s) < hi) && relaunder(F))
#define END(s) do { if (hi > (s) + 1) grid_sync(F.ws, F.lds); } while (0)
#define PINIT(P, nm, abase, bbase) do { P.G = F.G; P.c = F.bid; P.nM = (nm); P.gA = (const char*)(F.ws + (abase)); P.gB = (const char*)(F.ws + (bbase)); } while (0)

    if (EN(0) && IN(0)) { REP(0) p0_prologue(F, a); END(0); }

#pragma unroll 1
    for (int l = 0; l < 4; ++l) {
        const int s0 = 1 + l * STEPS_PER_LAYER;
        if (EN(1) && IN(s0 + 0)) {
            if (l & 1) row_pass<1>(F, a, l, true, NR); else row_pass<0>(F, a, l, l > 0, NR);
            END(s0 + 0);
        }
        if (!(l & 1)) {
            if (EN(2) && IN(s0 + 1)) {
                ProbF2 P; PINIT(P, 2, WS_CH, WS_HB);
                EpiF2 E; E.YT = WSP(bf16_t, WS_YT); E.YTC = WSP(bf16_t, WS_YTC);
                REP(2) pg8::gemm_phase(F.lds, F.tid, P, E);
                END(s0 + 1);
            }
            if (EN(3) && IN(s0 + 2)) {
                { ProbF3H P; PINIT(P, 64, WS_SEQX, WS_YT);
                  EpiF3H E; E.OUT = WSP(bf16_t, WS_OUTB); E.scratch = WSP(f32x4, WS_END); E.bid = F.bid;
                  pg8::gemm_phase(F.lds, F.tid, P, E);
                  f3_nyquist_row(F); }
                { ProbF3C P; PINIT(P, 16, WS_SEQC, WS_YTC);
                  EpiRows E; E.OUT = WSP(bf16_t, WS_OUTB); E.row0 = NXR; E.ld = D;
                  pg8::gemm_phase(F.lds, F.tid, P, E); }
                END(s0 + 2);
            }
        } else {
            if (EN(4) && IN(s0 + 1)) { shift_pass(F, a, l >> 1); END(s0 + 1); }
            if (EN(5) && IN(s0 + 2)) {
                EpiRG1 E; E.ws = F.ws; E.voff = (l == 1) ? WS_VFIRST : WS_VB;
                { ProbRG1B8 P; PINIT(P, NR / 256, WS_HB2, WS_WL8 + (size_t)(l >> 1) * 512 * 2048);
                  EpiRG1B8 EB; EB.ws = F.ws; EB.XSC = WSP(float, WS_HXS); EB.WSC = WSP(float, WS_WL8S) + (l >> 1) * 512;
                  pg8::gemm_phase<ProbRG1B8, EpiRG1B8, true>(F.lds, F.tid, P, EB); }
                { ProbRG1A8 P; PINIT(P, NR / 256, WS_XR, WS_WCAT + (size_t)(l >> 1) * 3584 * 2048 * 2); P.c = (F.bid + 192) & 255; if (F.G != 256) P.c = F.bid;
                  EpiRG1A8 E8; E8.ws = F.ws; E8.voff = (l == 1) ? WS_VFIRST : WS_VB; E8.XSC = WSP(float, WS_RKVXS); E8.WSC = WSP(float, WS_RKVWS) + (l >> 1) * 3072;
                  pg8::gemm_phase<ProbRG1A8, EpiRG1A8, true>(F.lds, F.tid, P, E8); }
                END(s0 + 2);
            }
            if (EN(6) && IN(s0 + 3)) {
                const int ri = l >> 1;
                ProbRG2 P; PINIT(P, NR / 256, WS_A23, WS_W2CAT + (size_t)ri * 6144 * 256 * 2); P.nn = (l == 1) ? 20 : 24;
                EpiRG2 E; E.ws = F.ws; E.w0 = a.in[I_W0] + ri * 2048; E.a0 = a.in[I_A0] + ri * 2048; E.v0 = a.in[I_V0];
                lora2_phase(F, P, E);
                END(s0 + 3);
            }
            if (EN(7) && IN(s0 + 4)) { REP(7) SCAN_FN(F, a, l >> 1, (l == 1) ? WSP(bf16_t, WS_VFIRST) : WSP(bf16_t, WS_VB), (l == 1) ? WSP(bf16_t, WS_VB) : WSP(bf16_t, WS_VFIRST)); END(s0 + 4); }
            if (EN(8) && IN(s0 + 5)) { rwkv_out_pass(F, a, l >> 1, (l == 1) ? WSP(bf16_t, WS_VFIRST) : WSP(bf16_t, WS_VB), (l == 1) ? WSP(bf16_t, WS_VB) : WSP(bf16_t, WS_VFIRST), (l < 3) ? NR : NXR); END(s0 + 5); }
        }
        if (EN(9) && IN(s0 + 6)) {
            ProbRM<4, D, D, 16> P; PINIT(P, (l < 3) ? NR / 256 : NXR / 256, WS_OUTB, WS_WOT + (size_t)l * D * D * 2);
            EpiWO E; E.DELTA = WSP(bf16_t, WS_DELTA); E.mod = WSP(float, WS_MOD) + (size_t)l * 17 * 6144; E.bias = WSP(float, WS_WOB) + l * 1024;
            if (l & 1) {
                ProbWO8 P8; PINIT(P8, (l < 3) ? NR / 256 : NXR / 256, WS_OUTB, WS_WO8 + (size_t)(l >> 1) * 1048576);
                EpiWO8 E8; E8.DELTA = E.DELTA; E8.mod = E.mod; E8.bias = E.bias; E8.XSC = WSP(float, WS_OUTSC); E8.WSC = WSP(float, WS_WO8S) + (l >> 1) * 1024;
                if (F.bid & 1) { moe_weight_conv(F, a, l, (l < 3) ? 576 : 512); __syncthreads(); pg8::gemm_phase<ProbWO8, EpiWO8, true>(F.lds, F.tid, P8, E8); }
                else { pg8::gemm_phase<ProbWO8, EpiWO8, true>(F.lds, F.tid, P8, E8); moe_weight_conv(F, a, l, (l < 3) ? 576 : 512); }
            } else {
            if (F.bid & 1) { moe_weight_conv(F, a, l, (l < 3) ? 576 : 512); __syncthreads(); pg8::gemm_phase(F.lds, F.tid, P, E); }
            else { pg8::gemm_phase(F.lds, F.tid, P, E); moe_weight_conv(F, a, l, (l < 3) ? 576 : 512); }
            }
            END(s0 + 6);
        }
        if (EN(10) && IN(s0 + 7)) { row_pass<2>(F, a, l, false, (l < 3) ? NR : NXR); END(s0 + 7); }
        if (EN(11) && IN(s0 + 8)) { REP(11) topk_phase(F, l < 3); END(s0 + 8); }
        if (EN(12) && IN(s0 + 9)) {
            ProbMoE8<8> P; PINIT(P, (l < 3) ? NS / 256 : NSX / 256, WS_XS, WS_MOEW_GU);
            EpiGU8 E; E.HID = WSP(bf16_t, WS_HID); E.XSC = WSP(float, WS_XSCALE); E.WSC = WSP(float, WS_WSCALE);
            pg8::gemm_phase<ProbMoE8<8>, EpiGU8, true>(F.lds, F.tid, P, E);
            END(s0 + 9);
        }
        if (EN(13) && IN(s0 + 10)) {
            ProbMoE<4, 1024> P; PINIT(P, (l < 3) ? NS / 256 : NSX / 256, WS_HID, WS_MOEW_DN);
            EpiDN E; E.YS = WSP(bf16_t, WS_YS); E.GATE = WSP(float, WS_GATE);
            REP(13) pg8::gemm_phase(F.lds, F.tid, P, E);
            END(s0 + 10);
        }
    }
    if (EN(14) && IN(STEP_FINAL)) { row_pass<3>(F, a, 3, true, NXR); }
#undef IN
#undef END
#undef PINIT
#undef a
}

extern "C" void kernel_launch(void* const* d_in, const int* in_sizes, int n_in, void* d_out, int out_size, void* d_ws, size_t ws_size, hipStream_t stream) {
    static int grid = 0;
    if (grid == 0) {
        if (n_in != 35 || out_size != NXR * D || ws_size < WS_TOTAL) { fprintf(stderr, "kernel_launch: unexpected shapes (n_in %d out %d ws %zu need %zu)\n", n_in, out_size, ws_size, (size_t)WS_TOTAL); grid = -1; return; }
        int dev = 0, cus = 0, per_cu = 0;
        if (hipGetDevice(&dev) != hipSuccess || hipDeviceGetAttribute(&cus, hipDeviceAttributeMultiprocessorCount, dev) != hipSuccess) { grid = -1; return; }
        if (hipFuncSetAttribute((const void*)fwd, hipFuncAttributeMaxDynamicSharedMemorySize, LDS_BYTES) != hipSuccess) { fprintf(stderr, "kernel_launch: hipFuncSetAttribute failed\n"); grid = -1; return; }
        if (hipOccupancyMaxActiveBlocksPerMultiprocessor(&per_cu, (const void*)fwd, NTHR, LDS_BYTES) != hipSuccess || per_cu < 1) fprintf(stderr, "kernel_launch: occupancy query says %d\n", per_cu);
        (void)hipGetLastError();
        grid = cus > 0 ? cus : 256;
    }
    if (grid < 0) return;
    if (hipMemsetAsync((char*)d_ws + WS_CTL, 0, WS_ZERO_BYTES, stream) != hipSuccess) return;
    Args a{};
    for (int i = 0; i < 35; ++i) a.in[i] = (const float*)d_in[i];
    a.out = (float*)d_out; a.ws = (unsigned char*)d_ws;
#if MK_SINGLE
    a.ph_lo = 0; a.ph_hi = NSTEPS;
    hipLaunchKernelGGL(fwd, dim3(grid), dim3(NTHR), LDS_BYTES, stream, a);
#else
    for (int s = 0; s < NSTEPS; ++s) {
        if (s >= 1 && s < STEP_FINAL) { const int l = (s - 1) / STEPS_PER_LAYER, k = (s - 1) % STEPS_PER_LAYER; if (!(l & 1) && k >= 3 && k <= 5) continue; }
        a.ph_lo = s; a.ph_hi = s + 1;
        hipLaunchKernelGGL(fwd, dim3(grid), dim3(NTHR), LDS_BYTES, stream, a);
    }
#endif
}
```

```cpp
#include <hip/hip_runtime.h>
#include <cstdio>
#include <cstdint>
#include <type_traits>

#ifndef MK_SINGLE
#define MK_SINGLE 1
#endif

#define LAS __attribute__((address_space(3)))
typedef unsigned short bf16_t;
typedef short bf16x8 __attribute__((ext_vector_type(8)));
typedef float f32x4 __attribute__((ext_vector_type(4)));
typedef float f32x2 __attribute__((ext_vector_type(2)));
typedef unsigned u32x4 __attribute__((ext_vector_type(4)));
typedef unsigned u32x2 __attribute__((ext_vector_type(2)));

constexpr int D = 1024, NB = 16, TX = 2048, TCX = 256, NXR = NB * TX, NCR = NB * TCX, NR = NXR + NCR;
constexpr int NE = 16, CAPX = 256, CAPC = 32, NSX = NB * NE * CAPX, NSC = NB * NE * CAPC, NS = NSX + NSC;
constexpr int NWAVES = 8, NTHR = 512;
constexpr int LDS_BYTES = 147456, MISC_OFF = LDS_BYTES - 256;

constexpr size_t MiB = 1u << 20;
constexpr size_t WS_CTL = 0, WS_W2CAT = 1 * MiB, WS_WCAT = 7 * MiB, WS_ZERO_BYTES = 35 * MiB;
constexpr size_t WS_MOD = 35 * MiB, WS_CTXR = 37 * MiB, WS_WOT = 53 * MiB, WS_CH = 61 * MiB, WS_SEQC = 61 * MiB + 512 * 1024, WS_SEQX = 62 * MiB;
constexpr size_t WS_AFF = 78 * MiB, WS_GATE = 81 * MiB, WS_IDX = 81 * MiB + 512 * 1024, WS_INV = 82 * MiB, WS_BONUS = 84 * MiB, WS_WOB = 89 * MiB;
constexpr size_t WS_HXS = 41 * MiB, WS_WL8 = 42 * MiB, WS_WL8S = 44 * MiB;
constexpr size_t WS_WO8 = 37 * MiB, WS_WO8S = 39 * MiB, WS_OUTSC = 40 * MiB;
constexpr size_t WS_RKVWS = 89 * MiB + 64 * 1024;
constexpr size_t WS_RKVXS = 78 * MiB;
constexpr size_t WS_HBSCALE = 83 * MiB + 256 * 1024;
constexpr size_t WS_XSCALE = 89 * MiB + 256 * 1024, WS_WSCALE = 89 * MiB + 640 * 1024;
constexpr size_t WS_MOEW = 90 * MiB, WS_MOEW_GU = WS_MOEW, WS_MOEW_DN = WS_MOEW + 64 * MiB, WS_G = WS_MOEW;
constexpr size_t WS_VFIRST = 186 * MiB, WS_ARENA = 258 * MiB;
constexpr size_t WS_HB2 = WS_ARENA, WS_HB = WS_ARENA, WS_OUTB = WS_ARENA, WS_W0 = WS_ARENA, WS_W1 = WS_ARENA + 72 * MiB;
constexpr size_t WS_YS = WS_ARENA + 144 * MiB, WS_A0 = WS_ARENA + 144 * MiB, WS_A1 = WS_ARENA + 216 * MiB;
constexpr size_t WS_XS = WS_ARENA + 288 * MiB, WS_YT = WS_ARENA + 288 * MiB, WS_YTC = WS_ARENA + 416 * MiB, WS_R = WS_ARENA + 288 * MiB, WS_K = WS_ARENA + 360 * MiB;
constexpr size_t WS_HID = WS_ARENA + 432 * MiB, WS_VB = WS_ARENA + 432 * MiB, WS_A23 = WS_ARENA + 504 * MiB, WS_Y0 = WS_ARENA + 504 * MiB;
constexpr size_t WS_XR = WS_ARENA + 144 * MiB, WS_XK = WS_ARENA + 216 * MiB, WS_XV = WS_ARENA + 576 * MiB;
constexpr size_t WS_DELTA = WS_XV;
constexpr size_t WS_END = WS_ARENA + 648 * MiB;
constexpr size_t WS_XB = WS_END + 64 * MiB, WS_TOTAL = WS_XB + (size_t)NR * D * 2;

__device__ __forceinline__ float bf2f(unsigned b) { return __uint_as_float(b << 16); }
typedef __bf16 bf16x2_t __attribute__((ext_vector_type(2)));
__device__ __forceinline__ unsigned pk2(float lo, float hi) { const f32x2 v = {lo, hi}; const bf16x2_t b = __builtin_convertvector(v, bf16x2_t); return __builtin_bit_cast(unsigned, b); }
__device__ __forceinline__ unsigned f2bf(float f) { return pk2(f, 0.f) & 0xffffu; }
#define DPP_F(v, ctrl) __int_as_float(__builtin_amdgcn_update_dpp(0, __float_as_int(v), (ctrl), 0xF, 0xF, true))
__device__ __forceinline__ float row16_sum(float v) {
    v += DPP_F(v, 0xB1); v += DPP_F(v, 0x4E); v += DPP_F(v, 0x141); v += DPP_F(v, 0x140); return v; }
__device__ __forceinline__ float wave_sum(float v) {
    v = row16_sum(v);
    return (__int_as_float(__builtin_amdgcn_readlane(__float_as_int(v), 0)) + __int_as_float(__builtin_amdgcn_readlane(__float_as_int(v), 16))) + (__int_as_float(__builtin_amdgcn_readlane(__float_as_int(v), 32)) + __int_as_float(__builtin_amdgcn_readlane(__float_as_int(v), 48))); }
__device__ __forceinline__ float wave_max(float v) {
    v = fmaxf(v, DPP_F(v, 0xB1)); v = fmaxf(v, DPP_F(v, 0x4E)); v = fmaxf(v, DPP_F(v, 0x141)); v = fmaxf(v, DPP_F(v, 0x140));
    return fmaxf(fmaxf(__int_as_float(__builtin_amdgcn_readlane(__float_as_int(v), 0)), __int_as_float(__builtin_amdgcn_readlane(__float_as_int(v), 16))), fmaxf(__int_as_float(__builtin_amdgcn_readlane(__float_as_int(v), 32)), __int_as_float(__builtin_amdgcn_readlane(__float_as_int(v), 48)))); }
__device__ __forceinline__ float lane_xor(float v, int mask, int lane) { return __int_as_float(__builtin_amdgcn_ds_bpermute((lane ^ mask) << 2, __float_as_int(v))); }
__device__ __forceinline__ float sigmoidf_(float x) { return __builtin_amdgcn_rcpf(1.0f + __expf(-x)); }
__device__ __forceinline__ float tanhf_(float x) { const float e = __expf(-2.0f * fabsf(x)); const float t = (1.0f - e) * __builtin_amdgcn_rcpf(1.0f + e); return x < 0.f ? -t : t; }

#define XB_TMO      128
#define XB_XCNT(j)  (256  + 64 * (j))
#define XB_XSUB(j)  (1280 + 64 * (j))
#define XB_XGEN(j)  (2304 + 64 * (j))
#define XB_TOP      3328
#define XB_TOPGEN   3392
#define XCD_BAR_WORDS 3456
#define XB_SPIN_CAP (1u << 22)
__device__ __forceinline__ unsigned xb_ld(unsigned* p)              { return __hip_atomic_load(p, __ATOMIC_RELAXED, __HIP_MEMORY_SCOPE_AGENT); }
__device__ __forceinline__ unsigned xb_add(unsigned* p, unsigned v) { return __hip_atomic_fetch_add(p, v, __ATOMIC_RELAXED, __HIP_MEMORY_SCOPE_AGENT); }
__device__ __forceinline__ unsigned xb_xcc_id() { return (unsigned)__builtin_amdgcn_s_getreg((3 << 11) | 20) & 0xFu; }
#define XB_SPIN(cond, bar) do { unsigned _sp = 0; while (cond) { __builtin_amdgcn_s_sleep(1); \
    if ((++_sp & 255u) == 0u) { if (xb_ld(&(bar)[XB_TMO])) break; if (_sp > XB_SPIN_CAP) { atomicAdd(&(bar)[XB_TMO], 1u); break; } } } } while (0)
struct XcdBarrier { unsigned* bar; unsigned x; volatile LAS unsigned* st; };
__device__ __forceinline__ XcdBarrier xcd_barrier_post(unsigned* bar, volatile LAS unsigned* st) {
    XcdBarrier b; b.bar = bar; b.x = xb_xcc_id(); b.st = st;
    if (threadIdx.x == 0) (void)xb_add(&bar[XB_XCNT(b.x)], 1u);
    return b;
}
__device__ __forceinline__ void xcd_barrier_complete(unsigned* bar, unsigned x, unsigned& nloc, unsigned& nx) {
    const unsigned G = gridDim.x * gridDim.y * gridDim.z;
    unsigned sum, cnt, mine, sp = 0u;
    for (;;) {
        sum = 0u; cnt = 0u; mine = 0u;
#pragma unroll
        for (unsigned j = 0; j < 16; ++j) { const unsigned c = xb_ld(&bar[XB_XCNT(j)]); sum += c; cnt += (c > 0u) ? 1u : 0u; mine = (j == x) ? c : mine; }
        if (sum == G) break;
        __builtin_amdgcn_s_sleep(1);
        if ((++sp & 255u) == 0u) { if (xb_ld(&bar[XB_TMO])) break; if (sp > XB_SPIN_CAP) { atomicAdd(&bar[XB_TMO], 1u); break; } }
    }
    nloc = mine > 0u ? mine : 1u; nx = cnt > 0u ? cnt : 1u;
}
__device__ __forceinline__ void xcd_barrier(const XcdBarrier& b) {
    asm volatile("s_waitcnt vmcnt(0)" ::: "memory");
    __syncthreads();
    if (threadIdx.x == 0) {
        unsigned* bar = b.bar;
        __builtin_amdgcn_s_waitcnt(0);
        unsigned nloc = b.st[0], nx = b.st[1];
        if (nloc == 0u) { xcd_barrier_complete(bar, b.x, nloc, nx); b.st[0] = nloc; b.st[1] = nx; }
        const unsigned old = xb_add(&bar[XB_XSUB(b.x)], 1u);
        const unsigned gen = old / nloc;
        if (old + 1u == (gen + 1u) * nloc) {
            __builtin_amdgcn_fence(__ATOMIC_RELEASE, "agent");
            asm volatile("s_waitcnt vmcnt(0)" ::: "memory");
            const unsigned og = xb_add(&bar[XB_TOP], 1u);
            const unsigned tg = og / nx;
            if (og + 1u == (tg + 1u) * nx) xb_add(&bar[XB_TOPGEN], 1u);
            else XB_SPIN(xb_ld(&bar[XB_TOPGEN]) == tg, bar);
            __builtin_amdgcn_fence(__ATOMIC_ACQUIRE, "agent");
            xb_add(&bar[XB_XGEN(b.x)], 1u);
            asm volatile("s_waitcnt vmcnt(0)" ::: "memory");
        } else {
            XB_SPIN(xb_ld(&bar[XB_XGEN(b.x)]) == gen, bar);
            __builtin_amdgcn_fence(__ATOMIC_ACQUIRE, "agent");
            asm volatile("s_waitcnt vmcnt(0)" ::: "memory");
        }
    }
    __syncthreads();
}

namespace pg8 {
constexpr int BM = 256, BK = 64, HALF = 128, HTB = HALF * BK * 2, STAGE_BYTES = 8 * HTB, NXCD = 8, WGM = 8;
__device__ __forceinline__ int lds_byte(int r, int c) { const int st = (r >> 4) * 2 + (c >> 5), rr = r & 15, cc = c & 31, ob = rr * 64 + cc * 2; return st * 1024 + (ob ^ (((ob >> 9) & 1) << 5)); }
__device__ __forceinline__ void stage_rc(int b, int& R, int& C) { const int st = b / 1024, sb = b % 1024, swz = sb ^ (((sb >> 9) & 1) << 5); R = (st >> 1) * 16 + swz / 64; C = (st & 1) * 32 + (swz % 64) / 2; }
__device__ __forceinline__ int perm32(int rho) { const int n = rho >> 4, i = rho & 15; return 8 * (i >> 2) + 4 * n + (i & 3); }
struct Unit { int pm, pn; };
__device__ __forceinline__ bool tile_order(int i, int G, int c, int nM, int nN, Unit& u) {
    const int nwg = nM * nN; const long L = (long)i * G + c; if (L >= nwg) return false;
    int wgid = (int)L; { const int q = nwg / NXCD, r = nwg % NXCD, xcd = wgid % NXCD, off = wgid / NXCD; wgid = (xcd < r ? xcd * (q + 1) : r * (q + 1) + (xcd - r) * q) + off; }
    const int nig = WGM * nN, gid = wgid / nig, fm = gid * WGM, gsz = (nM - fm) < WGM ? (nM - fm) : WGM;
    u.pm = fm + ((wgid % nig) % gsz); u.pn = (wgid % nig) / gsz; return true;
}
__device__ __forceinline__ unsigned cvt_pk_bf16(float lo, float hi) { const f32x2 v = {lo, hi}; const bf16x2_t b = __builtin_convertvector(v, bf16x2_t); return __builtin_bit_cast(unsigned, b); }

__device__ __forceinline__ const char* uni_ptr(const char* p) { const unsigned long long v = (unsigned long long)p;
    const unsigned lo = __builtin_amdgcn_readfirstlane((unsigned)v), hi = __builtin_amdgcn_readfirstlane((unsigned)(v >> 32)); return (const char*)(((unsigned long long)hi << 32) | lo); }
typedef int i32x4 __attribute__((ext_vector_type(4)));
template <bool I8> __device__ __forceinline__ f32x4 mma_step(const bf16x8 b, const bf16x8 a, const f32x4 c) { return __builtin_amdgcn_mfma_f32_16x16x32_bf16(b, a, c, 0, 0, 0); }
template <bool I8> __device__ __forceinline__ i32x4 mma_step(const bf16x8 b, const bf16x8 a, const i32x4 c) { return __builtin_amdgcn_mfma_i32_16x16x64_i8(__builtin_bit_cast(i32x4, b), __builtin_bit_cast(i32x4, a), c, 0, 0, 0); }
template <class Prob, class Epi, bool I8 = false>
__device__ __forceinline__ void gemm_phase(LAS unsigned char* lds, int tid, const Prob& P, const Epi& E) {
    typedef typename std::conditional<I8, i32x4, f32x4>::type acc_t;
    asm volatile("" : "+v"(tid));
    const int wid = __builtin_amdgcn_readfirstlane(tid >> 6), lane = tid & 63, wr = wid >> 2, wc = wid & 3, fr = lane & 15, fq = lane >> 4;
    constexpr int lda = Prob::LDA, ldb = Prob::LDB;
    unsigned voffA[2], voffB[2];
#pragma unroll
    for (int i = 0; i < 2; ++i) { int R, C; stage_rc(tid * 16 + i * 8192, R, C); const int Rb = Epi::PERM ? ((R & ~31) + perm32(R & 31)) : R;
        voffA[i] = (unsigned)(R * lda + C) * 2u; voffB[i] = (unsigned)(Rb * ldb + C) * 2u; }
    constexpr unsigned kstep = (unsigned)(BK * 2);
    constexpr unsigned hstepA = (unsigned)HALF * lda * 2, hstepB = (unsigned)HALF * ldb * 2;
    const unsigned ldsw = (unsigned)wid * 1024u;
    const int aoff = lds_byte(wr * 64 + fr, fq * 8), boff = lds_byte(wc * 32 + fr, fq * 8);
    typedef const __attribute__((address_space(1))) char* gptr_t;
    const gptr_t gA = (gptr_t)uni_ptr(P.gA), gB = (gptr_t)uni_ptr(P.gB);
#define PG8_SA(b, h) (((b) * 2 + (h)) * HTB)
#define PG8_SB(b, h) ((4 + (b) * 2 + (h)) * HTB)
#define PG8_STAGE(bufoff, gbase, uoff, voff) do { _Pragma("unroll") for (int _i = 0; _i < 2; ++_i) \
        __builtin_amdgcn_global_load_lds((const __attribute__((address_space(1))) unsigned*)((gbase) + (unsigned)((uoff) + (voff)[_i])), (LAS unsigned*)(lds + (bufoff) + ldsw + _i * 8192), 16, 0, 0); } while (0)
#define PG8_STA(bufoff, uoff) PG8_STAGE(bufoff, gA, uoff, voffA)
#define PG8_STB(bufoff, uoff) PG8_STAGE(bufoff, gB, uoff, voffB)
#define PG8_LDA(dst, b, h) do { _Pragma("unroll") for (int m = 0; m < 4; ++m) _Pragma("unroll") for (int k = 0; k < 2; ++k) dst[m][k] = *(const LAS bf16x8*)(lds + PG8_SA(b, h) + aoff + m * 2048 + k * 1024); } while (0)
#define PG8_LDB(dst, b, h) do { _Pragma("unroll") for (int n = 0; n < 2; ++n) _Pragma("unroll") for (int k = 0; k < 2; ++k) dst[n][k] = *(const LAS bf16x8*)(lds + PG8_SB(b, h) + boff + n * 2048 + k * 1024); } while (0)
#define PG8_MMA(ai, bj, At, Bt) do { __builtin_amdgcn_s_setprio(1); _Pragma("unroll") for (int m = 0; m < 4; ++m) _Pragma("unroll") for (int n = 0; n < 2; ++n) _Pragma("unroll") for (int k = 0; k < 2; ++k) \
        acc[ai][bj][m][n] = mma_step<I8>(Bt[n][k], At[m][k], acc[ai][bj][m][n]); __builtin_amdgcn_s_setprio(0); } while (0)
#define PG8_WAIT_V(n) asm volatile("s_waitcnt vmcnt(" #n ")" ::: "memory")
#define PG8_WAIT_L(n) asm volatile("s_waitcnt lgkmcnt(" #n ")" ::: "memory")
#define PG8_BAR __builtin_amdgcn_s_barrier()
#define PG8_SCHED __builtin_amdgcn_sched_barrier(0)
    Unit cur, nxt; int ui = 0;
    if (!P.next(0, cur)) return;
    acc_t acc[2][2][4][2];
#pragma unroll
    for (int a = 0; a < 2; ++a)
#pragma unroll
        for (int b = 0; b < 2; ++b)
#pragma unroll
            for (int m = 0; m < 4; ++m)
#pragma unroll
                for (int n = 0; n < 2; ++n) acc[a][b][m][n] = (acc_t){0, 0, 0, 0};
    bf16x8 At[4][2], B0[2][2], B1[2][2];
    unsigned cA = __builtin_amdgcn_readfirstlane(P.a_off(cur)), cB = __builtin_amdgcn_readfirstlane(P.b_off(cur)); int nt = P.nt(cur);
    PG8_STB(PG8_SB(0, 0), cB); PG8_STB(PG8_SB(0, 1), cB + hstepB); PG8_STA(PG8_SA(0, 0), cA); PG8_STA(PG8_SA(0, 1), cA + hstepA);
    if (wr == 1) PG8_BAR;
    PG8_WAIT_V(2); PG8_BAR;
    PG8_STB(PG8_SB(1, 0), cB + kstep); PG8_STA(PG8_SA(1, 0), cA + kstep); PG8_STB(PG8_SB(1, 1), cB + hstepB + kstep);
    PG8_WAIT_V(6); PG8_BAR;
    for (;;) {
        const bool has_next = P.next(ui + 1, nxt);
        const unsigned nA = has_next ? __builtin_amdgcn_readfirstlane(P.a_off(nxt)) : cA, nB = has_next ? __builtin_amdgcn_readfirstlane(P.b_off(nxt)) : cB;
#pragma unroll 1
        for (int t = 0; t < nt; t += 2) {
            const bool last = (t == nt - 2);
            const unsigned a1 = cA + (unsigned)(t + 1) * kstep;
            const unsigned a2 = last ? nA : cA + (unsigned)(t + 2) * kstep, b2 = last ? nB : cB + (unsigned)(t + 2) * kstep;
            const unsigned a3 = a2 + kstep, b3 = b2 + kstep;
            PG8_LDB(B0, 0, 0); PG8_LDB(B1, 0, 1); PG8_SCHED; PG8_LDA(At, 0, 0); PG8_STA(PG8_SA(1, 1), a1 + hstepA);
            PG8_WAIT_V(8); PG8_WAIT_L(0); PG8_BAR; PG8_MMA(0, 0, At, B0); PG8_MMA(0, 1, At, B1); PG8_BAR; PG8_SCHED;
            PG8_LDA(At, 0, 1); PG8_STB(PG8_SB(0, 0), b2); PG8_STB(PG8_SB(0, 1), b2 + hstepB); PG8_STA(PG8_SA(0, 0), a2);
            PG8_WAIT_V(8); PG8_WAIT_L(0); PG8_BAR; PG8_MMA(1, 0, At, B0); PG8_MMA(1, 1, At, B1); PG8_BAR; PG8_SCHED;
            PG8_LDB(B0, 1, 0); PG8_LDB(B1, 1, 1); PG8_SCHED; PG8_LDA(At, 1, 0); PG8_STA(PG8_SA(0, 1), a2 + hstepA);
            PG8_WAIT_V(8); PG8_WAIT_L(0); PG8_BAR; PG8_MMA(0, 0, At, B0); PG8_MMA(0, 1, At, B1); PG8_BAR; PG8_SCHED;
            PG8_LDA(At, 1, 1); PG8_STB(PG8_SB(1, 0), b3); PG8_STB(PG8_SB(1, 1), b3 + hstepB); PG8_STA(PG8_SA(1, 0), a3);
            PG8_WAIT_V(8); PG8_WAIT_L(0); PG8_BAR; PG8_MMA(1, 0, At, B0); PG8_MMA(1, 1, At, B1); PG8_BAR; PG8_SCHED;
        }
        if (wr == 0) PG8_BAR;
        E(acc, cur, wr, wc, fr, fq);
        if (!has_next) break;
#pragma unroll
        for (int a = 0; a < 2; ++a)
#pragma unroll
            for (int b = 0; b < 2; ++b)
#pragma unroll
                for (int m = 0; m < 4; ++m)
#pragma unroll
                    for (int n = 0; n < 2; ++n) acc[a][b][m][n] = (acc_t){0, 0, 0, 0};
        cur = nxt; cA = nA; cB = nB; nt = P.nt(cur); ++ui;
        if (wr == 1) PG8_BAR;
    }
    PG8_WAIT_V(0);
    PG8_BAR;
#undef PG8_SA
#undef PG8_SB
#undef PG8_STAGE
#undef PG8_STA
#undef PG8_STB
#undef PG8_LDA
#undef PG8_LDB
#undef PG8_MMA
#undef PG8_WAIT_V
#undef PG8_WAIT_L
#undef PG8_BAR
#undef PG8_SCHED
}

__device__ __forceinline__ void st8(bf16_t* p, const f32x4 v0, const f32x4 v1) {
    u32x4 w; w.x = cvt_pk_bf16(v0[0], v0[1]); w.y = cvt_pk_bf16(v0[2], v0[3]); w.z = cvt_pk_bf16(v1[0], v1[1]); w.w = cvt_pk_bf16(v1[2], v1[3]);
    *(u32x4*)p = w;
}
}

struct Args { const float* in[35]; float* out; unsigned char* ws; int ph_lo, ph_hi; };
typedef const __attribute__((address_space(4))) Args CArgs;
__device__ __forceinline__ CArgs* launder_args(CArgs* p) { unsigned long long v = (unsigned long long)p; asm volatile("" : "+s"(v)); return (CArgs*)v; }
enum { I_X = 0, I_C, I_CTX, I_CCTX, I_ADAW, I_ADAB, I_NORMG, I_FWO, I_FBO, I_MIX, I_WR, I_WK, I_WV, I_WO, I_W0, I_W1, I_W2, I_A0, I_A1, I_A2, I_V0, I_V1, I_V2, I_G1, I_G2,
       I_KK, I_KA, I_RK, I_LNW, I_LNB, I_ROUTER, I_WG, I_WU, I_WD, I_FG };

struct JobDesc { int src, soff, scl, sclo, dbuf, doff, K, N, ldt; };
#define MJ(src, soff, scl, sclo, dbuf, doff, K, N, ldt) { src, soff, scl, sclo, dbuf, doff, K, N, ldt }
#define WCB(ri) ((ri) * 3584 * 2048)
#define W2B(ri) ((ri) * 6144 * 256)
#define JOBS_RI(ri) \
    MJ(I_W1, ((ri) * 2 + 0) * 65536, -1, 0, 1, WCB(ri) + 3072 * 2048, 1024, 64, 2048), MJ(I_W1, ((ri) * 2 + 0) * 65536, I_MIX, ((ri) * 6 + 1) * 1024, 1, WCB(ri) + 3072 * 2048 + 1024, 1024, 64, 2048), \
    MJ(I_W1, ((ri) * 2 + 1) * 65536, -1, 0, 1, WCB(ri) + 3136 * 2048, 1024, 64, 2048), MJ(I_W1, ((ri) * 2 + 1) * 65536, I_MIX, ((ri) * 6 + 1) * 1024, 1, WCB(ri) + 3136 * 2048 + 1024, 1024, 64, 2048), \
    MJ(I_A1, ((ri) * 2 + 0) * 65536, -1, 0, 1, WCB(ri) + 3200 * 2048, 1024, 64, 2048), MJ(I_A1, ((ri) * 2 + 0) * 65536, I_MIX, ((ri) * 6 + 4) * 1024, 1, WCB(ri) + 3200 * 2048 + 1024, 1024, 64, 2048), \
    MJ(I_A1, ((ri) * 2 + 1) * 65536, -1, 0, 1, WCB(ri) + 3264 * 2048, 1024, 64, 2048), MJ(I_A1, ((ri) * 2 + 1) * 65536, I_MIX, ((ri) * 6 + 4) * 1024, 1, WCB(ri) + 3264 * 2048 + 1024, 1024, 64, 2048), \
    MJ(I_G1, (ri) * 131072, -1, 0, 1, WCB(ri) + 3328 * 2048, 1024, 128, 2048),   MJ(I_G1, (ri) * 131072, I_MIX, ((ri) * 6 + 5) * 1024, 1, WCB(ri) + 3328 * 2048 + 1024, 1024, 128, 2048), \
    MJ(I_W2, ((ri) * 2 + 0) * 65536, -1, 0, 2, W2B(ri) + 0 * 256 + 0, 64, 1024, 256),      MJ(I_W2, ((ri) * 2 + 1) * 65536, -1, 0, 2, W2B(ri) + 1024 * 256 + 64, 64, 1024, 256), \
    MJ(I_A2, ((ri) * 2 + 0) * 65536, -1, 0, 2, W2B(ri) + 2048 * 256 + 128, 64, 1024, 256), MJ(I_A2, ((ri) * 2 + 1) * 65536, -1, 0, 2, W2B(ri) + 3072 * 256 + 192, 64, 1024, 256), \
    MJ(I_G2, (ri) * 131072, -1, 0, 2, W2B(ri) + 4096 * 256 + 0, 128, 1024, 256)
__device__ const JobDesc JOBS[] = {
    MJ(I_FWO, 0 * 1048576, -1, 0, 0, 0 * 1048576, 1024, 1024, 1024),
    MJ(I_FWO, 1 * 1048576, -1, 0, 0, 2 * 1048576, 1024, 1024, 1024),
    JOBS_RI(0), JOBS_RI(1),
    MJ(I_V1, 0, -1, 0, 1, WCB(1) + 3456 * 2048, 1024, 32, 2048), MJ(I_V1, 0, I_MIX, (1 * 6 + 3) * 1024, 1, WCB(1) + 3456 * 2048 + 1024, 1024, 32, 2048),
    MJ(I_V2, 0, -1, 0, 2, W2B(1) + 5120 * 256 + 128, 32, 1024, 256),
};
constexpr int NJOBS = 2 + 2 * 15 + 3;
static_assert(sizeof(JOBS) / sizeof(JobDesc) == NJOBS, "job count");

__host__ __device__ constexpr int job_items(int K, int N) { return ((K + 63) / 64) * ((N + 63) / 64); }
__device__ __forceinline__ void conv_item(const float* W, int ldw, int kvalid, int nvalid, const float* scale, bf16_t* dst, int ldt, LAS float* scr, int lane) {
    const int kr = lane >> 4, nc = 4 * (lane & 15);
    f32x4 v[16];
#pragma unroll
    for (int it = 0; it < 16; ++it) { const int k = 4 * it + kr; v[it] = (f32x4){0.f, 0.f, 0.f, 0.f};
        if (k < kvalid && nc < nvalid) { v[it] = *(const f32x4*)(W + (size_t)k * ldw + nc); if (scale) v[it] = v[it] * scale[k]; } }
#pragma unroll
    for (int it = 0; it < 16; ++it) *(LAS f32x4*)(scr + (4 * it + kr) * 68 + nc) = v[it];
    asm volatile("s_waitcnt lgkmcnt(0)" ::: "memory");
    if (lane < nvalid) {
#pragma unroll
        for (int c2 = 0; c2 < 8; c2 += 4) {
            float t[4][8];
#pragma unroll
            for (int c = 0; c < 4; ++c)
#pragma unroll
                for (int k = 0; k < 8; ++k) t[c][k] = scr[(8 * (c2 + c) + k) * 68 + lane];
            asm volatile("s_waitcnt lgkmcnt(0)" ::: "memory");
#pragma unroll
            for (int c = 0; c < 4; ++c) { u32x4 o; o.x = pg8::cvt_pk_bf16(t[c][0], t[c][1]); o.y = pg8::cvt_pk_bf16(t[c][2], t[c][3]); o.z = pg8::cvt_pk_bf16(t[c][4], t[c][5]); o.w = pg8::cvt_pk_bf16(t[c][6], t[c][7]);
                *(u32x4*)(dst + (size_t)lane * ldt + 8 * (c2 + c)) = o; } }
    }
    asm volatile("s_waitcnt lgkmcnt(0)" ::: "memory");
}

struct Frame {
    LAS unsigned char* lds;
    int tid, lane, wave, G, bid;
    unsigned char* ws;
};
#define WSP(T, off) ((T*)(F.ws + (off)))

__device__ __forceinline__ void quant_strip(Frame& F, const float* W, signed char* dst, int dst_pitch, float* scl, int drow0) {
    LAS float* T = (LAS float*)F.lds;
    { const int j4 = 4 * (F.tid & 7), kk = F.tid >> 3;
      f32x4 t[16];
#pragma unroll
      for (int p = 0; p < 16; ++p) t[p] = *(const f32x4*)(W + (size_t)(64 * p + kk) * 1024 + j4);
#pragma unroll
      for (int p = 0; p < 16; ++p) { LAS float* tp = T + (64 * p + kk) * 33 + j4; tp[0] = t[p][0]; tp[1] = t[p][1]; tp[2] = t[p][2]; tp[3] = t[p][3]; } }
    __syncthreads();
#pragma unroll 1
    for (int cq = 0; cq < 4; ++cq) {
        const int c = 4 * F.wave + cq;
        float am = 0.f;
        float tv[16];
#pragma unroll
        for (int i = 0; i < 16; ++i) tv[i] = T[(F.lane + 64 * i) * 33 + c];
        asm volatile("s_waitcnt lgkmcnt(0)" ::: "memory");
#pragma unroll
        for (int i = 0; i < 16; ++i) am = fmaxf(am, fabsf(tv[i]));
#pragma unroll
        for (int i = 0; i < 16; ++i) tv[i] = T[(16 * F.lane + i) * 33 + c];
        am = wave_max(am);
        const float inv = am > 0.f ? 127.0f / am : 0.f;
        asm volatile("s_waitcnt lgkmcnt(0)" ::: "memory");
        unsigned q[4];
#pragma unroll
        for (int i = 0; i < 4; ++i) { unsigned o = 0u;
#pragma unroll
            for (int jj = 0; jj < 4; ++jj) { const int qi = (int)__builtin_rintf(tv[4 * i + jj] * inv); o |= ((unsigned)qi & 255u) << (8 * jj); }
            q[i] = o; }
        *(u32x4*)(dst + (size_t)(drow0 + c) * dst_pitch + 16 * F.lane) = (u32x4){q[0], q[1], q[2], q[3]};
        if (F.lane == 0) scl[drow0 + c] = am * (1.0f / 127.0f);
    }
    __syncthreads();
}
__device__ __forceinline__ void p0_prologue(Frame& F, CArgs& a) {
    const int gw = F.bid * NWAVES + F.wave, NGW = F.G * NWAVES;
    const size_t gt = (size_t)F.bid * NTHR + F.tid, GT = (size_t)F.G * NTHR;
    {
        LAS float* SIL = (LAS float*)F.lds;
        LAS float* RED = (LAS float*)(F.lds + 69632);
        float* MOD = WSP(float, WS_MOD);
        if (F.bid < 192) {
            for (int idx = F.tid; idx < 17 * 1024; idx += NTHR) { const int r = idx >> 10, k = idx & 1023; const float cv = (r < 16) ? a.in[I_C][r * 1024 + k] : a.in[I_CCTX][k]; SIL[idx] = cv / (1.0f + __expf(-cv)); }
            __syncthreads();
        }
        for (int u = F.bid; u < 192; u += F.G) {
            const int l = u / 48, col0 = (u % 48) * 128;
            const float* W = a.in[I_ADAW] + (size_t)l * 1024 * 6144 + col0 + 2 * F.lane;
            float acc[17][2];
#pragma unroll
            for (int r = 0; r < 17; ++r) { acc[r][0] = 0.f; acc[r][1] = 0.f; }
            const int kbase = F.wave * 128;
            f32x2 wn[8];
#pragma unroll
            for (int q = 0; q < 8; ++q) wn[q] = *(const f32x2*)(W + (size_t)(kbase + q) * 6144);
#pragma unroll 1
            for (int k8 = 0; k8 < 16; ++k8) {
                const int k = kbase + 8 * k8;
                f32x2 w[8];
#pragma unroll
                for (int q = 0; q < 8; ++q) w[q] = wn[q];
                if (k8 + 1 < 16) {
#pragma unroll
                    for (int q = 0; q < 8; ++q) wn[q] = *(const f32x2*)(W + (size_t)(k + 8 + q) * 6144); }
#pragma unroll
                for (int r = 0; r < 17; ++r) { const f32x4 s0 = *(const LAS f32x4*)(SIL + r * 1024 + k), s1 = *(const LAS f32x4*)(SIL + r * 1024 + k + 4);
#pragma unroll
                    for (int q = 0; q < 4; ++q) { acc[r][0] += s0[q] * w[q].x; acc[r][1] += s0[q] * w[q].y; }
#pragma unroll
                    for (int q = 0; q < 4; ++q) { acc[r][0] += s1[q] * w[4 + q].x; acc[r][1] += s1[q] * w[4 + q].y; } }
            }
#pragma unroll
            for (int r = 0; r < 17; ++r) { RED[(F.wave * 17 + r) * 128 + 2 * F.lane] = acc[r][0]; RED[(F.wave * 17 + r) * 128 + 2 * F.lane + 1] = acc[r][1]; }
            __syncthreads();
            for (int o = F.tid; o < 17 * 128; o += NTHR) { const int r = o >> 7, cc = o & 127; float s = a.in[I_ADAB][l * 6144 + col0 + cc];
#pragma unroll
                for (int w = 0; w < 8; ++w) s += RED[(w * 17 + r) * 128 + cc];
                MOD[(size_t)(l * 17 + r) * 6144 + col0 + cc] = s; }
            __syncthreads();
        }
        __syncthreads();
    }
    for (int sidx = F.bid; sidx < 2 * 3 * 32; sidx += F.G) {
        const int ri = sidx / 96, rem = sidx % 96, which = rem >> 5, n0 = 32 * (rem & 31);
        const float* W = (which == 0 ? a.in[I_WR] : (which == 1 ? a.in[I_WK] : a.in[I_WV])) + (size_t)ri * 1048576 + n0;
        quant_strip(F, W, WSP(signed char, WS_WCAT) + (size_t)ri * 3584 * 4096, 4096, WSP(float, WS_RKVWS) + ri * 3072, which * 1024 + n0);
    }
    for (int sidx = (F.bid + 64) % F.G; sidx < 2 * 32; sidx += F.G) { const int ri = sidx >> 5, n0 = 32 * (sidx & 31);
        quant_strip(F, a.in[I_WO] + (size_t)ri * 1048576 + n0, WSP(signed char, WS_WO8) + (size_t)ri * 1048576, 1024, WSP(float, WS_WO8S) + ri * 1024, n0); }
    {
        LAS float* scr = (LAS float*)(F.lds + F.wave * 17408);
        int total = 0;
#pragma unroll 1
        for (int j = 0; j < NJOBS; ++j) total += job_items(JOBS[j].K, JOBS[j].N);
        for (int it = gw; it < total; it += NGW) {
            int j = 0, r = it;
#pragma unroll 1
            for (; j < NJOBS; ++j) { const int n = job_items(JOBS[j].K, JOBS[j].N); if (r < n) break; r -= n; }
            const JobDesc jd = JOBS[j];
            const int nblk = (jd.N + 63) / 64, kb = r / nblk, nb = r % nblk, k0 = 64 * kb, n0 = 64 * nb;
            const float* src = nullptr; const float* scl = nullptr;
#define SEL_IN(idx, out) do { switch (idx) { case I_FWO: out = a.in[I_FWO]; break; case I_WO: out = a.in[I_WO]; break; case I_WR: out = a.in[I_WR]; break; case I_WK: out = a.in[I_WK]; break; \
                case I_WV: out = a.in[I_WV]; break; case I_W1: out = a.in[I_W1]; break; case I_W2: out = a.in[I_W2]; break; case I_A1: out = a.in[I_A1]; break; case I_A2: out = a.in[I_A2]; break; \
                case I_G1: out = a.in[I_G1]; break; case I_G2: out = a.in[I_G2]; break; case I_V1: out = a.in[I_V1]; break; case I_V2: out = a.in[I_V2]; break; case I_MIX: out = a.in[I_MIX]; break; default: out = nullptr; } } while (0)
            SEL_IN(jd.src, src); if (jd.scl >= 0) SEL_IN(jd.scl, scl);
            bf16_t* dbase = jd.dbuf == 0 ? WSP(bf16_t, WS_WOT) : (jd.dbuf == 1 ? WSP(bf16_t, WS_WCAT) : WSP(bf16_t, WS_W2CAT));
            const int kvalid = (jd.K - k0) < 64 ? (jd.K - k0) : 64, nvalid = (jd.N - n0) < 64 ? (jd.N - n0) : 64;
            conv_item(src + jd.soff + (size_t)k0 * jd.N + n0, jd.N, kvalid, nvalid, scl ? scl + jd.sclo + k0 : nullptr, dbase + jd.doff + (size_t)n0 * jd.ldt + k0, jd.ldt, scr, F.lane);
        }
    }
    {
        float* wob = WSP(float, WS_WOB);
        for (size_t i = gt; i < 4 * 1024; i += GT) { const int l = (int)(i >> 10); wob[i] = (l & 1) ? 0.f : a.in[I_FBO][(l >> 1) * 1024 + (i & 1023)]; }
    }
    {
        bf16_t* CH = WSP(bf16_t, WS_CH);
        for (size_t i = gt; i < 512 * 256; i += GT) { const int m = (int)(i >> 8), c = (int)(i & 255), l = m & 255; const float ang = (float)((l * c) & 255) * (2.0f / 256.0f);
            CH[i] = (bf16_t)f2bf((m < 256 ? cospif(ang) : sinpif(ang)) * 0.0625f); }
        bf16_t* SX = WSP(bf16_t, WS_SEQX);
        for (size_t i = gt; i < (size_t)2048 * 4096; i += GT) { const int k = (int)(i >> 12), j = (int)(i & 4095), t = j & 2047; const float ang = (float)((k * t) & 2047) * (2.0f / 2048.0f);
            SX[i] = (bf16_t)f2bf((j < 2048 ? cospif(ang) : -sinpif(ang)) * 0.022097087f); }
        bf16_t* SC = WSP(bf16_t, WS_SEQC);
        for (size_t i = gt; i < 256 * 512; i += GT) { const int k = (int)(i >> 9), j = (int)(i & 511), t = j & 255; const float ang = (float)((k * t) & 255) * (2.0f / 256.0f);
            SC[i] = (bf16_t)f2bf((j < 256 ? cospif(ang) : -sinpif(ang)) * 0.0625f); }
    }
}

template <int MODE>
__device__ __forceinline__ void row_pass(Frame& F, CArgs& a, int l, bool combine, int nrows) {
    const int gw = F.bid * NWAVES + F.wave, NGW = F.G * NWAVES, lane = F.lane;
    const float* MOD = WSP(float, WS_MOD);
    const short* INV = WSP(short, WS_INV);
    const bf16_t* YS = WSP(bf16_t, WS_YS);
    LAS float* RT = (LAS float*)F.lds;
    if (MODE == 2) {
        const float* rt = a.in[I_ROUTER] + (size_t)l * 1024 * 16;
        for (int i = F.tid; i < 16384; i += NTHR) { const int k = i >> 4, e = i & 15; RT[e * 1024 + k] = rt[i]; }
        __syncthreads();
    }
    const float* ng = (MODE == 3) ? a.in[I_FG] : a.in[I_NORMG] + (size_t)(l * 2 + (MODE == 2 ? 1 : 0)) * 1024;
    f32x4 gv[4];
#pragma unroll
    for (int j = 0; j < 4; ++j) gv[j] = *(const f32x4*)(ng + 4 * lane + 256 * j);
    const int RPW = (nrows + NGW - 1) / NGW, r0 = gw * RPW, r1 = (r0 + RPW < nrows) ? r0 + RPW : nrows;
    int bcur = -1; f32x4 shv[4], scv[4], g2v[4];
    u32x2 nv[4], nd[4];
    if (MODE == 2 && r0 < r1) { const bf16_t* xs0 = WSP(bf16_t, WS_XB) + (size_t)r0 * D + 4 * lane; const bf16_t* dp0 = WSP(bf16_t, WS_DELTA) + (size_t)r0 * D + 4 * lane;
#pragma unroll
        for (int j = 0; j < 4; ++j) { nv[j] = *(const u32x2*)(xs0 + 256 * j); nd[j] = *(const u32x2*)(dp0 + 256 * j); } }
    for (int row = r0; row < r1; ++row) {
        const bool isx = row < NXR;
        const int b = isx ? (row >> 11) : 16;
        if (b != bcur) { bcur = b;
            if (MODE != 3) { const float* mrow = MOD + (size_t)(l * 17 + b) * 6144 + 4 * lane; const int shi = (MODE == 2) ? 3 : 0, sci = (MODE == 2) ? 4 : 1;
#pragma unroll
                for (int j = 0; j < 4; ++j) { shv[j] = *(const f32x4*)(mrow + shi * 1024 + 256 * j); scv[j] = *(const f32x4*)(mrow + sci * 1024 + 256 * j) + 1.0f; } }
            if (combine) { const int lp = (MODE == 3) ? 3 : l - 1; const float* g2 = MOD + (size_t)(lp * 17 + b) * 6144 + 5 * 1024 + 4 * lane;
#pragma unroll
                for (int j = 0; j < 4; ++j) g2v[j] = *(const f32x4*)(g2 + 256 * j); } }
        bf16_t* xb = WSP(bf16_t, WS_XB) + (size_t)row * D + 4 * lane;
        float* xr = a.out + (size_t)row * D;
        f32x4 v[4];
        const bool first = (MODE == 0) && (l == 0);
        if (MODE == 2) {
#pragma unroll
            for (int j = 0; j < 4; ++j) { const u32x2 w = nd[j], xw = nv[j]; v[j] = (f32x4){bf2f(xw.x & 0xffffu), bf2f(xw.x >> 16), bf2f(xw.y & 0xffffu), bf2f(xw.y >> 16)};
                v[j][0] += bf2f(w.x & 0xffffu); v[j][1] += bf2f(w.x >> 16); v[j][2] += bf2f(w.y & 0xffffu); v[j][3] += bf2f(w.y >> 16); }
            if (row + 1 < r1) { const int rn = row + 1; const bf16_t* xsn = WSP(bf16_t, WS_XB) + (size_t)rn * D + 4 * lane; const bf16_t* dpn = WSP(bf16_t, WS_DELTA) + (size_t)rn * D + 4 * lane;
#pragma unroll
                for (int j = 0; j < 4; ++j) { nv[j] = *(const u32x2*)(xsn + 256 * j); nd[j] = *(const u32x2*)(dpn + 256 * j); } }
        } else {
        if (first) { const float* xs = isx ? a.in[I_X] + (size_t)row * D : a.in[I_CTX] + (size_t)(row - NXR) * D;
#pragma unroll
            for (int j = 0; j < 4; ++j) v[j] = *(const f32x4*)(xs + 4 * lane + 256 * j); }
        else {
#pragma unroll
            for (int j = 0; j < 4; ++j) { const u32x2 xw = *(const u32x2*)(xb + 256 * j); v[j] = (f32x4){bf2f(xw.x & 0xffffu), bf2f(xw.x >> 16), bf2f(xw.y & 0xffffu), bf2f(xw.y >> 16)}; } }
        if (combine) {
            const bf16_t* dp = WSP(bf16_t, WS_DELTA) + (size_t)row * D + 4 * lane;
#pragma unroll
            for (int j = 0; j < 4; ++j) { const u32x2 w = *(const u32x2*)(dp + 256 * j); v[j][0] += bf2f(w.x & 0xffffu); v[j][1] += bf2f(w.x >> 16); v[j][2] += bf2f(w.y & 0xffffu); v[j][3] += bf2f(w.y >> 16); }
        }
        }
        if (first) {
#pragma unroll
            for (int j = 0; j < 4; ++j) { u32x2 w; w.x = pk2(v[j][0], v[j][1]); w.y = pk2(v[j][2], v[j][3]); *(u32x2*)(xb + 256 * j) = w; }
        }
        if (combine) {
            int myinv = -1; if (lane < 16) myinv = INV[(size_t)row * 16 + lane];
            f32x4 s[4];
#pragma unroll
            for (int j = 0; j < 4; ++j) s[j] = (f32x4){0.f, 0.f, 0.f, 0.f};
            unsigned em = (unsigned)__builtin_amdgcn_ballot_w64(myinv >= 0);
#pragma unroll 1
            while (em) {
                const int e0 = __builtin_ctz(em); em &= em - 1u;
                const bool two = em != 0u; const int e1 = two ? __builtin_ctz(em) : e0; em &= em - 1u;
                const int slot0 = __builtin_amdgcn_readlane(myinv, e0), slot1 = __builtin_amdgcn_readlane(myinv, e1);
                const size_t sr0 = isx ? ((size_t)((row >> 11) * 16 + e0) * CAPX + slot0) : ((size_t)NSX + (size_t)(e0 * 16 + ((row - NXR) >> 8)) * CAPC + slot0);
                const size_t sr1 = isx ? ((size_t)((row >> 11) * 16 + e1) * CAPX + slot1) : ((size_t)NSX + (size_t)(e1 * 16 + ((row - NXR) >> 8)) * CAPC + slot1);
                const bf16_t* yp0 = YS + sr0 * D + 4 * lane; const bf16_t* yp1 = YS + sr1 * D + 4 * lane;
                const float gt0 = WSP(float, WS_GATE)[sr0]; const float gt1 = two ? WSP(float, WS_GATE)[sr1] : 0.f;
                u32x2 w0[4], w1[4];
#pragma unroll
                for (int j = 0; j < 4; ++j) { w0[j] = *(const u32x2*)(yp0 + 256 * j); w1[j] = *(const u32x2*)(yp1 + 256 * j); }
#pragma unroll
                for (int j = 0; j < 4; ++j) {
                    s[j][0] += gt0 * bf2f(w0[j].x & 0xffffu); s[j][1] += gt0 * bf2f(w0[j].x >> 16); s[j][2] += gt0 * bf2f(w0[j].y & 0xffffu); s[j][3] += gt0 * bf2f(w0[j].y >> 16);
                    s[j][0] += gt1 * bf2f(w1[j].x & 0xffffu); s[j][1] += gt1 * bf2f(w1[j].x >> 16); s[j][2] += gt1 * bf2f(w1[j].y & 0xffffu); s[j][3] += gt1 * bf2f(w1[j].y >> 16); }
            }
#pragma unroll
            for (int j = 0; j < 4; ++j) v[j] = v[j] + g2v[j] * s[j];
            if (MODE != 3) {
#pragma unroll
                for (int j = 0; j < 4; ++j) { u32x2 w; w.x = pk2(v[j][0], v[j][1]); w.y = pk2(v[j][2], v[j][3]); *(u32x2*)(xb + 256 * j) = w; }
            }
        }
        float ss = 0.f;
#pragma unroll
        for (int j = 0; j < 4; ++j) ss += (v[j][0] * v[j][0] + v[j][1] * v[j][1]) + (v[j][2] * v[j][2] + v[j][3] * v[j][3]);
        ss = wave_sum(ss);
        const float rs = 1.0f / sqrtf(ss * (1.0f / 1024.0f) + 1e-6f);
        if (MODE == 3) {
#pragma unroll
            for (int j = 0; j < 4; ++j) *(f32x4*)(xr + 4 * lane + 256 * j) = v[j] * rs * gv[j];
            continue;
        }
        f32x4 h[4];
#pragma unroll
        for (int j = 0; j < 4; ++j) h[j] = v[j] * rs * gv[j] * scv[j] + shv[j];
        if (MODE == 2) {
            float am = 0.f;
#pragma unroll
            for (int j = 0; j < 4; ++j) am = fmaxf(am, fmaxf(fmaxf(fabsf(h[j][0]), fabsf(h[j][1])), fmaxf(fabsf(h[j][2]), fabsf(h[j][3]))));
            am = wave_max(am); const float inv = am > 0.f ? 127.0f / am : 0.f;
            signed char* hq = WSP(signed char, WS_HB) + (size_t)row * D;
#pragma unroll
            for (int j = 0; j < 4; ++j) { unsigned o = 0u;
#pragma unroll
                for (int i = 0; i < 4; ++i) { const int qi = (int)__builtin_rintf(h[j][i] * inv); o |= ((unsigned)qi & 255u) << (8 * i); }
                *(unsigned*)(hq + 4 * lane + 256 * j) = o; }
            if (lane == 0) WSP(float, WS_HBSCALE)[row] = am * (1.0f / 127.0f);
        } else {
        bf16_t* hb = (MODE == 1) ? WSP(bf16_t, WS_HB2) + (size_t)row * 2048 : WSP(bf16_t, WS_HB) + (size_t)row * 1024;
#pragma unroll
        for (int j = 0; j < 4; ++j) { u32x2 w; w.x = pk2(h[j][0], h[j][1]); w.y = pk2(h[j][2], h[j][3]); *(u32x2*)(hb + 4 * lane + 256 * j) = w; }
        }
        if (MODE == 2) {
            float lg[16];
            int rto = 4 * lane; asm volatile("" : "+v"(rto));
#pragma unroll
            for (int e4 = 0; e4 < 16; e4 += 4) {
                f32x4 r4[4][4];
#pragma unroll
                for (int q = 0; q < 4; ++q)
#pragma unroll
                    for (int j = 0; j < 4; ++j) r4[q][j] = *(const LAS f32x4*)(RT + (e4 + q) * 1024 + rto + 256 * j);
                asm volatile("s_waitcnt lgkmcnt(0)" ::: "memory");
#pragma unroll
                for (int q = 0; q < 4; ++q) { f32x2 p2 = (f32x2){0.f, 0.f};
#pragma unroll
                    for (int j = 0; j < 4; ++j) { const f32x4 rr = r4[q][j], hh = h[j];
                        p2 = __builtin_shufflevector(hh, hh, 0, 1) * __builtin_shufflevector(rr, rr, 0, 1) + p2;
                        p2 = __builtin_shufflevector(hh, hh, 2, 3) * __builtin_shufflevector(rr, rr, 2, 3) + p2; }
                    lg[e4 + q] = p2[0] + p2[1]; } }
            float lgx;
            { const bool b0 = (lane & 1) != 0, b1 = (lane & 2) != 0, b2 = (lane & 4) != 0, b3 = (lane & 8) != 0;
              float q8[8], q4[4], q2[2];
#pragma unroll
              for (int i = 0; i < 8; ++i) { const float keep = b0 ? lg[2 * i + 1] : lg[2 * i], send = b0 ? lg[2 * i] : lg[2 * i + 1]; q8[i] = keep + DPP_F(send, 0xB1); }
#pragma unroll
              for (int i = 0; i < 4; ++i) { const float keep = b1 ? q8[2 * i + 1] : q8[2 * i], send = b1 ? q8[2 * i] : q8[2 * i + 1]; q4[i] = keep + DPP_F(send, 0x4E); }
#pragma unroll
              for (int i = 0; i < 2; ++i) { const float keep = b2 ? q4[2 * i + 1] : q4[2 * i], send = b2 ? q4[2 * i] : q4[2 * i + 1]; q2[i] = keep + DPP_F(send, 0x124); }
              { const float keep = b3 ? q2[1] : q2[0], send = b3 ? q2[0] : q2[1]; lgx = keep + DPP_F(send, 0x128); }
              lgx += lane_xor(lgx, 16, lane); lgx += lane_xor(lgx, 32, lane); }
            float mx = lgx; mx = fmaxf(mx, DPP_F(mx, 0xB1)); mx = fmaxf(mx, DPP_F(mx, 0x4E)); mx = fmaxf(mx, DPP_F(mx, 0x141)); mx = fmaxf(mx, DPP_F(mx, 0x140));
            const float ex = __expf(lgx - mx); const float sum = row16_sum(ex); const float inv = 1.0f / sum;
            if (lane < 16) WSP(float, WS_AFF)[(size_t)row * 16 + lane] = ex * inv;
        }
    }
    if (MODE == 2) __syncthreads();
}

__device__ __forceinline__ void moe_weight_conv(Frame& F, CArgs& a, int l, int gemm_units) {
    for (int sidx = F.bid; sidx < 16 * 2 * 32; sidx += F.G) {
        const int e = sidx >> 6, which = (sidx >> 5) & 1, n0 = 32 * (sidx & 31);
        quant_strip(F, (which ? a.in[I_WU] : a.in[I_WG]) + ((size_t)(l * 16 + e) << 20) + n0, WSP(signed char, WS_MOEW_GU), 1024, WSP(float, WS_WSCALE), e * 2048 + 256 * (n0 >> 7) + 128 * which + (n0 & 127));
    }
    constexpr int NIT = 16 * 256;
    LAS float* scr = (LAS float*)(F.lds + F.wave * 17408);
    int first, count;
    if (F.G == 256) {
        const int nbig = gemm_units % 256;
        const int lo = (nbig > 0) ? 4 : 16, hi = (nbig > 0) ? (NIT - nbig * lo + (256 - nbig) - 1) / (256 - nbig) : 16;
        if (F.bid < nbig) { first = F.bid * lo; count = lo; } else { first = nbig * lo + (F.bid - nbig) * hi; count = hi; }
        if (first > NIT) first = NIT; if (first + count > NIT) count = NIT - first;
    } else { const int per = (NIT + F.G - 1) / F.G; first = F.bid * per; count = per; if (first > NIT) first = NIT; if (first + count > NIT) count = NIT - first; }
    for (int q = F.wave; q < count; q += NWAVES) {
        const int it = first + q;
        const int e = it >> 8, blk = it & 255, kb = blk >> 4, nb = blk & 15, k0 = 64 * kb, n0 = 64 * nb;
        const float* src = a.in[I_WD] + ((size_t)(l * 16 + e) << 20) + (size_t)k0 * 1024 + n0;
        bf16_t* dst = WSP(bf16_t, WS_MOEW_DN) + ((size_t)e * 1024 + n0) * 1024 + k0;
        conv_item(src, 1024, 64, 64, nullptr, dst, 1024, scr, F.lane);
    }
}

__device__ __forceinline__ void shift_pass(Frame& F, CArgs& a, int ri) {
    const int gw = F.bid * NWAVES + F.wave, NGW = F.G * NWAVES, lane = F.lane;
    bf16_t* HB2 = WSP(bf16_t, WS_HB2);
    float* XSC = WSP(float, WS_RKVXS);
    const float* mix = a.in[I_MIX] + (size_t)ri * 6 * 1024;
    if (gw < 512) {
        const u32x4* wrow = (const u32x4*)(F.ws + WS_WCAT + ((size_t)ri * 3584 + 3072 + gw) * 4096);
        u32x4 wv[4];
#pragma unroll
        for (int q = 0; q < 4; ++q) wv[q] = wrow[lane + 64 * q];
        float wf[4][8]; float wam = 0.f;
#pragma unroll
        for (int q = 0; q < 4; ++q) { const unsigned ww[4] = {wv[q].x, wv[q].y, wv[q].z, wv[q].w};
#pragma unroll
            for (int i = 0; i < 4; ++i) { wf[q][2 * i] = bf2f(ww[i] & 0xffffu); wf[q][2 * i + 1] = bf2f(ww[i] >> 16); wam = fmaxf(wam, fmaxf(fabsf(wf[q][2 * i]), fabsf(wf[q][2 * i + 1]))); } }
        wam = wave_max(wam); const float winv = wam > 0.f ? 127.0f / wam : 0.f;
        unsigned char* wdst = F.ws + WS_WL8 + ((size_t)ri * 512 + gw) * 2048;
#pragma unroll
        for (int q = 0; q < 4; ++q) { unsigned o[2];
#pragma unroll
            for (int hh = 0; hh < 2; ++hh) { unsigned oo = 0u;
#pragma unroll
                for (int i = 0; i < 4; ++i) { const int qi = (int)__builtin_rintf(wf[q][4 * hh + i] * winv); oo |= ((unsigned)qi & 255u) << (8 * i); }
                o[hh] = oo; }
            *(u32x2*)(wdst + 8 * (lane + 64 * q)) = (u32x2){o[0], o[1]}; }
        if (lane == 0) WSP(float, WS_WL8S)[ri * 512 + gw] = wam * (1.0f / 127.0f);
    }
    f32x4 mzv[3][4];
#pragma unroll
    for (int z = 0; z < 3; ++z)
#pragma unroll
        for (int j = 0; j < 4; ++j) mzv[z][j] = *(const f32x4*)(mix + (z == 0 ? 0 : (z == 1 ? 2 : 3)) * 1024 + 4 * lane + 256 * j);
    for (int row = gw; row < NR; row += NGW) {
        bf16_t* hp = HB2 + (size_t)row * 2048;
        f32x4 xv3[3][4]; float am[3] = {0.f, 0.f, 0.f};
        f32x4 h4v[4], xxv[4]; float amh = 0.f;
        u32x2 hc[4], hn[4]; bool okj[4];
#pragma unroll
        for (int j = 0; j < 4; ++j) {
            int nrow; bool ok;
            if (row < NXR) { const int t = row & 2047, col = t & 63, rg = t >> 6;
                if (j == 0) { ok = col > 0; nrow = row - 1; } else if (j == 1) { ok = col < 63; nrow = row + 1; } else if (j == 2) { ok = rg > 0; nrow = row - 64; } else { ok = rg < 31; nrow = row + 64; } }
            else { const int t = (row - NXR) & 255; if (j < 2) { ok = t > 0; nrow = row - 1; } else { ok = t < 255; nrow = row + 1; } }
            const int c0 = 4 * lane + 256 * j;
            okj[j] = ok;
            hc[j] = *(const u32x2*)(hp + c0);
            hn[j] = *(const u32x2*)(HB2 + (size_t)(ok ? nrow : row) * 2048 + c0);
        }
#pragma unroll
        for (int j = 0; j < 4; ++j) {
            const int c0 = 4 * lane + 256 * j;
            const u32x2 hcj = hc[j]; u32x2 hnj = hn[j]; if (!okj[j]) hnj = (u32x2){0u, 0u};
            const f32x4 h4 = (f32x4){bf2f(hcj.x & 0xffffu), bf2f(hcj.x >> 16), bf2f(hcj.y & 0xffffu), bf2f(hcj.y >> 16)};
            const f32x4 xx = (f32x4){bf2f(hnj.x & 0xffffu), bf2f(hnj.x >> 16), bf2f(hnj.y & 0xffffu), bf2f(hnj.y >> 16)} - h4;
            h4v[j] = h4; xxv[j] = xx;
            amh = fmaxf(amh, fmaxf(fmaxf(fmaxf(fabsf(h4[0]), fabsf(h4[1])), fmaxf(fabsf(h4[2]), fabsf(h4[3]))), fmaxf(fmaxf(fabsf(xx[0]), fabsf(xx[1])), fmaxf(fabsf(xx[2]), fabsf(xx[3])))));
#pragma unroll
            for (int z = 0; z < 3; ++z) { const f32x4 v = h4 + xx * mzv[z][j]; xv3[z][j] = v;
                am[z] = fmaxf(am[z], fmaxf(fmaxf(fabsf(v[0]), fabsf(v[1])), fmaxf(fabsf(v[2]), fabsf(v[3])))); }
        }
        { const float amx = wave_max(amh); const float inv = amx > 0.f ? 127.0f / amx : 0.f;
          signed char* hq = (signed char*)hp + 2048;
#pragma unroll
          for (int j = 0; j < 4; ++j) { unsigned oh = 0u, ox = 0u;
#pragma unroll
              for (int i = 0; i < 4; ++i) { const int qh = (int)__builtin_rintf(h4v[j][i] * inv), qx = (int)__builtin_rintf(xxv[j][i] * inv); oh |= ((unsigned)qh & 255u) << (8 * i); ox |= ((unsigned)qx & 255u) << (8 * i); }
              *(unsigned*)(hq + 4 * lane + 256 * j) = oh; *(unsigned*)(hq + 1024 + 4 * lane + 256 * j) = ox; }
          if (lane == 0) WSP(float, WS_HXS)[row] = amx * (1.0f / 127.0f); }
#pragma unroll
        for (int z = 0; z < 3; ++z) {
            const float amz = wave_max(am[z]); const float inv = amz > 0.f ? 127.0f / amz : 0.f;
            signed char* xq = (signed char*)(F.ws + (z == 0 ? WS_XR : (z == 1 ? WS_XK : WS_XV))) + (size_t)row * D;
#pragma unroll
            for (int j = 0; j < 4; ++j) { unsigned o = 0u;
#pragma unroll
                for (int i = 0; i < 4; ++i) { const int qi = (int)__builtin_rintf(xv3[z][j][i] * inv); o |= ((unsigned)qi & 255u) << (8 * i); }
                *(unsigned*)(xq + 4 * lane + 256 * j) = o; }
            if (lane == 0) XSC[(size_t)z * NR + row] = amz * (1.0f / 127.0f);
        }
    }
}

__device__ __forceinline__ int block_excl_scan(Frame& F, int v, LAS int* wsum, int& total) {
    int x = v;
#pragma unroll
    for (int o = 1; o < 64; o <<= 1) { const int y = __builtin_amdgcn_ds_bpermute((F.lane - o) << 2, x); if (F.lane >= o) x += y; }
    if (F.lane == 63) wsum[F.wave] = x;
    __syncthreads();
    int off = 0; total = 0;
#pragma unroll
    for (int w = 0; w < 8; ++w) { const int s = wsum[w]; if (w < F.wave) off += s; total += s; }
    __syncthreads();
    return off + x - v;
}
__device__ __forceinline__ void topk_phase(Frame& F, bool with_ctx) {
    LAS unsigned* hist = (LAS unsigned*)F.lds;
    LAS int* wsum = (LAS int*)(F.lds + 1024);
    LAS int* sel = (LAS int*)(F.lds + 1536);
    LAS int* selrow = (LAS int*)(F.lds + 2048);
    const float* AFF = WSP(float, WS_AFF);
    float* GATE = WSP(float, WS_GATE); int* IDX = WSP(int, WS_IDX); short* INV = WSP(short, WS_INV);
    const bf16_t* HB = WSP(bf16_t, WS_HB); unsigned char* XS8 = WSP(unsigned char, WS_XS);
    const int ntask = with_ctx ? 512 : 256;
    for (int task = F.bid; task < ntask; task += F.G) {
        int n, C, row0, e, sr0;
        if (task < 256) { const int b = task >> 4; e = task & 15; n = TX; C = CAPX; row0 = b * TX; sr0 = (b * 16 + e) * CAPX; }
        else { const int q = task - 256, b = q >> 4; e = q & 15; n = TCX; C = CAPC; row0 = NXR + b * TCX; sr0 = NSX + (e * 16 + b) * CAPC; }
        unsigned key[4]; float val[4];
#pragma unroll
        for (int j = 0; j < 4; ++j) { const int t = F.tid * 4 + j; val[j] = AFF[(size_t)(row0 + (t < n ? t : n - 1)) * 16 + e]; }
#pragma unroll
        for (int j = 0; j < 4; ++j) { const int t = F.tid * 4 + j; if (t < n) key[j] = __float_as_uint(val[j]); else { val[j] = 0.f; key[j] = 0u; } }
        unsigned prefix = 0u, mask = 0u; int remaining = C;
#pragma unroll 1
        for (int pass = 0; pass < 4; ++pass) {
            const int shift = 24 - 8 * pass;
            if (F.tid < 256) hist[F.tid] = 0u;
            __syncthreads();
#pragma unroll
            for (int j = 0; j < 4; ++j) { const int t = F.tid * 4 + j; if (t < n && (key[j] & mask) == prefix) __hip_atomic_fetch_add(&hist[(key[j] >> shift) & 255u], 1u, __ATOMIC_RELAXED, __HIP_MEMORY_SCOPE_WORKGROUP); }
            __syncthreads();
            if (F.wave == 0) {
                const u32x4 hq = *(const LAS u32x4*)(hist + 4 * F.lane);
                const int h0 = (int)hq.x, h1 = (int)hq.y, h2 = (int)hq.z, h3 = (int)hq.w, tot = (h0 + h1) + (h2 + h3);
                int xs = tot;
#pragma unroll
                for (int o = 1; o < 64; o <<= 1) { const int y = __builtin_amdgcn_ds_bpermute((F.lane + o) << 2, xs); if (F.lane + o < 64) xs += y; }
                const int excl = xs - tot;
                const int c3 = excl + h3, c2 = c3 + h2, c1 = c2 + h1, c0 = c1 + h0;
                if (excl < remaining && c0 >= remaining) {
                    int d = 4 * F.lane, above = c1;
                    if (c3 >= remaining) { d += 3; above = excl; } else if (c2 >= remaining) { d += 2; above = c3; } else if (c1 >= remaining) { d += 1; above = c2; }
                    sel[0] = d; sel[1] = remaining - above;
                }
            }
            __syncthreads();
            const int d = sel[0]; remaining = sel[1]; prefix |= ((unsigned)d) << shift; mask |= 0xFFu << shift;
            __syncthreads();
        }
        const unsigned thr = prefix; const int need_eq = remaining;
        int ceq = 0;
#pragma unroll
        for (int j = 0; j < 4; ++j) { const int t = F.tid * 4 + j; ceq += (t < n && key[j] == thr) ? 1 : 0; }
        int tot; int req = block_excl_scan(F, ceq, wsum, tot);
        bool s[4]; int cnt = 0;
#pragma unroll
        for (int j = 0; j < 4; ++j) { const int t = F.tid * 4 + j; const bool valid = t < n; const bool gt = valid && key[j] > thr; const bool eq = valid && key[j] == thr;
            bool take = gt; if (eq) { take = req < need_eq; ++req; } s[j] = take; cnt += take ? 1 : 0; }
        int slot = block_excl_scan(F, cnt, wsum, tot);
#pragma unroll
        for (int j = 0; j < 4; ++j) { const int t = F.tid * 4 + j;
            if (t < n) { const int row = row0 + t;
                if (s[j]) { if (slot < C) { IDX[sr0 + slot] = row; GATE[sr0 + slot] = val[j]; selrow[slot] = row; } INV[(size_t)row * 16 + e] = (short)slot; ++slot; }
                else INV[(size_t)row * 16 + e] = (short)-1; } }
        __syncthreads();
        for (int sidx = F.wave; sidx < C; sidx += NWAVES) { const int row = selrow[sidx];
            const u32x4* src = (const u32x4*)(WSP(unsigned char, WS_HB) + (size_t)row * D);
            const u32x4 w = src[F.lane];
            *((u32x4*)(XS8 + (size_t)(sr0 + sidx) * D) + F.lane) = w;
            if (F.lane == 0) WSP(float, WS_XSCALE)[sr0 + sidx] = WSP(float, WS_HBSCALE)[row]; }
        __syncthreads();
    }
}

__device__ __forceinline__ float dpp_row_shr(float v, const int n) {
    int r;
    if (n == 1) r = __builtin_amdgcn_update_dpp(0, __float_as_int(v), 0x111, 0xF, 0xF, true);
    else if (n == 2) r = __builtin_amdgcn_update_dpp(0, __float_as_int(v), 0x112, 0xF, 0xF, true);
    else if (n == 4) r = __builtin_amdgcn_update_dpp(0, __float_as_int(v), 0x114, 0xF, 0xF, true);
    else r = __builtin_amdgcn_update_dpp(0, __float_as_int(v), 0x118, 0xF, 0xF, true);
    return __int_as_float(r);
}
__device__ __forceinline__ bf16x8 pack_2(const f32x4 d0, const f32x4 d1) {
    u32x4 w; w.x = pg8::cvt_pk_bf16(d0[0], d0[1]); w.y = pg8::cvt_pk_bf16(d0[2], d0[3]); w.z = pg8::cvt_pk_bf16(d1[0], d1[1]); w.w = pg8::cvt_pk_bf16(d1[2], d1[3]); return __builtin_bit_cast(bf16x8, w); }
typedef short bf16x4 __attribute__((ext_vector_type(4)));
__device__ __forceinline__ bf16x4 pack4(const f32x4 d) { u32x2 w; w.x = pg8::cvt_pk_bf16(d[0], d[1]); w.y = pg8::cvt_pk_bf16(d[2], d[3]); return __builtin_bit_cast(bf16x4, w); }
#define MFMA16(a, b, c) __builtin_amdgcn_mfma_f32_16x16x32_bf16((a), (b), (c), 0, 0, 0)
__device__ __forceinline__ bf16x8 widen4(const bf16x4 v) { const u32x2 t = __builtin_bit_cast(u32x2, v); u32x4 w; w.x = t.x; w.y = t.y; w.z = 0u; w.w = 0u; return __builtin_bit_cast(bf16x8, w); }
#define MFMA4(a, b, c) __builtin_amdgcn_mfma_f32_16x16x32_bf16(widen4(a), widen4(b), (c), 0, 0, 0)
__device__ __forceinline__ float dpp_row_last(float v) { return __int_as_float(__builtin_amdgcn_update_dpp(0, __float_as_int(v), 0x15F, 0xF, 0xF, false)); }
__device__ __forceinline__ f32x4 unpk4(const u32x2 w) { return (f32x4){__uint_as_float(w.x << 16), __uint_as_float(w.x & 0xffff0000u), __uint_as_float(w.y << 16), __uint_as_float(w.y & 0xffff0000u)}; }
__device__ __forceinline__ void scan_pipe(Frame& F, CArgs& a, int ri, const bf16_t* Vsrc, bf16_t* Y1buf) {
    const int lane = F.lane, x = lane & 15, g = lane >> 4;
    const f32x4 zero4 = (f32x4){0.f, 0.f, 0.f, 0.f};
    constexpr int NCH = (TCX + TX) / 16, NCH0 = TCX / 16;
    const int dir = F.wave >> 2, role = dir ? 3 - (F.wave & 3) : (F.wave & 3);
    if (role >= 2) __builtin_amdgcn_s_setprio(2);
    bf16_t* Yb = dir ? Y1buf : WSP(bf16_t, WS_Y0);
    float* BON = WSP(float, WS_BONUS) + (size_t)dir * NR * 16;
    LAS unsigned char* DB = F.lds + dir * 66560;
    LAS float* CST = (LAS float*)DB;
    LAS unsigned char* RINGQ = DB + 1024;
    LAS unsigned char* RINGV = DB + 17408;
    LAS unsigned char* OPS = DB + 23552;
    LAS unsigned char* C2 = DB + 40960;
    typedef const __attribute__((address_space(1))) char* gptr_t;
    size_t z0 = WS_R, z1 = WS_K; if (role == 1) { z0 = dir ? WS_A1 : WS_A0; z1 = dir ? WS_W1 : WS_W0; }
    const gptr_t gZ0 = (gptr_t)pg8::uni_ptr((const char*)(F.ws + z0)), gZ1 = (gptr_t)pg8::uni_ptr((const char*)(F.ws + z1)), gV = (gptr_t)pg8::uni_ptr((const char*)Vsrc);
    bf16x8 E0, E1;
    { u32x4 w0 = (u32x4){0u, 0u, 0u, 0u}, w1 = w0; const int d = x - 4 * g;
      const unsigned lo = (d == 0 || d == 2) ? 0x3F80u : 0u, hi = (d == 1 || d == 3) ? 0x3F800000u : 0u;
      if (d == 0 || d == 1) { w0.x = lo | hi; w1.z = lo | hi; } if (d == 2 || d == 3) { w0.y = lo | hi; w1.w = lo | hi; }
      E0 = __builtin_bit_cast(bf16x8, w0); E1 = __builtin_bit_cast(bf16x8, w1); }
    const bf16x4 E4 = __builtin_shufflevector(E0, E0, 0, 1, 2, 3);
    for (int task = F.bid; task < 256; task += F.G) {
        const int b = task >> 4, h = task & 15;
        if (role == 2) { CST[lane] = a.in[I_KK][ri * 1024 + 64 * h + lane]; CST[64 + lane] = a.in[I_KA][ri * 1024 + 64 * h + lane]; CST[128 + lane] = a.in[I_RK][ri * 1024 + 64 * h + lane]; }
        f32x4 ST[4][4];
#pragma unroll
        for (int vq = 0; vq < 4; ++vq)
#pragma unroll
            for (int q = 0; q < 4; ++q) ST[vq][q] = zero4;
#define SCAN_ROW(cc, tok) ((cc) < NCH0 ? (NXR + b * TCX + (dir ? (TCX - 1 - ((cc) * 16 + (tok))) : ((cc) * 16 + (tok)))) : (b * TX + (dir ? (TX - 1 - (((cc) - NCH0) * 16 + (tok))) : (((cc) - NCH0) * 16 + (tok)))))
#define SCAN_DMA(cc) do { LAS unsigned char* _dq = RINGQ + ((cc) & 1) * 8192 + role * 4096; LAS unsigned char* _dv = RINGV + ((cc) % 3) * 2048 + role * 1024; int _ln = lane; asm volatile("" : "+v"(_ln)); \
            const unsigned _r0 = (unsigned)(SCAN_ROW(cc, (_ln >> 3)) * D + 64 * h + 8 * (_ln & 7)) * 2u, _r1 = (unsigned)(SCAN_ROW(cc, (_ln >> 3) + 8) * D + 64 * h + 8 * (_ln & 7)) * 2u; \
            __builtin_amdgcn_global_load_lds((const __attribute__((address_space(1))) unsigned*)(gZ0 + _r0), (LAS unsigned*)(_dq), 16, 0, 0); \
            __builtin_amdgcn_global_load_lds((const __attribute__((address_space(1))) unsigned*)(gZ0 + _r1), (LAS unsigned*)(_dq + 1024), 16, 0, 0); \
            __builtin_amdgcn_global_load_lds((const __attribute__((address_space(1))) unsigned*)(gZ1 + _r0), (LAS unsigned*)(_dq + 2048), 16, 0, 0); \
            __builtin_amdgcn_global_load_lds((const __attribute__((address_space(1))) unsigned*)(gZ1 + _r1), (LAS unsigned*)(_dq + 3072), 16, 0, 0); \
            __builtin_amdgcn_global_load_lds((const __attribute__((address_space(1))) unsigned*)(gV + (role ? _r1 : _r0)), (LAS unsigned*)(_dv), 16, 0, 0); } while (0)
        if (role < 2) SCAN_DMA(0);
#pragma unroll 1
        for (int t = 0; t < NCH + 2; ++t) {
            if (role < 2) asm volatile("s_waitcnt vmcnt(0)" ::: "memory");
            asm volatile("s_waitcnt lgkmcnt(0)" ::: "memory");
            __builtin_amdgcn_s_barrier();
            asm volatile("" ::: "memory");
            if (role < 2) {
                if (t < NCH) {
                    const int cc = t;
                    if (cc + 1 < NCH) { __builtin_amdgcn_s_setprio(3); SCAN_DMA(cc + 1); __builtin_amdgcn_s_setprio(0); }
                    const LAS unsigned char* rw = RINGQ + (cc & 1) * 8192 + x * 128 + 8 * g;
                    LAS unsigned char* ob = OPS + (cc & 1) * 8704;
                    int cso = 4 * g; asm volatile("" : "+v"(cso));
                    float ssq = 0.f;
                    float bon = 0.f;
#pragma unroll
                    for (int u = 0; u < 2; ++u) {
                        const int q = 2 * role + u;
                        const f32x4 kkc = *(const LAS f32x4*)(CST + 16 * q + cso), kac = *(const LAS f32x4*)(CST + 64 + 16 * q + cso), rkc = *(const LAS f32x4*)(CST + 128 + 16 * q + cso);
                        const f32x4 rr = unpk4(*(const LAS u32x2*)(rw + 32 * q)), kv = unpk4(*(const LAS u32x2*)(rw + 2048 + 32 * q)), aa = unpk4(*(const LAS u32x2*)(rw + 4096 + 32 * q));
                        const f32x4 l2 = unpk4(*(const LAS u32x2*)(rw + 6144 + 32 * q)) * 1.44269504f;
                        const f32x4 kn = kv * kkc;
                        ssq += (kn[0] * kn[0] + kn[1] * kn[1]) + (kn[2] * kn[2] + kn[3] * kn[3]);
                        const f32x4 kd = kv * ((aa - 1.0f) * kac + 1.0f);
                        const f32x4 bq = rr * kd * rkc;
                        bon += (bq[0] + bq[1]) + (bq[2] + bq[3]);
                        f32x4 glq, at, bt, kt, rt;
#pragma unroll
                        for (int e = 0; e < 4; ++e) { float c = l2[e]; c += dpp_row_shr(c, 1); c += dpp_row_shr(c, 2); c += dpp_row_shr(c, 4); c += dpp_row_shr(c, 8);
                            const float e1 = __builtin_amdgcn_exp2f(c), e0 = __builtin_amdgcn_exp2f(c - l2[e]), e2 = __builtin_amdgcn_rcpf(e1);
                            glq[e] = dpp_row_last(e1); at[e] = -kn[e] * e0; bt[e] = kn[e] * aa[e] * e2; kt[e] = kd[e] * e2; rt[e] = rr[e] * e1; }
                        if (x == 0) *(LAS f32x4*)(ob + 8192 + (16 * g + 4 * q) * 4) = glq;
                        LAS unsigned char* op = ob + q * 512 + lane * 8;
                        *(LAS bf16x4*)(op) = pack4(at); *(LAS bf16x4*)(op + 2048) = pack4(bt); *(LAS bf16x4*)(op + 4096) = pack4(kt); *(LAS bf16x4*)(op + 6144) = pack4(rt);
                    }
                    bon += lane_xor(bon, 16, lane); bon += lane_xor(bon, 32, lane);
                    ssq += lane_xor(ssq, 16, lane); ssq += lane_xor(ssq, 32, lane);
                    if (g == 0) { *(LAS float*)(ob + 8192 + 256 + (role * 16 + x) * 4) = bon; *(LAS float*)(ob + 8192 + 384 + (role * 16 + x) * 4) = ssq; }
                }
            } else if (role == 2) {
                if (t >= 1 && t <= NCH) {
                    const int cc = t - 1;
                    const LAS unsigned char* ob = OPS + (cc & 1) * 8704;
                    LAS unsigned char* cb = C2 + (cc & 1) * 12544;
                    bf16x8 aP[2], bP[2], kP[2], rP[2];
                    { const LAS unsigned char* op = ob + lane * 8;
#pragma unroll
                      for (int s2 = 0; s2 < 2; ++s2) {
                          const u32x2 a0 = *(const LAS u32x2*)(op + (2 * s2) * 512), a1 = *(const LAS u32x2*)(op + (2 * s2 + 1) * 512);
                          const u32x2 b0 = *(const LAS u32x2*)(op + 2048 + (2 * s2) * 512), b1 = *(const LAS u32x2*)(op + 2048 + (2 * s2 + 1) * 512);
                          const u32x2 k0 = *(const LAS u32x2*)(op + 4096 + (2 * s2) * 512), k1 = *(const LAS u32x2*)(op + 4096 + (2 * s2 + 1) * 512);
                          const u32x2 r0 = *(const LAS u32x2*)(op + 6144 + (2 * s2) * 512), r1 = *(const LAS u32x2*)(op + 6144 + (2 * s2 + 1) * 512);
                          aP[s2] = __builtin_bit_cast(bf16x8, (u32x4){a0.x, a0.y, a1.x, a1.y}); bP[s2] = __builtin_bit_cast(bf16x8, (u32x4){b0.x, b0.y, b1.x, b1.y});
                          kP[s2] = __builtin_bit_cast(bf16x8, (u32x4){k0.x, k0.y, k1.x, k1.y}); rP[s2] = __builtin_bit_cast(bf16x8, (u32x4){r0.x, r0.y, r1.x, r1.y}); } }
                    *(LAS float*)(cb + 12288 + lane * 4) = *(const LAS float*)(ob + 8192 + lane * 4);
                    if (g == 0) { const LAS float* bp = (const LAS float*)(ob + 8192 + 256) + x; ((__attribute__((address_space(1))) float*)BON)[(size_t)SCAN_ROW(cc, x) * 16 + h] = bp[0] + bp[16]; }
                    LAS unsigned char* cl = cb + lane * 192;
                    *(LAS bf16x8*)(cl) = rP[0]; *(LAS bf16x8*)(cl + 16) = rP[1];
                    { const LAS unsigned char* vr = RINGV + (cc % 3) * 2048 + x * 128 + 8 * g;
#pragma unroll
                      for (int vq = 0; vq < 4; ++vq) *(LAS bf16x4*)(cl + 160 + 8 * vq) = pack4(MFMA4(__builtin_bit_cast(bf16x4, *(const LAS u32x2*)(vr + 32 * vq)), E4, zero4)); }
                    float rx; f32x4 r4;
                    { const LAS float* sq = (const LAS float*)(ob + 8192 + 384);
                      rx = __builtin_amdgcn_rsqf(sq[x] + sq[16 + x] + 1e-12f);
                      const f32x4 s0 = *(const LAS f32x4*)(sq + 4 * g), s1 = *(const LAS f32x4*)(sq + 16 + 4 * g);
#pragma unroll
                      for (int e = 0; e < 4; ++e) r4[e] = __builtin_amdgcn_rsqf(s0[e] + s1[e] + 1e-12f); }
                    f32x4 nA = MFMA16(bP[0], aP[0], zero4); nA = MFMA16(bP[1], aP[1], nA);
                    f32x4 nB = MFMA16(aP[0], bP[0], zero4); nB = MFMA16(aP[1], bP[1], nB);
                    f32x4 mak = MFMA16(kP[0], aP[0], zero4); mak = MFMA16(kP[1], aP[1], mak);
                    f32x4 mrb = MFMA16(bP[0], rP[0], zero4); mrb = MFMA16(bP[1], rP[1], mrb);
                    f32x4 mrk = MFMA16(kP[0], rP[0], zero4); mrk = MFMA16(kP[1], rP[1], mrk);
                    bf16x4 atT[4];
#pragma unroll
                    for (int q = 0; q < 4; ++q) { atT[q] = pack4(MFMA16(aP[q >> 1], (q & 1) ? E1 : E0, zero4) * r4);
                        *(LAS bf16x8*)(cl + 64 + 16 * q) = pack_2(MFMA16(bP[q >> 1], (q & 1) ? E1 : E0, zero4) * r4, MFMA16(kP[q >> 1], (q & 1) ? E1 : E0, zero4)); }
                    f32x4 eye;
#pragma unroll
                    for (int e = 0; e < 4; ++e) { const int j = 4 * g + e; const float rr2 = rx * r4[e]; nA[e] = (j < x) ? nA[e] * rr2 : 0.f; nB[e] = (j > x) ? nB[e] * rr2 : 0.f; mak[e] = (j < x) ? mak[e] * rx : 0.f; mrb[e] = (j <= x) ? mrb[e] * r4[e] : 0.f; mrk[e] = (j <= x) ? mrk[e] : 0.f; eye[e] = (j == x) ? 1.f : 0.f; }
                    const bf16x4 nAo = pack4(nA), nBo = pack4(nB);
                    *(LAS bf16x8*)(cl + 128) = pack_2(mrb, mrk);
                    *(LAS bf16x4*)(cl + 144) = pack4(mak);
                    const f32x4 m2B = MFMA4(nBo, nAo, zero4), m2A = MFMA4(nAo, nBo, zero4);
                    const bf16x4 m2Bo = pack4(m2B), m2Ao = pack4(m2A);
                    const f32x4 m4B = MFMA4(m2Ao, m2Bo, zero4), m4A = MFMA4(m2Bo, m2Ao, zero4);
                    const bf16x4 m4Bo = pack4(m4B), m4Ao = pack4(m4A);
                    const f32x4 m8A = MFMA4(m4Bo, m4Ao, zero4);
                    f32x4 X1 = eye + m2B; X1 = MFMA4(nBo, pack4(X1), X1);
                    X1 = MFMA4(m4Ao, pack4(X1), X1);
                    X1 = MFMA4(pack4(m8A), pack4(X1), X1);
                    const bf16x4 tA = pack4(X1);
                    *(LAS bf16x4*)(cl + 152) = tA;
                    { f32x4 ah[4];
#pragma unroll
                      for (int q = 0; q < 4; ++q) ah[q] = MFMA4(atT[q], tA, zero4);
                      *(LAS bf16x8*)(cl + 32) = pack_2(ah[0], ah[1]); *(LAS bf16x8*)(cl + 48) = pack_2(ah[2], ah[3]); }
                }
            } else {
                if (t >= 2) {
                    const int cc = t - 2;
                    const LAS unsigned char* cb = C2 + (cc & 1) * 12544;
                    const LAS unsigned char* cl = cb + lane * 192;
                    const bf16x8 rP0 = *(const LAS bf16x8*)(cl), rP1 = *(const LAS bf16x8*)(cl + 16), ahP0 = *(const LAS bf16x8*)(cl + 32), ahP1 = *(const LAS bf16x8*)(cl + 48);
                    bf16x8 bkT[4];
#pragma unroll
                    for (int q = 0; q < 4; ++q) bkT[q] = *(const LAS bf16x8*)(cl + 64 + 16 * q);
                    const bf16x8 mrbk = *(const LAS bf16x8*)(cl + 128);
                    const bf16x4 makA = *(const LAS bf16x4*)(cl + 144), tA = *(const LAS bf16x4*)(cl + 152);
                    f32x4 GL[4];
#pragma unroll
                    for (int q = 0; q < 4; ++q) GL[q] = *(const LAS f32x4*)(cb + 12288 + (16 * g + 4 * q) * 4);
#pragma unroll
                    for (int vq = 0; vq < 4; ++vq) {
                        const bf16x4 vT4 = *(const LAS bf16x4*)(cl + 160 + 8 * vq);
                        const f32x4 X = MFMA4(makA, vT4, zero4);
                        f32x4 U = MFMA4(tA, pack4(X), zero4);
                        const bf16x8 s0 = pack_2(ST[vq][0], ST[vq][1]), s1 = pack_2(ST[vq][2], ST[vq][3]);
                        U = MFMA16(ahP0, s0, U); U = MFMA16(ahP1, s1, U);
                        const u32x2 uu = __builtin_bit_cast(u32x2, pack4(U)), vv = __builtin_bit_cast(u32x2, vT4);
                        const bf16x8 uv = __builtin_bit_cast(bf16x8, (u32x4){uu.x, uu.y, vv.x, vv.y});
                        f32x4 Y = MFMA16(rP0, s0, zero4); Y = MFMA16(rP1, s1, Y); Y = MFMA16(mrbk, uv, Y);
#pragma unroll
                        for (int e = 0; e < 4; ++e) ((__attribute__((address_space(1))) bf16_t*)Yb)[(size_t)SCAN_ROW(cc, 4 * g + e) * D + 64 * h + 16 * vq + x] = (bf16_t)f2bf(Y[e]);
#pragma unroll
                        for (int q = 0; q < 4; ++q) ST[vq][q] = MFMA16(bkT[q], uv, ST[vq][q]) * GL[q];
                    }
                }
            }
        }
        asm volatile("s_waitcnt vmcnt(0) lgkmcnt(0)" ::: "memory");
        __builtin_amdgcn_s_barrier();
#undef SCAN_ROW
#undef SCAN_DMA
    }
    __builtin_amdgcn_s_setprio(0);
}
#undef MFMA16
#undef MFMA4

__device__ __forceinline__ void rwkv_out_pass(Frame& F, CArgs& a, int ri, const bf16_t* Vsrc, const bf16_t* Y1buf, int nrows) {
    const int gw = F.bid * NWAVES + F.wave, NGW = F.G * NWAVES, lane = F.lane;
    const bf16_t* Y0 = WSP(bf16_t, WS_Y0); const bf16_t* Gb = WSP(bf16_t, WS_G); bf16_t* OUTB = WSP(bf16_t, WS_OUTB);
    const float* BON = WSP(float, WS_BONUS);
    f32x4 lw[4], lb[4];
#pragma unroll
    for (int j = 0; j < 4; ++j) { lw[j] = *(const f32x4*)(a.in[I_LNW] + ri * 1024 + 4 * lane + 256 * j); lb[j] = *(const f32x4*)(a.in[I_LNB] + ri * 1024 + 4 * lane + 256 * j); }
    for (int row = gw; row < nrows; row += NGW) {
        const size_t base = (size_t)row * D + 4 * lane;
        u32x2 y0v[4], y1v[4], vvv[4], ggv[4]; float bonv[4]; float ov[4][4]; float am = 0.f;
#pragma unroll
        for (int j = 0; j < 4; ++j) { y0v[j] = *(const u32x2*)(Y0 + base + 256 * j); y1v[j] = *(const u32x2*)(Y1buf + base + 256 * j); vvv[j] = *(const u32x2*)(Vsrc + base + 256 * j); ggv[j] = *(const u32x2*)(Gb + base + 256 * j);
            const int head = 4 * j + (lane >> 4); bonv[j] = BON[(size_t)row * 16 + head] + BON[(size_t)NR * 16 + (size_t)row * 16 + head]; }
#pragma unroll
        for (int j = 0; j < 4; ++j) {
            const u32x2 y0 = y0v[j], y1 = y1v[j], vv = vvv[j], gg = ggv[j];
            float y[4] = { bf2f(y0.x & 0xffffu) + bf2f(y1.x & 0xffffu), bf2f(y0.x >> 16) + bf2f(y1.x >> 16), bf2f(y0.y & 0xffffu) + bf2f(y1.y & 0xffffu), bf2f(y0.y >> 16) + bf2f(y1.y >> 16) };
            float s = (y[0] + y[1]) + (y[2] + y[3]);
            s = row16_sum(s);
            const float mu = s * (1.0f / 64.0f);
            float q = 0.f;
#pragma unroll
            for (int i = 0; i < 4; ++i) { y[i] -= mu; q += y[i] * y[i]; }
            q = row16_sum(q);
            const float rstd = 1.0f / sqrtf(q * (1.0f / 64.0f) + 64e-5f);
            const float bon = bonv[j];
            const float v4[4] = { bf2f(vv.x & 0xffffu), bf2f(vv.x >> 16), bf2f(vv.y & 0xffffu), bf2f(vv.y >> 16) };
            const float g4[4] = { bf2f(gg.x & 0xffffu), bf2f(gg.x >> 16), bf2f(gg.y & 0xffffu), bf2f(gg.y >> 16) };
#pragma unroll
            for (int i = 0; i < 4; ++i) { ov[j][i] = (y[i] * rstd * lw[j][i] + lb[j][i] + bon * v4[i]) * g4[i]; am = fmaxf(am, fabsf(ov[j][i])); }
        }
        am = wave_max(am); const float inv = am > 0.f ? 127.0f / am : 0.f;
        signed char* oq = (signed char*)OUTB + (size_t)row * D;
#pragma unroll
        for (int j = 0; j < 4; ++j) { unsigned o = 0u;
#pragma unroll
            for (int i = 0; i < 4; ++i) { const int qi = (int)__builtin_rintf(ov[j][i] * inv); o |= ((unsigned)qi & 255u) << (8 * i); }
            *(unsigned*)(oq + 4 * lane + 256 * j) = o; }
        if (lane == 0) WSP(float, WS_OUTSC)[row] = am * (1.0f / 127.0f);
    }
}

using pg8::Unit;
typedef const f32x4 (&AccRef)[2][2][4][2];
template <int NN, int LDA_, int LDB_> struct ProbBase { static constexpr int LDA = LDA_, LDB = LDB_; int G, c, nM; const char* gA; const char* gB;
    __device__ __forceinline__ bool next(int i, Unit& u) const { return pg8::tile_order(i, G, c, nM, NN, u); } };

struct ProbF2 : ProbBase<576, 256, D> {
    __device__ __forceinline__ unsigned a_off(const Unit& u) const { return (unsigned)u.pm * 256 * 256 * 2; }
    __device__ __forceinline__ unsigned b_off(const Unit& u) const {
        if (u.pn < 512) { const int b = u.pn >> 5, g = (u.pn >> 3) & 3, tt = u.pn & 7; return (unsigned)((b * TX + 256 * tt) * D + 256 * g) * 2u; }
        const int q = u.pn - 512, b = q >> 2, g = q & 3; return (unsigned)((NXR + b * TCX) * D + 256 * g) * 2u; }
    __device__ __forceinline__ int nt(const Unit&) const { return 4; } };
struct EpiF2 { static constexpr bool PERM = true; bf16_t* YT; bf16_t* YTC;
    __device__ __forceinline__ void operator()(AccRef acc, const Unit& u, int wr, int wc, int fr, int fq) const {
        bf16_t* base; int ld;
        if (u.pn < 512) { const int b = u.pn >> 5, g = (u.pn >> 3) & 3, tt = u.pn & 7; base = YT + ((size_t)(b * 1024 + 256 * g) * 2 + u.pm) * 2048 + 256 * tt; ld = 4096; }
        else { const int q = u.pn - 512, b = q >> 2, g = q & 3; base = YTC + ((size_t)(b * 1024 + 256 * g) * 2 + u.pm) * 256; ld = 512; }
        const int col0 = wc * 32 + 8 * fq;
#pragma unroll
        for (int ai = 0; ai < 2; ++ai)
#pragma unroll
            for (int m = 0; m < 4; ++m) { bf16_t* rowp = base + (size_t)(wr * 64 + fr + ai * 128 + m * 16) * ld + col0;
#pragma unroll
                for (int bj = 0; bj < 2; ++bj) pg8::st8(rowp + bj * 128, acc[ai][bj][m][0], acc[ai][bj][m][1]); }
    } };
struct ProbF3X : ProbBase<4, 4096, 4096> {
    __device__ __forceinline__ unsigned a_off(const Unit& u) const { return (unsigned)(u.pm & 7) * 256 * 4096 * 2; }
    __device__ __forceinline__ unsigned b_off(const Unit& u) const { return (unsigned)((u.pm >> 3) * 1024 + 256 * u.pn) * 4096u * 2u; }
    __device__ __forceinline__ int nt(const Unit&) const { return 64; } };
struct ProbF3H : ProbBase<4, 4096, 4096> {
    __device__ __forceinline__ bool next(int i, Unit& u) const { const int pair = (i >> 1) * G + c; if (pair >= 256) return false; u.pm = pair >> 2; u.pn = (pair & 3) | ((i & 1) << 2); return true; }
    __device__ __forceinline__ unsigned a_off(const Unit& u) const { return (unsigned)(u.pm & 3) * 256u * 4096u * 2u + ((u.pn & 4) ? 4096u : 0u); }
    __device__ __forceinline__ unsigned b_off(const Unit& u) const { return (unsigned)((u.pm >> 2) * 1024 + 256 * (u.pn & 3)) * 4096u * 2u + ((u.pn & 4) ? 4096u : 0u); }
    __device__ __forceinline__ int nt(const Unit&) const { return 32; } };
struct EpiF3H { static constexpr bool PERM = true; bf16_t* OUT; f32x4* scratch; int bid;
    __device__ __forceinline__ void operator()(AccRef acc, const Unit& u, int wr, int wc, int fr, int fq) const {
        int tid = (wr * 4 + wc) * 64 + fq * 16 + fr; asm volatile("" : "+v"(tid));
        u32x4* sp = (u32x4*)scratch + (size_t)bid * 16 * 512 + tid;
        if (!(u.pn & 4)) {
#pragma unroll
            for (int ai = 0; ai < 2; ++ai)
#pragma unroll
                for (int bj = 0; bj < 2; ++bj)
#pragma unroll
                    for (int m = 0; m < 4; ++m) { const f32x4 c0 = acc[ai][bj][m][0], c1 = acc[ai][bj][m][1];
                        u32x4 w; w.x = pg8::cvt_pk_bf16(c0[0], c0[1]); w.y = pg8::cvt_pk_bf16(c0[2], c0[3]); w.z = pg8::cvt_pk_bf16(c1[0], c1[1]); w.w = pg8::cvt_pk_bf16(c1[2], c1[3]);
                        sp[((ai * 2 + bj) * 4 + m) * 512] = w; }
            return;
        }
        asm volatile("s_waitcnt vmcnt(0)" ::: "memory");
        int fr2 = fr; asm volatile("" : "+v"(fr2));
        const int b = u.pm >> 2, kt = u.pm & 3, col0 = 256 * (u.pn & 3) + wc * 32 + 8 * fq;
#pragma unroll
        for (int ai = 0; ai < 2; ++ai)
#pragma unroll
            for (int m = 0; m < 4; ++m) { const int k = 256 * kt + wr * 64 + fr2 + ai * 128 + m * 16;
                bf16_t* r1 = OUT + (size_t)(b * TX + k) * D + col0; bf16_t* r2 = OUT + (size_t)(b * TX + ((TX - k) & (TX - 1))) * D + col0;
#pragma unroll
                for (int bj = 0; bj < 2; ++bj) { const u32x4 pw = sp[((ai * 2 + bj) * 4 + m) * 512];
                    const f32x4 p0 = (f32x4){bf2f(pw.x & 0xffffu), bf2f(pw.x >> 16), bf2f(pw.y & 0xffffu), bf2f(pw.y >> 16)}, p1 = (f32x4){bf2f(pw.z & 0xffffu), bf2f(pw.z >> 16), bf2f(pw.w & 0xffffu), bf2f(pw.w >> 16)};
                    pg8::st8(r1 + bj * 128, p0 + acc[ai][bj][m][0], p1 + acc[ai][bj][m][1]);
                    if (k > 0) pg8::st8(r2 + bj * 128, p0 - acc[ai][bj][m][0], p1 - acc[ai][bj][m][1]); }
                __builtin_amdgcn_sched_barrier(0); }
    } };
struct ProbF3C : ProbBase<4, 512, 512> {
    __device__ __forceinline__ unsigned a_off(const Unit&) const { return 0u; }
    __device__ __forceinline__ unsigned b_off(const Unit& u) const { return (unsigned)(u.pm * 1024 + 256 * u.pn) * 512u * 2u; }
    __device__ __forceinline__ int nt(const Unit&) const { return 8; } };
struct EpiRows { static constexpr bool PERM = true; bf16_t* OUT; int row0, ld;
    __device__ __forceinline__ void operator()(AccRef acc, const Unit& u, int wr, int wc, int fr, int fq) const {
        bf16_t* base = OUT + (size_t)(row0 + 256 * u.pm) * ld + 256 * u.pn; const int col0 = wc * 32 + 8 * fq;
#pragma unroll
        for (int ai = 0; ai < 2; ++ai)
#pragma unroll
            for (int m = 0; m < 4; ++m) { bf16_t* rowp = base + (size_t)(wr * 64 + fr + ai * 128 + m * 16) * ld + col0;
#pragma unroll
                for (int bj = 0; bj < 2; ++bj) pg8::st8(rowp + bj * 128, acc[ai][bj][m][0], acc[ai][bj][m][1]); }
    } };
template <int NN, int LDA_, int LDB_, int NT> struct ProbRM : ProbBase<NN, LDA_, LDB_> {
    __device__ __forceinline__ unsigned a_off(const Unit& u) const { return (unsigned)u.pm * 256u * LDA_ * 2u; }
    __device__ __forceinline__ unsigned b_off(const Unit& u) const { return (unsigned)u.pn * 256u * LDB_ * 2u; }
    __device__ __forceinline__ int nt(const Unit&) const { return NT; } };
struct ProbRG1A : ProbBase<12, D, 2048> {
    __device__ __forceinline__ unsigned a_off(const Unit& u) const { const int grp = u.pn >> 2; return (grp == 2 ? (unsigned)(WS_XV - WS_XR) : (unsigned)grp * (unsigned)(WS_XK - WS_XR)) + (unsigned)u.pm * 256u * D * 2u; }
    __device__ __forceinline__ unsigned b_off(const Unit& u) const { return (unsigned)u.pn * 256u * 2048u * 2u; }
    __device__ __forceinline__ int nt(const Unit&) const { return 16; } };
struct ProbRG1A8 : ProbBase<12, 512, 2048> {
    __device__ __forceinline__ unsigned a_off(const Unit& u) const { const int grp = u.pn >> 2; return (grp == 2 ? (unsigned)(WS_XV - WS_XR) : (unsigned)grp * (unsigned)(WS_XK - WS_XR)) + (unsigned)u.pm * 256u * 1024u; }
    __device__ __forceinline__ unsigned b_off(const Unit& u) const { return (unsigned)u.pn * 256u * 4096u; }
    __device__ __forceinline__ int nt(const Unit&) const { return 8; } };
struct EpiRG1A8 { static constexpr bool PERM = true; unsigned char* ws; size_t voff; const float* XSC; const float* WSC;
    __device__ __forceinline__ void operator()(const pg8::i32x4 (&acc)[2][2][4][2], const Unit& u, int wr, int wc, int fr, int fq) const {
        const int which = u.pn >> 2; const size_t off = (which == 2) ? voff : WS_R + (size_t)which * (WS_K - WS_R);
        bf16_t* base = (bf16_t*)(ws + off) + (size_t)u.pm * 256 * D + (u.pn & 3) * 256 + wc * 32 + 8 * fq;
        const float* wsp = WSC + u.pn * 256 + wc * 32 + 8 * fq;
        f32x4 sw[2][2];
#pragma unroll
        for (int bj = 0; bj < 2; ++bj)
#pragma unroll
            for (int n = 0; n < 2; ++n) sw[bj][n] = *(const f32x4*)(wsp + 128 * bj + 4 * n);
        float sxv[2][4];
#pragma unroll
        for (int ai = 0; ai < 2; ++ai)
#pragma unroll
            for (int m = 0; m < 4; ++m) sxv[ai][m] = XSC[(size_t)which * NR + (size_t)u.pm * 256 + wr * 64 + fr + ai * 128 + m * 16];
#pragma unroll
        for (int ai = 0; ai < 2; ++ai)
#pragma unroll
            for (int m = 0; m < 4; ++m) { const int r = wr * 64 + fr + ai * 128 + m * 16; const float sx = sxv[ai][m];
#pragma unroll
                for (int bj = 0; bj < 2; ++bj) { f32x4 v0, v1;
#pragma unroll
                    for (int i = 0; i < 4; ++i) { v0[i] = (float)acc[ai][bj][m][0][i] * (sx * sw[bj][0][i]); v1[i] = (float)acc[ai][bj][m][1][i] * (sx * sw[bj][1][i]); }
                    pg8::st8(base + (size_t)r * D + 128 * bj, v0, v1); } }
    } };
struct ProbRG1B : ProbBase<2, 2048, 2048> {
    __device__ __forceinline__ bool next(int i, Unit& u) const { if (!pg8::tile_order(i, G, c, nM, 2, u)) return false; u.pn += 12; return true; }
    __device__ __forceinline__ unsigned a_off(const Unit& u) const { return (unsigned)u.pm * 256u * 2048u * 2u; }
    __device__ __forceinline__ unsigned b_off(const Unit& u) const { return (unsigned)u.pn * 256u * 2048u * 2u; }
    __device__ __forceinline__ int nt(const Unit&) const { return 32; } };
struct ProbRG1B8 : ProbBase<2, 2048, 1024> {
    __device__ __forceinline__ bool next(int i, Unit& u) const { if (!pg8::tile_order(i, G, c, nM, 2, u)) return false; u.pn += 12; return true; }
    __device__ __forceinline__ unsigned a_off(const Unit& u) const { return (unsigned)u.pm * 256u * 4096u + 2048u; }
    __device__ __forceinline__ unsigned b_off(const Unit& u) const { return (unsigned)(u.pn - 12) * 256u * 2048u; }
    __device__ __forceinline__ int nt(const Unit&) const { return 16; } };
struct EpiRG1B8 { static constexpr bool PERM = true; unsigned char* ws; const float* XSC; const float* WSC;
    __device__ __forceinline__ void operator()(const pg8::i32x4 (&acc)[2][2][4][2], const Unit& u, int wr, int wc, int fr, int fq) const {
        bf16_t* base = (bf16_t*)(ws + WS_A23) + (size_t)u.pm * 256 * 512 + (u.pn - 12) * 256; const int act = u.pn - 11;
        const int col0 = wc * 32 + 8 * fq;
        const float* wsp = WSC + (u.pn - 12) * 256 + col0;
        f32x4 sw[2][2];
#pragma unroll
        for (int bj = 0; bj < 2; ++bj)
#pragma unroll
            for (int n = 0; n < 2; ++n) sw[bj][n] = *(const f32x4*)(wsp + 128 * bj + 4 * n);
        float sxv[2][4];
#pragma unroll
        for (int ai = 0; ai < 2; ++ai)
#pragma unroll
            for (int m = 0; m < 4; ++m) sxv[ai][m] = XSC[(size_t)u.pm * 256 + wr * 64 + fr + ai * 128 + m * 16];
#pragma unroll
        for (int ai = 0; ai < 2; ++ai)
#pragma unroll
            for (int m = 0; m < 4; ++m) { bf16_t* rowp = base + (size_t)(wr * 64 + fr + ai * 128 + m * 16) * 512 + col0; const float sx = sxv[ai][m];
                f32x4 v0, v1, u0, u1;
#pragma unroll
                for (int i = 0; i < 4; ++i) { v0[i] = (float)acc[ai][0][m][0][i] * (sx * sw[0][0][i]); v1[i] = (float)acc[ai][0][m][1][i] * (sx * sw[0][1][i]);
                    u0[i] = (float)acc[ai][1][m][0][i] * (sx * sw[1][0][i]); u1[i] = (float)acc[ai][1][m][1][i] * (sx * sw[1][1][i]); }
                if (act == 1) {
#pragma unroll
                    for (int i = 0; i < 4; ++i) { v0[i] = tanhf_(v0[i]); v1[i] = tanhf_(v1[i]); } }
                else {
#pragma unroll
                    for (int i = 0; i < 4; ++i) { v0[i] = sigmoidf_(v0[i]); v1[i] = sigmoidf_(v1[i]); } }
                pg8::st8(rowp, v0, v1);
                pg8::st8(rowp + 128, u0, u1); }
    } };
struct EpiWO { static constexpr bool PERM = true; bf16_t* DELTA; const float* mod; const float* bias;
    __device__ __forceinline__ void operator()(AccRef acc, const Unit& u, int wr, int wc, int fr, int fq) const {
        const int b = u.pm < 128 ? (u.pm >> 3) : 16;
        const int col0 = u.pn * 256 + wc * 32 + 8 * fq; const float* gate = mod + (size_t)b * 6144 + 2 * 1024;
        f32x4 gv[2][2], bv[2][2];
#pragma unroll
        for (int bj = 0; bj < 2; ++bj)
#pragma unroll
            for (int n = 0; n < 2; ++n) { gv[bj][n] = *(const f32x4*)(gate + col0 + bj * 128 + 4 * n); bv[bj][n] = *(const f32x4*)(bias + col0 + bj * 128 + 4 * n); }
#pragma unroll
        for (int ai = 0; ai < 2; ++ai)
#pragma unroll
            for (int m = 0; m < 4; ++m) { bf16_t* rowp = DELTA + (size_t)(u.pm * 256 + wr * 64 + fr + ai * 128 + m * 16) * D + col0;
#pragma unroll
                for (int bj = 0; bj < 2; ++bj) pg8::st8(rowp + bj * 128, gv[bj][0] * (acc[ai][bj][m][0] + bv[bj][0]), gv[bj][1] * (acc[ai][bj][m][1] + bv[bj][1])); }
    } };
struct ProbWO8 : ProbBase<4, 512, 512> {
    __device__ __forceinline__ unsigned a_off(const Unit& u) const { return (unsigned)u.pm * 256u * 1024u; }
    __device__ __forceinline__ unsigned b_off(const Unit& u) const { return (unsigned)u.pn * 256u * 1024u; }
    __device__ __forceinline__ int nt(const Unit&) const { return 8; } };
struct EpiWO8 { static constexpr bool PERM = true; bf16_t* DELTA; const float* mod; const float* bias; const float* XSC; const float* WSC;
    __device__ __forceinline__ void operator()(const pg8::i32x4 (&acc)[2][2][4][2], const Unit& u, int wr, int wc, int fr, int fq) const {
        const int b = u.pm < 128 ? (u.pm >> 3) : 16;
        const int col0 = u.pn * 256 + wc * 32 + 8 * fq; const float* gate = mod + (size_t)b * 6144 + 2 * 1024;
        f32x4 gs[2][2], gb[2][2];
#pragma unroll
        for (int bj = 0; bj < 2; ++bj)
#pragma unroll
            for (int n = 0; n < 2; ++n) { const f32x4 g = *(const f32x4*)(gate + col0 + bj * 128 + 4 * n); gs[bj][n] = g * *(const f32x4*)(WSC + col0 + bj * 128 + 4 * n); gb[bj][n] = g * *(const f32x4*)(bias + col0 + bj * 128 + 4 * n); }
        float sxv[2][4];
#pragma unroll
        for (int ai = 0; ai < 2; ++ai)
#pragma unroll
            for (int m = 0; m < 4; ++m) sxv[ai][m] = XSC[(size_t)u.pm * 256 + wr * 64 + fr + ai * 128 + m * 16];
#pragma unroll
        for (int ai = 0; ai < 2; ++ai)
#pragma unroll
            for (int m = 0; m < 4; ++m) { bf16_t* rowp = DELTA + (size_t)(u.pm * 256 + wr * 64 + fr + ai * 128 + m * 16) * D + col0; const float sx = sxv[ai][m];
#pragma unroll
                for (int bj = 0; bj < 2; ++bj) { f32x4 v0, v1;
#pragma unroll
                    for (int i = 0; i < 4; ++i) { v0[i] = (float)acc[ai][bj][m][0][i] * (sx * gs[bj][0][i]) + gb[bj][0][i]; v1[i] = (float)acc[ai][bj][m][1][i] * (sx * gs[bj][1][i]) + gb[bj][1][i]; }
                    pg8::st8(rowp + bj * 128, v0, v1); } }
    } };
struct EpiRG1 { static constexpr bool PERM = true; unsigned char* ws; size_t voff;
    __device__ __forceinline__ void operator()(AccRef acc, const Unit& u, int wr, int wc, int fr, int fq) const {
        bf16_t* base; int ld; int act = 0;
        if (u.pn < 12) { const int which = u.pn >> 2; const size_t off = (which == 2) ? voff : WS_R + (size_t)which * (WS_K - WS_R);
            base = (bf16_t*)(ws + off) + (size_t)u.pm * 256 * D + (u.pn & 3) * 256; ld = D; }
        else { base = (bf16_t*)(ws + WS_A23) + (size_t)u.pm * 256 * 512 + (u.pn - 12) * 256; ld = 512; act = u.pn - 11; }
        const int col0 = wc * 32 + 8 * fq;
#pragma unroll
        for (int ai = 0; ai < 2; ++ai)
#pragma unroll
            for (int m = 0; m < 4; ++m) { bf16_t* rowp = base + (size_t)(wr * 64 + fr + ai * 128 + m * 16) * ld + col0;
                f32x4 v0 = acc[ai][0][m][0], v1 = acc[ai][0][m][1];
                if (act == 1) {
#pragma unroll
                    for (int i = 0; i < 4; ++i) { v0[i] = tanhf_(v0[i]); v1[i] = tanhf_(v1[i]); } }
                else if (act == 2) {
#pragma unroll
                    for (int i = 0; i < 4; ++i) { v0[i] = sigmoidf_(v0[i]); v1[i] = sigmoidf_(v1[i]); } }
                pg8::st8(rowp, v0, v1);
                pg8::st8(rowp + 128, acc[ai][1][m][0], acc[ai][1][m][1]); }
    } };
struct ProbRG2 : ProbBase<24, 512, 256> { int nn;
    __device__ __forceinline__ bool next(int i, Unit& u) const { return pg8::tile_order(i, G, c, nM, nn, u); }
    __device__ __forceinline__ unsigned a_off(const Unit& u) const { return ((unsigned)u.pm * 256u * 512u + (u.pn >= 16 ? 256u : 0u)) * 2u; }
    __device__ __forceinline__ unsigned b_off(const Unit& u) const { return (unsigned)u.pn * 256u * 256u * 2u; }
    __device__ __forceinline__ int nt(const Unit&) const { return 4; } };
struct EpiRG2 { static constexpr bool PERM = true; unsigned char* ws; const float *w0, *a0, *v0;
    __device__ __forceinline__ void operator()(AccRef acc, const Unit& u, int wr, int wc, int fr, int fq) const {
        const int grp = u.pn >> 2, colb = (u.pn & 3) * 256;
        size_t doff = WS_W0; if (grp == 1) doff = WS_W1; if (grp == 2) doff = WS_A0; if (grp == 3) doff = WS_A1; if (grp == 4) doff = WS_G; if (grp == 5) doff = WS_VB;
        bf16_t* dst = (bf16_t*)(ws + doff); bf16_t* Vb = (bf16_t*)(ws + WS_VB); const bf16_t* VF = (const bf16_t*)(ws + WS_VFIRST);
        const float* bias = w0 + grp * 1024; if (grp >= 2) bias = a0 + (grp - 2) * 1024; if (grp >= 4) bias = v0;
        const int col0 = colb + wc * 32 + 8 * fq;
        f32x4 bv[2][2];
#pragma unroll
        for (int bj = 0; bj < 2; ++bj)
#pragma unroll
            for (int n = 0; n < 2; ++n) bv[bj][n] = (grp == 4) ? (f32x4){0.f, 0.f, 0.f, 0.f} : *(const f32x4*)(bias + col0 + bj * 128 + 4 * n);
#pragma unroll
        for (int ai = 0; ai < 2; ++ai)
#pragma unroll
            for (int m = 0; m < 4; ++m) { const size_t ro = (size_t)(u.pm * 256 + wr * 64 + fr + ai * 128 + m * 16) * D + col0;
#pragma unroll
                for (int bj = 0; bj < 2; ++bj) {
                    f32x4 v0v = acc[ai][bj][m][0] + bv[bj][0], v1v = acc[ai][bj][m][1] + bv[bj][1];
                    if (grp < 2) {
#pragma unroll
                        for (int i = 0; i < 4; ++i) { v0v[i] = -0.60653066f * sigmoidf_(v0v[i]); v1v[i] = -0.60653066f * sigmoidf_(v1v[i]); } }
                    else if (grp < 4) {
#pragma unroll
                        for (int i = 0; i < 4; ++i) { v0v[i] = sigmoidf_(v0v[i]); v1v[i] = sigmoidf_(v1v[i]); } }
                    else if (grp == 5) {
                        const u32x4 vp = *(const u32x4*)(Vb + ro + bj * 128), vf = *(const u32x4*)(VF + ro + bj * 128);
                        const unsigned vpw[4] = {vp.x, vp.y, vp.z, vp.w}, vfw[4] = {vf.x, vf.y, vf.z, vf.w};
                        float pv[8], fv[8];
#pragma unroll
                        for (int i = 0; i < 4; ++i) { pv[2 * i] = bf2f(vpw[i] & 0xffffu); pv[2 * i + 1] = bf2f(vpw[i] >> 16); fv[2 * i] = bf2f(vfw[i] & 0xffffu); fv[2 * i + 1] = bf2f(vfw[i] >> 16); }
#pragma unroll
                        for (int i = 0; i < 4; ++i) { v0v[i] = pv[i] + (fv[i] - pv[i]) * sigmoidf_(v0v[i]); v1v[i] = pv[4 + i] + (fv[4 + i] - pv[4 + i]) * sigmoidf_(v1v[i]); } }
                    pg8::st8(dst + ro + bj * 128, v0v, v1v);
                } }
    } };
__device__ __forceinline__ void lora2_phase(Frame& F, const ProbRG2& P, const EpiRG2& E) {
    const int wid = F.wave, lane = F.lane, wr = wid >> 2, wc = wid & 3, fr = lane & 15, fq = lane >> 4;
    const bf16_t* A23 = (const bf16_t*)P.gA; const bf16_t* W2 = (const bf16_t*)P.gB;
    Unit u;
    for (int i = 0; P.next(i, u); ++i) {
        const int grp = u.pn >> 2;
        const int acol0 = grp < 4 ? 64 * grp : (grp == 4 ? 256 : 384), bcol0 = grp < 4 ? 64 * grp : (grp == 4 ? 0 : 128), K = grp < 4 ? 64 : (grp == 4 ? 128 : 32);
        f32x4 acc[2][2][4][2];
#pragma unroll
        for (int a = 0; a < 2; ++a)
#pragma unroll
            for (int b = 0; b < 2; ++b)
#pragma unroll
                for (int m = 0; m < 4; ++m)
#pragma unroll
                    for (int n = 0; n < 2; ++n) acc[a][b][m][n] = (f32x4){0.f, 0.f, 0.f, 0.f};
        const bf16_t* arow = A23 + (size_t)(u.pm * 256 + wr * 64 + fr) * 512 + acol0 + 8 * fq;
        const bf16_t* brow[2][2];
#pragma unroll
        for (int bj = 0; bj < 2; ++bj)
#pragma unroll
            for (int n = 0; n < 2; ++n) { const int rho = 128 * bj + 32 * wc + 16 * n + fr; brow[bj][n] = W2 + (size_t)(u.pn * 256 + (rho & ~31) + pg8::perm32(rho & 31)) * 256 + bcol0 + 8 * fq; }
#pragma unroll 1
        for (int k0 = 0; k0 < K; k0 += 64) {
            const bool two = (K - k0) >= 64;
            bf16x8 Bf[2][2][2];
#pragma unroll
            for (int bj = 0; bj < 2; ++bj)
#pragma unroll
                for (int n = 0; n < 2; ++n) { Bf[bj][n][0] = *(const bf16x8*)(brow[bj][n] + k0); Bf[bj][n][1] = two ? *(const bf16x8*)(brow[bj][n] + k0 + 32) : (bf16x8){0, 0, 0, 0, 0, 0, 0, 0}; }
#pragma unroll
            for (int ai = 0; ai < 2; ++ai) {
                bf16x8 Af[4][2];
#pragma unroll
                for (int m = 0; m < 4; ++m) { const bf16_t* ap = arow + (size_t)(128 * ai + 16 * m) * 512 + k0; Af[m][0] = *(const bf16x8*)ap; Af[m][1] = two ? *(const bf16x8*)(ap + 32) : (bf16x8){0, 0, 0, 0, 0, 0, 0, 0}; }
#pragma unroll
                for (int bj = 0; bj < 2; ++bj)
#pragma unroll
                    for (int m = 0; m < 4; ++m)
#pragma unroll
                        for (int n = 0; n < 2; ++n) {
                            acc[ai][bj][m][n] = __builtin_amdgcn_mfma_f32_16x16x32_bf16(Bf[bj][n][0], Af[m][0], acc[ai][bj][m][n], 0, 0, 0);
                            acc[ai][bj][m][n] = __builtin_amdgcn_mfma_f32_16x16x32_bf16(Bf[bj][n][1], Af[m][1], acc[ai][bj][m][n], 0, 0, 0);
                        }
            }
        }
        E(acc, u, wr, wc, fr, fq);
    }
}
template <int NN, int ROWS_PER_E> struct ProbMoE : ProbBase<NN, D, D> {
    __device__ __forceinline__ bool next(int i, Unit& u) const { if (!pg8::tile_order(i, this->G, this->c, this->nM, NN, u)) return false;
        if (this->nM == NS / 256) { const int e = u.pm / 18, r = u.pm % 18; u.pm = r < 16 ? r * 16 + e : 256 + 2 * e + (r - 16); } else { const int e = u.pm >> 4, r = u.pm & 15; u.pm = r * 16 + e; }
        return true; }
    __device__ __forceinline__ unsigned a_off(const Unit& u) const { return (unsigned)u.pm * 256u * D * 2u; }
    __device__ __forceinline__ unsigned b_off(const Unit& u) const { const int e = u.pm < 256 ? (u.pm & 15) : ((u.pm - 256) >> 1); return (unsigned)(e * ROWS_PER_E + 256 * u.pn) * D * 2u; }
    __device__ __forceinline__ int nt(const Unit&) const { return 16; } };
template <int NN> struct ProbMoE8 : ProbBase<NN, 512, 512> {
    __device__ __forceinline__ bool next(int i, Unit& u) const { if (!pg8::tile_order(i, this->G, this->c, this->nM, NN, u)) return false;
        if (this->nM == NS / 256) { const int e = u.pm / 18, r = u.pm % 18; u.pm = r < 16 ? r * 16 + e : 256 + 2 * e + (r - 16); } else { const int e = u.pm >> 4, r = u.pm & 15; u.pm = r * 16 + e; }
        return true; }
    __device__ __forceinline__ unsigned a_off(const Unit& u) const { return (unsigned)u.pm * 256u * 1024u; }
    __device__ __forceinline__ unsigned b_off(const Unit& u) const { const int e = u.pm < 256 ? (u.pm & 15) : ((u.pm - 256) >> 1); return (unsigned)(e * 2048 + 256 * u.pn) * 1024u; }
    __device__ __forceinline__ int nt(const Unit&) const { return 8; } };
struct EpiGU8 { static constexpr bool PERM = true; bf16_t* HID; const float* XSC; const float* WSC;
    __device__ __forceinline__ void operator()(const pg8::i32x4 (&acc)[2][2][4][2], const Unit& u, int wr, int wc, int fr, int fq) const {
        const int e = u.pm < 256 ? (u.pm & 15) : ((u.pm - 256) >> 1);
        const float* wsp = WSC + e * 2048 + 256 * u.pn + wc * 32 + 8 * fq;
        const f32x4 sg0 = *(const f32x4*)(wsp), sg1 = *(const f32x4*)(wsp + 4), su0 = *(const f32x4*)(wsp + 128), su1 = *(const f32x4*)(wsp + 132);
        bf16_t* base = HID + (size_t)u.pm * 256 * D + 128 * u.pn + wc * 32 + 8 * fq;
        float sxv[2][4];
#pragma unroll
        for (int ai = 0; ai < 2; ++ai)
#pragma unroll
            for (int m = 0; m < 4; ++m) sxv[ai][m] = XSC[(size_t)u.pm * 256 + wr * 64 + fr + ai * 128 + m * 16];
#pragma unroll
        for (int ai = 0; ai < 2; ++ai)
#pragma unroll
            for (int m = 0; m < 4; ++m) { const int r = wr * 64 + fr + ai * 128 + m * 16; const float sx = sxv[ai][m]; f32x4 h0, h1;
#pragma unroll
                for (int i = 0; i < 4; ++i) { const float g0 = (float)acc[ai][0][m][0][i] * (sx * sg0[i]), g1 = (float)acc[ai][0][m][1][i] * (sx * sg1[i]);
                    h0[i] = g0 * sigmoidf_(g0) * ((float)acc[ai][1][m][0][i] * (sx * su0[i])); h1[i] = g1 * sigmoidf_(g1) * ((float)acc[ai][1][m][1][i] * (sx * su1[i])); }
                pg8::st8(base + (size_t)r * D, h0, h1); }
    } };
struct EpiGU { static constexpr bool PERM = true; bf16_t* HID;
    __device__ __forceinline__ void operator()(AccRef acc, const Unit& u, int wr, int wc, int fr, int fq) const {
        bf16_t* base = HID + (size_t)u.pm * 256 * D + 128 * u.pn + wc * 32 + 8 * fq;
#pragma unroll
        for (int ai = 0; ai < 2; ++ai)
#pragma unroll
            for (int m = 0; m < 4; ++m) { f32x4 h0, h1;
#pragma unroll
                for (int i = 0; i < 4; ++i) { const float g0 = acc[ai][0][m][0][i], g1 = acc[ai][0][m][1][i]; h0[i] = g0 * sigmoidf_(g0) * acc[ai][1][m][0][i]; h1[i] = g1 * sigmoidf_(g1) * acc[ai][1][m][1][i]; }
                pg8::st8(base + (size_t)(wr * 64 + fr + ai * 128 + m * 16) * D, h0, h1); }
    } };
struct EpiDN { static constexpr bool PERM = true; bf16_t* YS; const float* GATE;
    __device__ __forceinline__ void operator()(AccRef acc, const Unit& u, int wr, int wc, int fr, int fq) const {
        const int col0 = 256 * u.pn + wc * 32 + 8 * fq;
#pragma unroll
        for (int ai = 0; ai < 2; ++ai)
#pragma unroll
            for (int m = 0; m < 4; ++m) { const size_t row = (size_t)u.pm * 256 + wr * 64 + fr + ai * 128 + m * 16;
#pragma unroll
                for (int bj = 0; bj < 2; ++bj) pg8::st8(YS + row * D + col0 + bj * 128, acc[ai][bj][m][0], acc[ai][bj][m][1]); }
    } };

__device__ __forceinline__ void f3_nyquist_row(Frame& F) {
    const int gw = F.bid * NWAVES + F.wave, NGW = F.G * NWAVES, lane = F.lane;
    const bf16_t* YT = WSP(bf16_t, WS_YT); bf16_t* OUT = WSP(bf16_t, WS_OUTB);
    for (int task = gw; task < NB * D; task += NGW) {
        const u32x4* yp = (const u32x4*)(YT + (size_t)task * 4096);
        float se = 0.f, so = 0.f;
#pragma unroll
        for (int j = 0; j < 4; ++j) { const u32x4 w = yp[lane + 64 * j];
            se += (bf2f(w.x & 0xffffu) + bf2f(w.y & 0xffffu)) + (bf2f(w.z & 0xffffu) + bf2f(w.w & 0xffffu));
            so += (bf2f(w.x >> 16) + bf2f(w.y >> 16)) + (bf2f(w.z >> 16) + bf2f(w.w >> 16)); }
        const float tot = wave_sum(se - so) * 0.022097087f;
        if (lane == 0) OUT[(size_t)((task >> 10) * TX + TX / 2) * D + (task & 1023)] = (bf16_t)f2bf(tot);
    }
}

constexpr int STEPS_PER_LAYER = 11, STEP_FINAL = 1 + 4 * STEPS_PER_LAYER, NSTEPS = STEP_FINAL + 1;
#ifndef SCAN_IMPL
#define SCAN_IMPL 1
#endif
#define SCAN_FN scan_pipe
#ifndef PH_MASK
#define PH_MASK 0xFFFFFFFFu
#endif
#define EN(k) (((PH_MASK) >> (k)) & 1u)
#ifndef PROBE_DUP
#define PROBE_DUP -1
#endif
#define REP(k) _Pragma("unroll 1") for (int _rep = 0; _rep < ((PROBE_DUP) == (k) ? 2 : 1); ++_rep)

__device__ __forceinline__ bool relaunder(Frame& F) { unsigned long long v = (unsigned long long)F.ws; asm volatile("" : "+s"(v)); F.ws = (unsigned char*)(__attribute__((address_space(1))) unsigned char*)v;
    int w = F.wave; asm volatile("" : "+s"(w)); F.wave = w;
    int ln = (int)__builtin_amdgcn_mbcnt_hi(~0u, __builtin_amdgcn_mbcnt_lo(~0u, 0u)); asm volatile("" : "+v"(ln)); F.lane = ln; F.tid = w * 64 + ln; return true; }
__device__ __forceinline__ void grid_sync(unsigned char* ws, LAS unsigned char* lds) {
    XcdBarrier bar; bar.bar = (unsigned*)(ws + WS_CTL); bar.x = xb_xcc_id(); bar.st = (volatile LAS unsigned*)(lds + MISC_OFF);
    xcd_barrier(bar);
}

__global__ void __launch_bounds__(NTHR, 2) fwd(Args a_unused) {
    extern __shared__ __attribute__((aligned(16))) unsigned char lds_raw[];
    Frame F;
    F.lds = (LAS unsigned char*)lds_raw;
    F.tid = threadIdx.x; F.lane = F.tid & 63; F.wave = __builtin_amdgcn_readfirstlane(F.tid >> 6);
    CArgs* ap0 = (CArgs*)__builtin_amdgcn_kernarg_segment_ptr();
    F.G = gridDim.x; F.bid = blockIdx.x; F.ws = ap0->ws;
    const int lo = ap0->ph_lo, hi = ap0->ph_hi;
#define a (*launder_args(ap0))
    if (hi - lo > 1) {
        volatile LAS unsigned* MISC = (volatile LAS unsigned*)(F.lds + MISC_OFF);
        if (F.tid < 4) MISC[F.tid] = 0u;
        __syncthreads();
        (void)xcd_barrier_post((unsigned*)(F.ws + WS_CTL), MISC);
    }
#define IN(s) ((lo <= (s) && (s) < hi) && relaunder(F))
#define END(s) do { if (hi > (s) + 1) grid_sync(F.ws, F.lds); } while (0)
#define PINIT(P, nm, abase, bbase) do { P.G = F.G; P.c = F.bid; P.nM = (nm); P.gA = (const char*)(F.ws + (abase)); P.gB = (const char*)(F.ws + (bbase)); } while (0)

    if (EN(0) && IN(0)) { REP(0) p0_prologue(F, a); END(0); }

#pragma unroll 1
    for (int l = 0; l < 4; ++l) {
        const int s0 = 1 + l * STEPS_PER_LAYER;
        if (EN(1) && IN(s0 + 0)) {
            if (l & 1) row_pass<1>(F, a, l, true, NR); else row_pass<0>(F, a, l, l > 0, NR);
            END(s0 + 0);
        }
        if (!(l & 1)) {
            if (EN(2) && IN(s0 + 1)) {
                ProbF2 P; PINIT(P, 2, WS_CH, WS_HB);
                EpiF2 E; E.YT = WSP(bf16_t, WS_YT); E.YTC = WSP(bf16_t, WS_YTC);
                REP(2) pg8::gemm_phase(F.lds, F.tid, P, E);
                END(s0 + 1);
            }
            if (EN(3) && IN(s0 + 2)) {
                { ProbF3H P; PINIT(P, 64, WS_SEQX, WS_YT);
                  EpiF3H E; E.OUT = WSP(bf16_t, WS_OUTB); E.scratch = WSP(f32x4, WS_END); E.bid = F.bid;
                  pg8::gemm_phase(F.lds, F.tid, P, E);
                  f3_nyquist_row(F); }
                { ProbF3C P; PINIT(P, 16, WS_SEQC, WS_YTC);
                  EpiRows E; E.OUT = WSP(bf16_t, WS_OUTB); E.row0 = NXR; E.ld = D;
                  pg8::gemm_phase(F.lds, F.tid, P, E); }
                END(s0 + 2);
            }
        } else {
            if (EN(4) && IN(s0 + 1)) { shift_pass(F, a, l >> 1); END(s0 + 1); }
            if (EN(5) && IN(s0 + 2)) {
                EpiRG1 E; E.ws = F.ws; E.voff = (l == 1) ? WS_VFIRST : WS_VB;
                { ProbRG1B8 P; PINIT(P, NR / 256, WS_HB2, WS_WL8 + (size_t)(l >> 1) * 512 * 2048);
                  EpiRG1B8 EB; EB.ws = F.ws; EB.XSC = WSP(float, WS_HXS); EB.WSC = WSP(float, WS_WL8S) + (l >> 1) * 512;
                  pg8::gemm_phase<ProbRG1B8, EpiRG1B8, true>(F.lds, F.tid, P, EB); }
                { ProbRG1A8 P; PINIT(P, NR / 256, WS_XR, WS_WCAT + (size_t)(l >> 1) * 3584 * 2048 * 2); P.c = (F.bid + 192) & 255; if (F.G != 256) P.c = F.bid;
                  EpiRG1A8 E8; E8.ws = F.ws; E8.voff = (l == 1) ? WS_VFIRST : WS_VB; E8.XSC = WSP(float, WS_RKVXS); E8.WSC = WSP(float, WS_RKVWS) + (l >> 1) * 3072;
                  pg8::gemm_phase<ProbRG1A8, EpiRG1A8, true>(F.lds, F.tid, P, E8); }
                END(s0 + 2);
            }
            if (EN(6) && IN(s0 + 3)) {
                const int ri = l >> 1;
                ProbRG2 P; PINIT(P, NR / 256, WS_A23, WS_W2CAT + (size_t)ri * 6144 * 256 * 2); P.nn = (l == 1) ? 20 : 24;
                EpiRG2 E; E.ws = F.ws; E.w0 = a.in[I_W0] + ri * 2048; E.a0 = a.in[I_A0] + ri * 2048; E.v0 = a.in[I_V0];
                lora2_phase(F, P, E);
                END(s0 + 3);
            }
            if (EN(7) && IN(s0 + 4)) { REP(7) SCAN_FN(F, a, l >> 1, (l == 1) ? WSP(bf16_t, WS_VFIRST) : WSP(bf16_t, WS_VB), (l == 1) ? WSP(bf16_t, WS_VB) : WSP(bf16_t, WS_VFIRST)); END(s0 + 4); }
            if (EN(8) && IN(s0 + 5)) { rwkv_out_pass(F, a, l >> 1, (l == 1) ? WSP(bf16_t, WS_VFIRST) : WSP(bf16_t, WS_VB), (l == 1) ? WSP(bf16_t, WS_VB) : WSP(bf16_t, WS_VFIRST), (l < 3) ? NR : NXR); END(s0 + 5); }
        }
        if (EN(9) && IN(s0 + 6)) {
            ProbRM<4, D, D, 16> P; PINIT(P, (l < 3) ? NR / 256 : NXR / 256, WS_OUTB, WS_WOT + (size_t)l * D * D * 2);
            EpiWO E; E.DELTA = WSP(bf16_t, WS_DELTA); E.mod = WSP(float, WS_MOD) + (size_t)l * 17 * 6144; E.bias = WSP(float, WS_WOB) + l * 1024;
            if (l & 1) {
                ProbWO8 P8; PINIT(P8, (l < 3) ? NR / 256 : NXR / 256, WS_OUTB, WS_WO8 + (size_t)(l >> 1) * 1048576);
                EpiWO8 E8; E8.DELTA = E.DELTA; E8.mod = E.mod; E8.bias = E.bias; E8.XSC = WSP(float, WS_OUTSC); E8.WSC = WSP(float, WS_WO8S) + (l >> 1) * 1024;
                if (F.bid & 1) { moe_weight_conv(F, a, l, (l < 3) ? 576 : 512); __syncthreads(); pg8::gemm_phase<ProbWO8, EpiWO8, true>(F.lds, F.tid, P8, E8); }
                else { pg8::gemm_phase<ProbWO8, EpiWO8, true>(F.lds, F.tid, P8, E8); moe_weight_conv(F, a, l, (l < 3) ? 576 : 512); }
            } else {
            if (F.bid & 1) { moe_weight_conv(F, a, l, (l < 3) ? 576 : 512); __syncthreads(); pg8::gemm_phase(F.lds, F.tid, P, E); }
            else { pg8::gemm_phase(F.lds, F.tid, P, E); moe_weight_conv(F, a, l, (l < 3) ? 576 : 512); }
            }
            END(s0 + 6);
        }
        if (EN(10) && IN(s0 + 7)) { row_pass<2>(F, a, l, false, (l < 3) ? NR : NXR); END(s0 + 7); }
        if (EN(11) && IN(s0 + 8)) { REP(11) topk_phase(F, l < 3); END(s0 + 8); }
        if (EN(12) && IN(s0 + 9)) {
            ProbMoE8<8> P; PINIT(P, (l < 3) ? NS / 256 : NSX / 256, WS_XS, WS_MOEW_GU);
            EpiGU8 E; E.HID = WSP(bf16_t, WS_HID); E.XSC = WSP(float, WS_XSCALE); E.WSC = WSP(float, WS_WSCALE);
            pg8::gemm_phase<ProbMoE8<8>, EpiGU8, true>(F.lds, F.tid, P, E);
            END(s0 + 9);
        }
        if (EN(13) && IN(s0 + 10)) {
            ProbMoE<4, 1024> P; PINIT(P, (l < 3) ? NS / 256 : NSX / 256, WS_HID, WS_MOEW_DN);
            EpiDN E; E.YS = WSP(bf16_t, WS_YS); E.GATE = WSP(float, WS_GATE);
            REP(13) pg8::gemm_phase(F.lds, F.tid, P, E);
            END(s0 + 10);
        }
    }
    if (EN(14) && IN(STEP_FINAL)) { row_pass<3>(F, a, 3, true, NXR); }
#undef IN
#undef END
#undef PINIT
#undef a
}

extern "C" void kernel_launch(void* const* d_in, const int* in_sizes, int n_in, void* d_out, int out_size, void* d_ws, size_t ws_size, hipStream_t stream) {
    static int grid = 0;
    if (grid == 0) {
        if (n_in != 35 || out_size != NXR * D || ws_size < WS_TOTAL) { fprintf(stderr, "kernel_launch: unexpected shapes (n_in %d out %d ws %zu need %zu)\n", n_in, out_size, ws_size, (size_t)WS_TOTAL); grid = -1; return; }
        int dev = 0, cus = 0, per_cu = 0;
        if (hipGetDevice(&dev) != hipSuccess || hipDeviceGetAttribute(&cus, hipDeviceAttributeMultiprocessorCount, dev) != hipSuccess) { grid = -1; return; }
        if (hipFuncSetAttribute((const void*)fwd, hipFuncAttributeMaxDynamicSharedMemorySize, LDS_BYTES) != hipSuccess) { fprintf(stderr, "kernel_launch: hipFuncSetAttribute failed\n"); grid = -1; return; }
        if (hipOccupancyMaxActiveBlocksPerMultiprocessor(&per_cu, (const void*)fwd, NTHR, LDS_BYTES) != hipSuccess || per_cu < 1) fprintf(stderr, "kernel_launch: occupancy query says %d\n", per_cu);
        (void)hipGetLastError();
        grid = cus > 0 ? cus : 256;
    }
    if (grid < 0) return;
    if (hipMemsetAsync((char*)d_ws + WS_CTL, 0, WS_ZERO_BYTES, stream) != hipSuccess) return;
    Args a{};
    for (int i = 0; i < 35; ++i) a.in[i] = (const float*)d_in[i];
    a.out = (float*)d_out; a.ws = (unsigned char*)d_ws;
#if MK_SINGLE
    a.ph_lo = 0; a.ph_hi = NSTEPS;
    hipLaunchKernelGGL(fwd, dim3(grid), dim3(NTHR), LDS_BYTES, stream, a);
#else
    for (int s = 0; s < NSTEPS; ++s) {
        if (s >= 1 && s < STEP_FINAL) { const int l = (s - 1) / STEPS_PER_LAYER, k = (s - 1) % STEPS_PER_LAYER; if (!(l & 1) && k >= 3 && k <= 5) continue; }
        a.ph_lo = s; a.ph_hi = s + 1;
        hipLaunchKernelGGL(fwd, dim3(grid), dim3(NTHR), LDS_BYTES, stream, a);
    }
#endif
}
```
